# Optimizing an MI355X kernel written in HIP

```python
import jax, jax.numpy as jnp
from jax import lax
import numpy as np

D_MODEL = 2048
BATCH = 8
SEQ = 2048
DEPTH = 1

D_CONV = D_MODEL // 2
CONV_GROUPS = 16
CONV_WIDTH = 3
D_ATTN = D_MODEL - D_CONV
N_HEADS = 8
HEAD_DIM = D_ATTN // N_HEADS
D_MIX = D_CONV + D_ATTN
D_IN = 4 * D_CONV + 4 * D_ATTN
MOBA_BLOCK = 256
MOBA_TOPK = 3
Q_CHUNK = 64
EPS = 1e-6

kernel_name = "hymba_conv_moba_hybrid"


def rms_norm(x, gain):
    xf = x.astype(jnp.float32)
    y = xf * lax.rsqrt(jnp.mean(xf * xf, axis=-1, keepdims=True) + EPS)
    return (y * gain.astype(jnp.float32)).astype(x.dtype)


def short_gated_conv(h, b_gate, c_gate, conv_w):
    seq = h.shape[1]
    u = c_gate * h
    u_pad = jnp.pad(u, ((0, 0), (CONV_WIDTH - 1, 0), (0, 0)))
    conv = u_pad[:, 0:seq] * conv_w[0]
    for tap in range(1, CONV_WIDTH):
        conv = conv + u_pad[:, tap:tap + seq] * conv_w[tap]
    return b_gate * conv


def moba_attention(q, k, v):
    bsz, n_heads, seq, hd = q.shape
    n_blocks = -(-seq // MOBA_BLOCK)
    pad = n_blocks * MOBA_BLOCK - seq
    k_pad = jnp.pad(k, ((0, 0), (0, 0), (0, pad), (0, 0)))
    v_pad = jnp.pad(v, ((0, 0), (0, 0), (0, pad), (0, 0)))
    k_blocks = k_pad.reshape(bsz, n_heads, n_blocks, MOBA_BLOCK, hd)
    v_blocks = v_pad.reshape(bsz, n_heads, n_blocks, MOBA_BLOCK, hd)
    k_mean = jnp.mean(k_blocks.astype(jnp.float32), axis=3)
    k_sel = min(MOBA_TOPK, n_blocks)
    scale = hd ** -0.5
    n_chunks = seq // Q_CHUNK
    q_chunks = q.reshape(bsz, n_heads, n_chunks, Q_CHUNK, hd).transpose(2, 0, 1, 3, 4)
    b_idx = jnp.arange(bsz)[:, None, None]
    h_idx = jnp.arange(n_heads)[None, :, None]
    block_ids = jnp.arange(n_blocks)
    slot_ids = jnp.arange(k_sel)
    key_offsets = jnp.arange(MOBA_BLOCK)

    def chunk_fn(args):
        ci, q_blk = args
        start = ci * Q_CHUNK
        own = start // MOBA_BLOCK
        q_pos = start + jnp.arange(Q_CHUNK)
        gate = jnp.einsum('bhqd,bhnd->bhqn', q_blk.astype(jnp.float32), k_mean)
        gate = jnp.where(block_ids < own, gate, -jnp.inf)
        _, sel = lax.top_k(gate, k_sel)
        sel_valid = slot_ids < own
        k_own = lax.dynamic_index_in_dim(k_blocks, own, axis=2, keepdims=False)
        v_own = lax.dynamic_index_in_dim(v_blocks, own, axis=2, keepdims=False)
        s_own = jnp.einsum('bhqd,bhkd->bhqk', q_blk, k_own).astype(jnp.float32) * scale
        k_pos = own * MOBA_BLOCK + key_offsets
        s_own = jnp.where(k_pos[None, :] <= q_pos[:, None], s_own, -jnp.inf)
        scores = []
        for slot in range(k_sel):
            k_g = k_blocks[b_idx, h_idx, sel[..., slot]]
            s = jnp.einsum('bhqd,bhqkd->bhqk', q_blk, k_g).astype(jnp.float32) * scale
            scores.append(jnp.where(sel_valid[slot], s, -jnp.inf))
        scores.append(s_own)
        probs = jax.nn.softmax(jnp.concatenate(scores, axis=-1), axis=-1).astype(v.dtype)
        out = jnp.einsum('bhqk,bhkd->bhqd', probs[..., k_sel * MOBA_BLOCK:], v_own)
        for slot in range(k_sel):
            v_g = v_blocks[b_idx, h_idx, sel[..., slot]]
            p_slot = probs[..., slot * MOBA_BLOCK:(slot + 1) * MOBA_BLOCK]
            out = out + jnp.einsum('bhqk,bhqkd->bhqd', p_slot, v_g)
        return out.astype(q.dtype)

    outs = lax.map(chunk_fn, (jnp.arange(n_chunks), q_chunks))
    return outs.transpose(1, 2, 0, 3, 4).reshape(bsz, n_heads, seq, hd)


def setup_inputs(seed: int = 0) -> dict:
    key = jax.random.key(seed)
    ks = jax.random.split(key, 9)
    x = jax.random.normal(ks[0], (BATCH, SEQ, D_MODEL), jnp.float32)
    norm_gain = 1.0 + 0.1 * jax.random.normal(ks[1], (DEPTH, D_MODEL), jnp.float32)
    w_in = jax.random.normal(ks[2], (DEPTH, D_MODEL, D_IN), jnp.float32) * D_MODEL ** -0.5
    conv_w = jax.random.normal(ks[3], (DEPTH, CONV_WIDTH, D_CONV), jnp.float32) * CONV_WIDTH ** -0.5
    q_norm_gain = 1.0 + 0.1 * jax.random.normal(ks[4], (DEPTH, HEAD_DIM), jnp.float32)
    k_norm_gain = 1.0 + 0.1 * jax.random.normal(ks[5], (DEPTH, HEAD_DIM), jnp.float32)
    conv_out_gain = 1.0 + 0.1 * jax.random.normal(ks[6], (DEPTH, D_CONV), jnp.float32)
    attn_out_gain = 1.0 + 0.1 * jax.random.normal(ks[7], (DEPTH, D_ATTN), jnp.float32)
    w_out = jax.random.normal(ks[8], (DEPTH, D_MIX, D_MODEL), jnp.float32) * D_MIX ** -0.5
    return {"x": x, "norm_gain": norm_gain, "w_in": w_in, "conv_w": conv_w,
            "q_norm_gain": q_norm_gain, "k_norm_gain": k_norm_gain,
            "conv_out_gain": conv_out_gain, "attn_out_gain": attn_out_gain, "w_out": w_out}


def reference(x, norm_gain, w_in, conv_w, q_norm_gain, k_norm_gain, conv_out_gain, attn_out_gain, w_out):
    bsz, seq, _ = x.shape
    split_points = [D_CONV, 2 * D_CONV, 3 * D_CONV, 4 * D_CONV,
                    4 * D_CONV + D_ATTN, 4 * D_CONV + 2 * D_ATTN, 4 * D_CONV + 3 * D_ATTN]
    for layer in range(DEPTH):
        h = rms_norm(x, norm_gain[layer])
        proj = jnp.einsum('bsd,de->bse', h, w_in[layer])
        h_conv, b_gate, c_gate, z_conv, q, k, v, z_attn = jnp.split(proj, split_points, axis=-1)
        y_conv = short_gated_conv(h_conv, b_gate, c_gate, conv_w[layer])
        y_conv = rms_norm(y_conv, conv_out_gain[layer]) * jax.nn.silu(z_conv)
        q = rms_norm(q.reshape(bsz, seq, N_HEADS, HEAD_DIM), q_norm_gain[layer]).transpose(0, 2, 1, 3)
        k = rms_norm(k.reshape(bsz, seq, N_HEADS, HEAD_DIM), k_norm_gain[layer]).transpose(0, 2, 1, 3)
        v = v.reshape(bsz, seq, N_HEADS, HEAD_DIM).transpose(0, 2, 1, 3)
        y_attn = moba_attention(q, k, v).transpose(0, 2, 1, 3).reshape(bsz, seq, D_ATTN)
        y_attn = rms_norm(y_attn, attn_out_gain[layer]) * jax.nn.silu(z_attn)
        y = jnp.concatenate([y_conv, y_attn], axis=-1)
        x = x + jnp.einsum('bse,ed->bsd', y, w_out[layer])
    return x
```

```cpp
#include <hip/hip_runtime.h>
#include <cstdio>
#include <cstdint>
namespace pg8 {
#define PG8_LAS __attribute__((address_space(3)))
typedef unsigned short bf16_t;
typedef short bf16x8 __attribute__((ext_vector_type(8)));
typedef float f32x4 __attribute__((ext_vector_type(4)));
typedef unsigned u32x4 __attribute__((ext_vector_type(4)));
constexpr int BM = 256, BK = 64, HALF = 128, HTB = HALF * BK * 2  , STAGE_BYTES = 8 * HTB, NXCD = 8, WGM = 8;

__host__ __device__ __forceinline__ int lds_byte(int r, int c) { const int st = (r >> 4) * 2 + (c >> 5), rr = r & 15, cc = c & 31, ob = rr * 64 + cc * 2; return st * 1024 + (ob ^ (((ob >> 9) & 1) << 5)); }
__host__ __device__ __forceinline__ void stage_rc(int b, int& R, int& C) { const int st = b / 1024, sb = b % 1024, swz = sb ^ (((sb >> 9) & 1) << 5); R = (st >> 1) * 16 + swz / 64; C = (st & 1) * 32 + (swz % 64) / 2; }
__host__ __device__ __forceinline__ int perm32(int rho) { const int n = rho >> 4, i = rho & 15; return 8 * (i >> 2) + 4 * n + (i & 3); }

struct Unit { int pm, pn; };
struct Gemm { const bf16_t* A; const bf16_t* Bt; int M, N, K; };

struct StaticOrder {
    int nM, nN, nwg, G, c;
    __host__ __device__ void init(int M, int N, int G_, int c_) { nM = M / BM; nN = N / BM; nwg = nM * nN; G = G_; c = c_; }
    __host__ __device__ bool next(int i, Unit& u) const {
        const long L = (long)i * G + c; if (L >= nwg) return false;
        int wgid = (int)L; { const int q = nwg / NXCD, r = nwg % NXCD, xcd = wgid % NXCD, off = wgid / NXCD; wgid = (xcd < r ? xcd * (q + 1) : r * (q + 1) + (xcd - r) * q) + off; }
        const int nig = WGM * nN, gid = wgid / nig, fm = gid * WGM, gsz = (nM - fm) < WGM ? (nM - fm) : WGM;
        u.pm = fm + ((wgid % nig) % gsz); u.pn = (wgid % nig) / gsz; return true;
    }
    __device__ __forceinline__ void a_ready(const Unit&) const {}
    __device__ __forceinline__ void done(const Unit&) const {}
};

__device__ __forceinline__ unsigned cvt_pk_bf16(float lo, float hi) { unsigned r; asm volatile("v_cvt_pk_bf16_f32 %0, %1, %2" : "=v"(r) : "v"(lo), "v"(hi)); return r; }
typedef float f32x2 __attribute__((ext_vector_type(2)));
__device__ __forceinline__ f32x2 gelu_pk(f32x2 v) {
    const f32x2 av = __builtin_elementwise_abs(v), d = av * 0.2316418882f + 1.0f;
    f32x2 t; t.x = __builtin_amdgcn_rcpf(d.x); t.y = __builtin_amdgcn_rcpf(d.y);
    f32x2 q = t * 0.5307027145f + (-0.7265760135f); q = q * t + 0.7107068705f; q = q * t + (-0.142248368f); q = q * t + 0.127414796f; q = q * t;
    const f32x2 s = (v * v) * (-0.72134752044f);
    f32x2 e; e.x = __builtin_amdgcn_exp2f(s.x); e.y = __builtin_amdgcn_exp2f(s.y);
    const f32x2 m = v * (q * e), r = v - m;
    f32x2 o; o.x = v.x < 0.f ? m.x : r.x; o.y = v.y < 0.f ? m.y : r.y; return o;
}

template <int ACT  > struct EpiBf16 {
    static constexpr bool PERM = true, AFTER_DRAIN = false; static_assert(ACT == 0 || ACT == 1, "EpiBf16: ACT is 0 (none) or 1 (gelu_pk)");
    bf16_t* O; int ldc; const float* bias; int split_cols; size_t split_stride; float scale0;
    __device__ __forceinline__ void operator()(const f32x4 (&acc)[2][2][4][2], const Unit& u, int wr, int wc, int fr, int fq) const {
        const int row0 = u.pm * BM + wr * 64 + fr; int colt = u.pn * BM; bf16_t* base = O;
        float sc = 1.f; if (split_cols) { const int t = colt / split_cols; base += (size_t)t * split_stride; colt -= t * split_cols; if (t == 0) sc = scale0; }
        const int col0 = colt + wc * 32 + 8 * fq, bcol0 = u.pn * BM + wc * 32 + 8 * fq;
        f32x4 bv[2][2];
#pragma unroll
        for (int bj = 0; bj < 2; ++bj)
#pragma unroll
            for (int n = 0; n < 2; ++n) bv[bj][n] = bias ? *(const f32x4*)(bias + bcol0 + bj * HALF + 4 * n) : (f32x4){0.f, 0.f, 0.f, 0.f};
#pragma unroll
        for (int ai = 0; ai < 2; ++ai)
#pragma unroll
            for (int m = 0; m < 4; ++m) { bf16_t* rowp = base + (size_t)(row0 + ai * HALF + m * 16) * ldc + col0;
#pragma unroll
                for (int bj = 0; bj < 2; ++bj) { f32x4 v0 = acc[ai][bj][m][0] + bv[bj][0], v1 = acc[ai][bj][m][1] + bv[bj][1];
                    if (ACT == 1) { f32x2 a = gelu_pk((f32x2){v0[0], v0[1]}), b = gelu_pk((f32x2){v0[2], v0[3]}), c = gelu_pk((f32x2){v1[0], v1[1]}), d = gelu_pk((f32x2){v1[2], v1[3]});
                        v0 = (f32x4){a.x, a.y, b.x, b.y}; v1 = (f32x4){c.x, c.y, d.x, d.y}; }
                    v0 = v0 * sc; v1 = v1 * sc; u32x4 w; w.x = cvt_pk_bf16(v0[0], v0[1]); w.y = cvt_pk_bf16(v0[2], v0[3]); w.z = cvt_pk_bf16(v1[0], v1[1]); w.w = cvt_pk_bf16(v1[2], v1[3]);
                    *(u32x4*)(rowp + bj * HALF) = w; } }
    }
};

struct PanelStats {
    unsigned* xbuf;
    unsigned* cnt;
    unsigned* tmo;
    int ntn; float eps;
    unsigned code;
    __device__ __forceinline__ bool run(const f32x4 (&v)[2][2][4][2], const Unit& u, int wr, int wc, int fr, int fq, PG8_LAS unsigned char* lds, int wid, int lane) const {
        typedef float f32x2v __attribute__((ext_vector_type(2)));
        PG8_LAS f32x2v* P = (PG8_LAS f32x2v*)lds;
        PG8_LAS f32x2v* S = (PG8_LAS f32x2v*)(lds + 8192);
        PG8_LAS unsigned* flag = (PG8_LAS unsigned*)(lds + 8192 + 2048);
#pragma unroll
        for (int ai = 0; ai < 2; ++ai)
#pragma unroll
            for (int m = 0; m < 4; ++m) {
                float s = 0.f;
#pragma unroll
                for (int bj = 0; bj < 2; ++bj)
#pragma unroll
                    for (int n = 0; n < 2; ++n) { const f32x4 x = v[ai][bj][m][n]; s += (x[0] + x[1]) + (x[2] + x[3]); }
                s += __shfl_xor(s, 16); s += __shfl_xor(s, 32);
                const float mw = s * (1.0f / 64.0f); float q = 0.f;
#pragma unroll
                for (int bj = 0; bj < 2; ++bj)
#pragma unroll
                    for (int n = 0; n < 2; ++n) { const f32x4 d = v[ai][bj][m][n] - mw; q += (d[0] * d[0] + d[1] * d[1]) + (d[2] * d[2] + d[3] * d[3]); }
                q += __shfl_xor(q, 16); q += __shfl_xor(q, 32);
                if (fq == 0) P[(ai * HALF + wr * 64 + m * 16 + fr) * 4 + wc] = (f32x2v){mw, q};
            }
        asm volatile("s_waitcnt lgkmcnt(0)" ::: "memory"); __builtin_amdgcn_s_barrier(); asm volatile("" ::: "memory");
#if defined(BROKEN_EXCHANGE_NO_WAIT)
#warning BROKEN CONTROL BUILD: the row-statistics exchange does not wait; results are wrong by design
        if (blockIdx.x >= 64) { const long long t0_ = clock64(); while (clock64() - t0_ < 60000) __builtin_amdgcn_s_sleep(8); }
#endif
        const int row = wid * 32 + (lane & 31);
        if (lane < 32) {
            const f32x2v a = P[row * 4 + 0], b = P[row * 4 + 1], c = P[row * 4 + 2], d = P[row * 4 + 3];
            const float mt = (a.x + b.x + c.x + d.x) * 0.25f;
            const float da = a.x - mt, db = b.x - mt, dc = c.x - mt, dd = d.x - mt;
            const float m2 = (a.y + b.y) + (c.y + d.y) + 64.0f * ((da * da + db * db) + (dc * dc + dd * dd));
            unsigned long long* slot = (unsigned long long*)xbuf + ((size_t)(u.pm * BM + row) * 4 + u.pn);
            __hip_atomic_store(slot, ((unsigned long long)__float_as_uint(m2) << 32) | __float_as_uint(mt), __ATOMIC_RELAXED, __HIP_MEMORY_SCOPE_AGENT);
        }
        asm volatile("s_waitcnt vmcnt(0)" ::: "memory");
        if (lane == 0) __hip_atomic_fetch_add(cnt + 64 * u.pm, 1u, __ATOMIC_RELAXED, __HIP_MEMORY_SCOPE_AGENT);
        if (wid == 0) {
            bool dead = false; const unsigned long long t0 = __builtin_amdgcn_s_memrealtime(); const unsigned want = 8u * (unsigned)ntn;
            for (;;) {
#if defined(BROKEN_EXCHANGE_NO_WAIT)
                break;
#endif
                if ((unsigned)__builtin_amdgcn_readfirstlane(__hip_atomic_load(cnt + 64 * u.pm, __ATOMIC_RELAXED, __HIP_MEMORY_SCOPE_AGENT)) >= want) break;
                if (__builtin_amdgcn_s_memrealtime() - t0 > 2000000ull) {
                    if (lane == 0) { unsigned expect = 0u; __hip_atomic_compare_exchange_strong(tmo + 1, &expect, code | (unsigned)(u.pm & 0xff), __ATOMIC_RELAXED, __ATOMIC_RELAXED, __HIP_MEMORY_SCOPE_AGENT);
                                     __hip_atomic_store(tmo, 1u, __ATOMIC_RELAXED, __HIP_MEMORY_SCOPE_AGENT); }
                    dead = true; break; }
                __builtin_amdgcn_s_sleep(2);
            }
            __builtin_amdgcn_fence(__ATOMIC_ACQUIRE, "agent");
            if (lane == 0) flag[0] = dead ? 1u : 0u;
        }
        asm volatile("s_waitcnt vmcnt(0) lgkmcnt(0)" ::: "memory"); __builtin_amdgcn_s_barrier(); asm volatile("" ::: "memory");
        const bool bad = flag[0] != 0u;
        if (lane < 32) {
            const unsigned long long* slot = (const unsigned long long*)xbuf + (size_t)(u.pm * BM + row) * 4; float mt[4], m2[4]; float ms = 0.f;
#pragma unroll
            for (int t = 0; t < 4; ++t) { if (t < ntn) { const unsigned long long w = __hip_atomic_load(slot + t, __ATOMIC_RELAXED, __HIP_MEMORY_SCOPE_AGENT); mt[t] = __uint_as_float((unsigned)w); m2[t] = __uint_as_float((unsigned)(w >> 32)); } else { mt[t] = 0.f; m2[t] = 0.f; } ms += mt[t]; }
            const float mean = ms / (float)ntn; float q = 0.f;
#pragma unroll
            for (int t = 0; t < 4; ++t) if (t < ntn) { const float dm = mt[t] - mean; q += m2[t] + 256.0f * dm * dm; }
            S[row] = (f32x2v){mean, 1.0f / sqrtf(q / (256.0f * (float)ntn) + eps)};
        }
        asm volatile("s_waitcnt lgkmcnt(0)" ::: "memory"); __builtin_amdgcn_s_barrier(); asm volatile("" ::: "memory");
        return bad;
    }
};
struct EpiLnRes {
    static constexpr bool PERM = false, AFTER_DRAIN = true;
    const float* base; float* out; int ldc; const float* bias; PanelStats st; unsigned poison;
    __device__ __forceinline__ void fused(f32x4 (&acc)[2][2][4][2], const Unit& u, int wr, int wc, int fr, int fq, PG8_LAS unsigned char* lds, int wid, int lane) const {
        typedef float f32x2v __attribute__((ext_vector_type(2)));
        const PG8_LAS f32x2v* S = (const PG8_LAS f32x2v*)(lds + 8192);
        const int col0 = u.pn * BM + wc * 32 + 4 * fq;
#pragma unroll
        for (int bj = 0; bj < 2; ++bj)
#pragma unroll
            for (int n = 0; n < 2; ++n) { const f32x4 bv = bias ? *(const f32x4*)(bias + col0 + bj * HALF + n * 16) : (f32x4){0.f, 0.f, 0.f, 0.f};
#pragma unroll
                for (int ai = 0; ai < 2; ++ai)
#pragma unroll
                    for (int m = 0; m < 4; ++m) acc[ai][bj][m][n] += bv; }
        f32x4 pre[4][2][2];
#pragma unroll
        for (int m = 0; m < 4; ++m) { const size_t off = (size_t)(u.pm * BM + wr * 64 + m * 16 + fr) * ldc + col0;
#pragma unroll
            for (int bj = 0; bj < 2; ++bj)
#pragma unroll
                for (int n = 0; n < 2; ++n) pre[m][bj][n] = *(const f32x4*)(base + off + bj * HALF + n * 16); }
        const bool bad = st.run(acc, u, wr, wc, fr, fq, lds, wid, lane) || poison != 0u;
        const float qnan = __builtin_nanf("");
#pragma unroll
        for (int ai = 0; ai < 2; ++ai)
#pragma unroll
            for (int m = 0; m < 4; ++m) { const int r = ai * HALF + wr * 64 + m * 16 + fr; const f32x2v sr = S[r]; const size_t off = (size_t)(u.pm * BM + r) * ldc + col0;
#pragma unroll
                for (int bj = 0; bj < 2; ++bj)
#pragma unroll
                    for (int n = 0; n < 2; ++n) { const f32x4 bs = ai == 0 ? pre[m][bj][n] : *(const f32x4*)(base + off + bj * HALF + n * 16); f32x4 o = bs + (acc[ai][bj][m][n] - sr.x) * sr.y;
                        if (bad) o = (f32x4){qnan, qnan, qnan, qnan}; *(f32x4*)(out + off + bj * HALF + n * 16) = o; }
                if (m & 1) asm volatile("" ::: "memory"); }
    }
};
struct EpiLnResLn {
    static constexpr bool PERM = false, AFTER_DRAIN = true;
    const float* base; float* out; bf16_t* xn; int ldc; const float* bias; PanelStats st1, st2; unsigned poison;
    __device__ __forceinline__ void fused(f32x4 (&acc)[2][2][4][2], const Unit& u, int wr, int wc, int fr, int fq, PG8_LAS unsigned char* lds, int wid, int lane) const {
        typedef float f32x2v __attribute__((ext_vector_type(2))); typedef unsigned u32x2v __attribute__((ext_vector_type(2)));
        const PG8_LAS f32x2v* S = (const PG8_LAS f32x2v*)(lds + 8192);
        const int col0 = u.pn * BM + wc * 32 + 4 * fq;
#pragma unroll
        for (int bj = 0; bj < 2; ++bj)
#pragma unroll
            for (int n = 0; n < 2; ++n) { const f32x4 bv = bias ? *(const f32x4*)(bias + col0 + bj * HALF + n * 16) : (f32x4){0.f, 0.f, 0.f, 0.f};
#pragma unroll
                for (int ai = 0; ai < 2; ++ai)
#pragma unroll
                    for (int m = 0; m < 4; ++m) acc[ai][bj][m][n] += bv; }
        bool bad = st1.run(acc, u, wr, wc, fr, fq, lds, wid, lane) || poison != 0u;
        const float qnan = __builtin_nanf("");
#pragma unroll
        for (int ai = 0; ai < 2; ++ai)
#pragma unroll
            for (int m = 0; m < 4; ++m) { const int r = ai * HALF + wr * 64 + m * 16 + fr; const f32x2v sr = S[r]; const size_t off = (size_t)(u.pm * BM + r) * ldc + col0;
#pragma unroll
                for (int bj = 0; bj < 2; ++bj)
#pragma unroll
                    for (int n = 0; n < 2; ++n) { const f32x4 bs = *(const f32x4*)(base + off + bj * HALF + n * 16); acc[ai][bj][m][n] = bs + (acc[ai][bj][m][n] - sr.x) * sr.y; }
                asm volatile("" : "+v"(acc[ai][0][m][0]), "+v"(acc[ai][0][m][1]), "+v"(acc[ai][1][m][0]), "+v"(acc[ai][1][m][1]));
                if (m & 1) asm volatile("" ::: "memory"); }
        const bool bad1 = bad;
        bad = st2.run(acc, u, wr, wc, fr, fq, lds, wid, lane) || bad;
#pragma unroll
        for (int ai = 0; ai < 2; ++ai)
#pragma unroll
            for (int m = 0; m < 4; ++m) { const int r = ai * HALF + wr * 64 + m * 16 + fr; const f32x2v sr = S[r]; const size_t off = (size_t)(u.pm * BM + r) * ldc + col0;
#pragma unroll
                for (int bj = 0; bj < 2; ++bj)
#pragma unroll
                    for (int n = 0; n < 2; ++n) { const f32x4 x1 = acc[ai][bj][m][n]; *(f32x4*)(out + off + bj * HALF + n * 16) = bad1 ? (f32x4){qnan, qnan, qnan, qnan} : x1;
                        const f32x4 o = (x1 - sr.x) * sr.y; u32x2v w; w.x = cvt_pk_bf16(o[0], o[1]); w.y = cvt_pk_bf16(o[2], o[3]);
                        if (bad) { w.x = 0x7fc07fc0u; w.y = 0x7fc07fc0u; } *(u32x2v*)(xn + off + bj * HALF + n * 16) = w; }
                asm volatile("" ::: "memory"); }
    }
};

template <class Epi, class Sched, bool ALIGN_EPI = false, bool SP2 = false>
__device__ __forceinline__ void gemm_phase(PG8_LAS unsigned char* lds, const Gemm g, const Sched& S, const Epi& E) {
    const int tid = threadIdx.x, wid = __builtin_amdgcn_readfirstlane(tid >> 6), lane = tid & 63, wr = wid >> 2, wc = wid & 3, fr = lane & 15, fq = lane >> 4;
    const int K = g.K, nt = K / BK;
    unsigned voffA[2], voffB[2];
#pragma unroll
    for (int i = 0; i < 2; ++i) { int R, C; stage_rc(tid * 16 + i * 8192, R, C); const int Rb = Epi::PERM ? ((R & ~31) + perm32(R & 31)) : R;
        voffA[i] = (unsigned)(R * K + C) * 2u; voffB[i] = (unsigned)(Rb * K + C) * 2u; }
    const size_t kstep = (size_t)(BK * 2);
    const size_t hstep = (size_t)HALF * K * 2;
    const size_t tstep = 2 * hstep;
    const unsigned ldsw = (unsigned)wid * 1024u;
    const int aoff = lds_byte(wr * 64 + fr, fq * 8), boff = lds_byte(wc * 32 + fr, fq * 8);
#define PG8_SA(b, h) (((b) * 2 + (h)) * HTB)
#define PG8_SB(b, h) ((4 + (b) * 2 + (h)) * HTB)
#define PG8_STAGE(bufoff, gbase, voff) do { _Pragma("unroll") for (int _i = 0; _i < 2; ++_i) \
        __builtin_amdgcn_global_load_lds((const unsigned*)((const char*)(gbase) + (voff)[_i]), (PG8_LAS unsigned*)(lds + (bufoff) + ldsw + _i * 8192), 16, 0, 0); } while (0)
#define PG8_LDA(dst, b, h) do { _Pragma("unroll") for (int m = 0; m < 4; ++m) _Pragma("unroll") for (int k = 0; k < 2; ++k) dst[m][k] = *(const PG8_LAS bf16x8*)(lds + PG8_SA(b, h) + aoff + m * 2048 + k * 1024); } while (0)
#define PG8_LDB(dst, b, h) do { _Pragma("unroll") for (int n = 0; n < 2; ++n) _Pragma("unroll") for (int k = 0; k < 2; ++k) dst[n][k] = *(const PG8_LAS bf16x8*)(lds + PG8_SB(b, h) + boff + n * 2048 + k * 1024); } while (0)
#define PG8_MMA(ai, bj, At, Bt) do { __builtin_amdgcn_s_setprio(1); _Pragma("unroll") for (int m = 0; m < 4; ++m) _Pragma("unroll") for (int n = 0; n < 2; ++n) _Pragma("unroll") for (int k = 0; k < 2; ++k) \
        acc[ai][bj][m][n] = __builtin_amdgcn_mfma_f32_16x16x32_bf16(Bt[n][k], At[m][k], acc[ai][bj][m][n], 0, 0, 0); __builtin_amdgcn_s_setprio(0); } while (0)
#define PG8_WAIT_V(n) asm volatile("s_waitcnt vmcnt(" #n ")" ::: "memory")
#define PG8_WAIT_L(n) asm volatile("s_waitcnt lgkmcnt(" #n ")" ::: "memory")
#define PG8_BAR __builtin_amdgcn_s_barrier()
#define PG8_SCHED __builtin_amdgcn_sched_barrier(0)
    Unit cur, nxt; int ui = 0;
    if (!S.next(0, cur)) return;
    f32x4 acc[2][2][4][2];
#pragma unroll
    for (int a = 0; a < 2; ++a)
#pragma unroll
        for (int b = 0; b < 2; ++b)
#pragma unroll
            for (int m = 0; m < 4; ++m)
#pragma unroll
                for (int n = 0; n < 2; ++n) acc[a][b][m][n] = (f32x4){0.f, 0.f, 0.f, 0.f};
    bf16x8 At[4][2], B0[2][2], B1[2][2];
    const char* cA = (const char*)g.A + (size_t)cur.pm * tstep; const char* cB = (const char*)g.Bt + (size_t)cur.pn * tstep;
    S.a_ready(cur);
    if constexpr (SP2) {
        PG8_STAGE(PG8_SB(0, 0), cB, voffB); PG8_STAGE(PG8_SB(0, 1), cB + hstep, voffB); PG8_STAGE(PG8_SA(0, 0), cA, voffA); PG8_STAGE(PG8_SA(0, 1), cA + hstep, voffA);
        if (wr == 1) PG8_BAR;
        PG8_WAIT_V(2); PG8_BAR;
        PG8_STAGE(PG8_SB(1, 0), cB + kstep, voffB); PG8_STAGE(PG8_SA(1, 0), cA + kstep, voffA); PG8_STAGE(PG8_SB(1, 1), cB + hstep + kstep, voffB);
        PG8_WAIT_V(6); PG8_BAR;
    } else {
        PG8_STAGE(PG8_SB(0, 0), cB, voffB); PG8_STAGE(PG8_SA(0, 0), cA, voffA); PG8_STAGE(PG8_SB(0, 1), cB + hstep, voffB); PG8_STAGE(PG8_SA(0, 1), cA + hstep, voffA);
        if (wr == 1) PG8_BAR;
        PG8_WAIT_V(4); PG8_BAR;
        PG8_STAGE(PG8_SB(1, 0), cB + kstep, voffB); PG8_STAGE(PG8_SA(1, 0), cA + kstep, voffA); PG8_STAGE(PG8_SB(1, 1), cB + hstep + kstep, voffB);
        PG8_WAIT_V(6); PG8_BAR;
    }
    for (;;) {
        const bool has_next = S.next(ui + 1, nxt);
        const char* nA = has_next ? (const char*)g.A + (size_t)nxt.pm * tstep : cA; const char* nB = has_next ? (const char*)g.Bt + (size_t)nxt.pn * tstep : cB;
        for (int t = 0; t < nt; t += 2) {
            const bool last = (t == nt - 2);
            const char* a1 = cA + (size_t)(t + 1) * kstep;
            const char* a2 = last ? nA : cA + (size_t)(t + 2) * kstep; const char* b2 = last ? nB : cB + (size_t)(t + 2) * kstep;
            const char* a3 = a2 + kstep; const char* b3 = b2 + kstep;
            if (last && has_next) S.a_ready(nxt);
            if constexpr (SP2) {
            PG8_LDB(B0, 0, 0); PG8_LDB(B1, 0, 1); PG8_SCHED; PG8_LDA(At, 0, 0); PG8_STAGE(PG8_SA(1, 1), a1 + hstep, voffA);
            PG8_WAIT_V(8); PG8_WAIT_L(0); PG8_BAR; PG8_MMA(0, 0, At, B0); PG8_MMA(0, 1, At, B1); PG8_BAR; PG8_SCHED;
            PG8_LDA(At, 0, 1); PG8_STAGE(PG8_SB(0, 0), b2, voffB); PG8_STAGE(PG8_SB(0, 1), b2 + hstep, voffB); PG8_STAGE(PG8_SA(0, 0), a2, voffA);
            PG8_WAIT_V(8); PG8_WAIT_L(0); PG8_BAR; PG8_MMA(1, 0, At, B0); PG8_MMA(1, 1, At, B1); PG8_BAR; PG8_SCHED;
            PG8_LDB(B0, 1, 0); PG8_LDB(B1, 1, 1); PG8_SCHED; PG8_LDA(At, 1, 0); PG8_STAGE(PG8_SA(0, 1), a2 + hstep, voffA);
            PG8_WAIT_V(8); PG8_WAIT_L(0); PG8_BAR; PG8_MMA(0, 0, At, B0); PG8_MMA(0, 1, At, B1); PG8_BAR; PG8_SCHED;
            PG8_LDA(At, 1, 1); PG8_STAGE(PG8_SB(1, 0), b3, voffB); PG8_STAGE(PG8_SB(1, 1), b3 + hstep, voffB); PG8_STAGE(PG8_SA(1, 0), a3, voffA);
            PG8_WAIT_V(8); PG8_WAIT_L(0); PG8_BAR; PG8_MMA(1, 0, At, B0); PG8_MMA(1, 1, At, B1); PG8_BAR; PG8_SCHED;
            } else {
            PG8_LDB(B0, 0, 0); PG8_SCHED; PG8_LDA(At, 0, 0); PG8_STAGE(PG8_SA(1, 1), a1 + hstep, voffA);
            PG8_WAIT_L(8); PG8_BAR; PG8_WAIT_L(0); PG8_MMA(0, 0, At, B0); PG8_BAR; PG8_SCHED;
            PG8_LDB(B1, 0, 1); PG8_STAGE(PG8_SB(0, 0), b2, voffB);
            PG8_BAR; PG8_WAIT_L(0); PG8_MMA(0, 1, At, B1); PG8_BAR;
            PG8_LDA(At, 0, 1); PG8_STAGE(PG8_SA(0, 0), a2, voffA);
            PG8_BAR; PG8_WAIT_L(0); PG8_MMA(1, 0, At, B0); PG8_BAR; PG8_SCHED;
            PG8_STAGE(PG8_SB(0, 1), b2 + hstep, voffB);
            PG8_WAIT_V(6); PG8_BAR; PG8_MMA(1, 1, At, B1); PG8_BAR;
            PG8_LDB(B0, 1, 0); PG8_SCHED; PG8_LDA(At, 1, 0); PG8_STAGE(PG8_SA(0, 1), a2 + hstep, voffA);
            PG8_WAIT_L(8); PG8_BAR; PG8_WAIT_L(0); PG8_MMA(0, 0, At, B0); PG8_BAR; PG8_SCHED;
            PG8_LDB(B1, 1, 1); PG8_STAGE(PG8_SB(1, 0), b3, voffB);
            PG8_BAR; PG8_WAIT_L(0); PG8_MMA(0, 1, At, B1); PG8_BAR;
            PG8_LDA(At, 1, 1); PG8_STAGE(PG8_SA(1, 0), a3, voffA);
            PG8_BAR; PG8_WAIT_L(0); PG8_MMA(1, 0, At, B0); PG8_BAR; PG8_SCHED;
            PG8_STAGE(PG8_SB(1, 1), b3 + hstep, voffB);
            PG8_WAIT_V(6); PG8_BAR; PG8_MMA(1, 1, At, B1); PG8_BAR;
            }
        }
        if constexpr (ALIGN_EPI) { if (wr == 0) PG8_BAR; }
        if constexpr (!Epi::AFTER_DRAIN) { E(acc, cur, wr, wc, fr, fq); S.done(cur); }
        if (!has_next) break;
#pragma unroll
        for (int a = 0; a < 2; ++a)
#pragma unroll
            for (int b = 0; b < 2; ++b)
#pragma unroll
                for (int m = 0; m < 4; ++m)
#pragma unroll
                    for (int n = 0; n < 2; ++n) acc[a][b][m][n] = (f32x4){0.f, 0.f, 0.f, 0.f};
        cur = nxt; cA = nA; cB = nB; ++ui;
        if constexpr (ALIGN_EPI) { if (wr == 1) PG8_BAR; }
    }
    PG8_WAIT_V(0);
    if constexpr (!ALIGN_EPI) { if (wr == 0) PG8_BAR; }
    PG8_BAR;
    if constexpr (Epi::AFTER_DRAIN) { E.fused(acc, cur, wr, wc, fr, fq, lds, wid, lane); S.done(cur); }
#undef PG8_SA
#undef PG8_SB
#undef PG8_STAGE
#undef PG8_LDA
#undef PG8_LDB
#undef PG8_MMA
#undef PG8_WAIT_V
#undef PG8_WAIT_L
#undef PG8_BAR
#undef PG8_SCHED
}
}

#include <cmath>
namespace pg8 {
struct EpiResF32 {
    static constexpr bool PERM = false, AFTER_DRAIN = false;
    const float* base; float* out; int ldc;
    __device__ __forceinline__ void operator()(const f32x4 (&acc)[2][2][4][2], const Unit& u, int wr, int wc, int fr, int fq) const {
        const int row0 = u.pm * BM + wr * 64 + fr, col0 = u.pn * BM + wc * 32 + 4 * fq;
#pragma unroll
        for (int ai = 0; ai < 2; ++ai)
#pragma unroll
            for (int m = 0; m < 4; ++m) { const size_t off = (size_t)(row0 + ai * HALF + m * 16) * ldc + col0;
#pragma unroll
                for (int bj = 0; bj < 2; ++bj)
#pragma unroll
                    for (int n = 0; n < 2; ++n) *(f32x4*)(out + off + bj * HALF + n * 16) = acc[ai][bj][m][n] + *(const f32x4*)(base + off + bj * HALF + n * 16); }
    }
};
}

#ifndef PG8_SP2
#define PG8_SP2 true
#endif
#ifndef PG8_ALIGN
#define PG8_ALIGN true
#endif

constexpr int NWAVES = 8;
#ifndef MK_ONE_LAUNCH
#define MK_ONE_LAUNCH 0
#endif
constexpr int PER_PHASE = 6;
constexpr bool ONE_LAUNCH = (MK_ONE_LAUNCH != 0);

constexpr int BATCH = 8, SEQ = 2048, DM = 2048, M = BATCH * SEQ;
constexpr int DCONV = 1024, DATTN = 1024, NH = 8, HD = 128, DIN = 8192, DMIX = 2048;
constexpr int MBLK = 256, NBLK = SEQ / MBLK, TOPK = 3;
constexpr float EPS = 1e-6f;
constexpr float SM_SCALE = 0.08838834764831845f;

constexpr size_t MiB = 1u << 20;
constexpr size_t WS_CTL = 0, CTL_ZERO_BYTES = 1 * MiB;
constexpr size_t WS_WIN = 2 * MiB;
constexpr size_t WS_WOUT = 34 * MiB;
constexpr size_t WS_KMEAN = 42 * MiB;
constexpr size_t WS_XN = 48 * MiB;
constexpr size_t WS_PROJ = 112 * MiB;
constexpr size_t PROJ_STRIDE = 32 * MiB;
constexpr size_t WS_Y = 368 * MiB;
constexpr size_t WS_ARAW = 432 * MiB;
constexpr size_t WS_END = 496 * MiB;
constexpr int CW_TMO = 0, CW_CODE = 1;
constexpr int CW_BAR = 4096;

constexpr int RING_OFF = 0, RING_BYTES = 131072;
constexpr int LDSCTL_OFF = RING_BYTES, MISC_OFF = LDSCTL_OFF + 320;
constexpr int LDS_BYTES = 147456;
static_assert(MISC_OFF + 128 <= LDS_BYTES, "LDS map");

#define GAS __attribute__((address_space(1)))
#define LAS __attribute__((address_space(3)))
typedef unsigned short bf16;
typedef unsigned v4u __attribute__((ext_vector_type(4)));
typedef float f32x4 __attribute__((ext_vector_type(4)));
typedef short bf16x8 __attribute__((ext_vector_type(8)));
typedef GAS unsigned gu32;
typedef GAS unsigned long long gu64;
#define RLX_AGENT __ATOMIC_RELAXED, __HIP_MEMORY_SCOPE_AGENT
#define LDS_WAIT() asm volatile("s_waitcnt lgkmcnt(0)" ::: "memory")
#define VM_WAIT() asm volatile("s_waitcnt vmcnt(0)" ::: "memory")
__device__ __forceinline__ unsigned long long rt() { return __builtin_amdgcn_s_memrealtime(); }
__device__ __forceinline__ unsigned f2bf(float f) { unsigned u = __builtin_bit_cast(unsigned, f); return (u + 0x7fffu + ((u >> 16) & 1u)) >> 16; }
__device__ __forceinline__ unsigned pk2(float lo, float hi) { return f2bf(lo) | (f2bf(hi) << 16); }

#define XB_TMO      128
#define XB_XCNT(j)  (256  + 64 * (j))
#define XB_XSUB(j)  (1280 + 64 * (j))
#define XB_XGEN(j)  (2304 + 64 * (j))
#define XB_TOP      3328
#define XB_TOPGEN   3392
#define XCD_BAR_WORDS 3456
#define XB_SPIN_CAP (1u << 18)

__device__ __forceinline__ unsigned xb_ld(unsigned* p)              { return __hip_atomic_load(p, __ATOMIC_RELAXED, __HIP_MEMORY_SCOPE_AGENT); }
__device__ __forceinline__ unsigned xb_add(unsigned* p, unsigned v) { return __hip_atomic_fetch_add(p, v, __ATOMIC_RELAXED, __HIP_MEMORY_SCOPE_AGENT); }
__device__ __forceinline__ unsigned xb_xcc_id() { return (unsigned)__builtin_amdgcn_s_getreg((3 << 11) | 20) & 0xFu; }
#define XB_SPIN(cond, bar) do { unsigned _sp = 0; while (cond) { __builtin_amdgcn_s_sleep(1); \
    if ((++_sp & 255u) == 0u) { if (xb_ld(&(bar)[XB_TMO])) break; if (_sp > XB_SPIN_CAP) { atomicAdd(&(bar)[XB_TMO], 1u); break; } } } } while (0)

struct XcdBarrier {
    unsigned* bar; unsigned x;
    volatile LAS unsigned* st;
};

__device__ __forceinline__ XcdBarrier xcd_barrier_post(unsigned* bar, volatile LAS unsigned* st) {
    XcdBarrier b; b.bar = bar; b.x = xb_xcc_id(); b.st = st;
    if (threadIdx.x == 0) (void)xb_add(&bar[XB_XCNT(b.x)], 1u);
    return b;
}
__device__ __forceinline__ void xcd_barrier_complete(unsigned* bar, unsigned x, unsigned& nloc, unsigned& nx) {
    const unsigned G = gridDim.x * gridDim.y * gridDim.z;
    unsigned sum, cnt, mine, sp = 0u;
    for (;;) {
        sum = 0u; cnt = 0u; mine = 0u;
#pragma unroll
        for (unsigned j = 0; j < 16; ++j) { const unsigned c = xb_ld(&bar[XB_XCNT(j)]); sum += c; cnt += (c > 0u) ? 1u : 0u; mine = (j == x) ? c : mine; }
        if (sum == G) break;
        __builtin_amdgcn_s_sleep(1);
        if ((++sp & 255u) == 0u) { if (xb_ld(&bar[XB_TMO])) break; if (sp > XB_SPIN_CAP) { atomicAdd(&bar[XB_TMO], 1u); break; } }
    }
    nloc = mine > 0u ? mine : 1u; nx = cnt > 0u ? cnt : 1u;
}

__device__ __forceinline__ void xcd_barrier(const XcdBarrier& b) {
    asm volatile("s_waitcnt vmcnt(0)" ::: "memory");
    __syncthreads();
    if (threadIdx.x == 0) {
        unsigned* bar = b.bar;
        __builtin_amdgcn_s_waitcnt(0);
        unsigned nloc = b.st[0], nx = b.st[1];
        if (nloc == 0u) { xcd_barrier_complete(bar, b.x, nloc, nx); b.st[0] = nloc; b.st[1] = nx; }
        const unsigned old = xb_add(&bar[XB_XSUB(b.x)], 1u);
        const unsigned gen = old / nloc;
        if (old + 1u == (gen + 1u) * nloc) {
            __builtin_amdgcn_fence(__ATOMIC_RELEASE, "agent");
            asm volatile("s_waitcnt vmcnt(0)" ::: "memory");
            const unsigned og = xb_add(&bar[XB_TOP], 1u);
            const unsigned tg = og / nx;
            if (og + 1u == (tg + 1u) * nx) xb_add(&bar[XB_TOPGEN], 1u);
            else XB_SPIN(xb_ld(&bar[XB_TOPGEN]) == tg, bar);
            __builtin_amdgcn_fence(__ATOMIC_ACQUIRE, "agent");
            xb_add(&bar[XB_XGEN(b.x)], 1u);
            asm volatile("s_waitcnt vmcnt(0)" ::: "memory");
        } else {
            XB_SPIN(xb_ld(&bar[XB_XGEN(b.x)]) == gen, bar);
            __builtin_amdgcn_fence(__ATOMIC_ACQUIRE, "agent");
            asm volatile("s_waitcnt vmcnt(0)" ::: "memory");
        }
    }
    __syncthreads();
}


struct Frame {
    LAS unsigned char* lds;
    volatile LAS unsigned* MISC;
    gu32* ctl;
    int tid, lane, wave;
    int vcu, G;
    const float *x, *norm_gain, *w_in, *conv_w, *qg, *kg, *cog, *aog, *w_out; float* out;
    bf16 *WinT, *WoutT, *XN, *PROJ, *Y; float *KMEAN, *ARAW;
};

__device__ __forceinline__ float wave_sum(float v) {
#pragma unroll
    for (int o = 1; o < 64; o <<= 1) v += __shfl_xor(v, o);
    return v;
}
__device__ __forceinline__ float wave_max(float v) {
#pragma unroll
    for (int o = 1; o < 64; o <<= 1) v = fmaxf(v, __shfl_xor(v, o));
    return v;
}
__device__ __forceinline__ float bf_lo(unsigned w) { return __builtin_bit_cast(float, w << 16); }
__device__ __forceinline__ float bf_hi(unsigned w) { return __builtin_bit_cast(float, w & 0xffff0000u); }
__device__ __forceinline__ float silu_f(float z) { return z / (1.0f + __expf(-z)); }

__device__ __forceinline__ void p0_transpose_item(const float* W, const float* g0, const float* g1, int ksplit, int K, int N, bf16* WT, LAS float* scr, int item, int lane) {
    const int nblk = N / 32, kb = item / nblk, nb = item % nblk, k0 = 64 * kb, n0 = 32 * nb;
#pragma unroll 8
    for (int i = 0; i < 32; ++i) { const int kk = 2 * i + (lane >> 5), k = k0 + kk; const float gv = (k < ksplit) ? g0[k] : g1[k - ksplit];
        scr[kk * 33 + (lane & 31)] = W[(size_t)k * N + n0 + (lane & 31)] * gv; }
    LDS_WAIT(); asm volatile("" ::: "memory");
    const int c = lane & 7;
#pragma unroll
    for (int j = 0; j < 4; ++j) { const int n = (lane >> 3) + 8 * j; const LAS float* s = scr + (8 * c) * 33 + n;
        v4u o; o.x = pk2(s[0 * 33], s[1 * 33]); o.y = pk2(s[2 * 33], s[3 * 33]); o.z = pk2(s[4 * 33], s[5 * 33]); o.w = pk2(s[6 * 33], s[7 * 33]);
        *(GAS v4u*)(WT + (size_t)(n0 + n) * K + k0 + 8 * c) = o; }
    LDS_WAIT(); asm volatile("" ::: "memory");
}
__device__ __forceinline__ void rms_row_to_bf16(Frame& F, const float* xrow, bf16* orow) {
    const GAS f32x4* xr = (const GAS f32x4*)xrow + F.lane;
    f32x4 v[8]; float s = 0.f;
#pragma unroll
    for (int j = 0; j < 8; ++j) { v[j] = xr[64 * j]; s += (v[j].x * v[j].x + v[j].y * v[j].y) + (v[j].z * v[j].z + v[j].w * v[j].w); }
    const float rs = 1.f / sqrtf(wave_sum(s) * (1.f / DM) + EPS);
    GAS unsigned long long* o8 = (GAS unsigned long long*)orow + F.lane;
#pragma unroll
    for (int j = 0; j < 8; ++j) o8[64 * j] = (unsigned long long)pk2(v[j].x * rs, v[j].y * rs) | ((unsigned long long)pk2(v[j].z * rs, v[j].w * rs) << 32);
}
__device__ __forceinline__ void p0_prologue(Frame& F) {
    LAS float* scr = (LAS float*)(F.lds + RING_OFF + F.wave * 16384);
    const int gw = F.vcu * NWAVES + F.wave, NGW = F.G * NWAVES;
    constexpr int I_IN = (DM / 64) * (DIN / 32), I_OUT = (DMIX / 64) * (DM / 32);
    for (int it = gw; it < I_IN + I_OUT; it += NGW) {
        if (it < I_IN) p0_transpose_item(F.w_in, F.norm_gain, F.norm_gain, DM, DM, DIN, F.WinT, scr, it, F.lane);
        else p0_transpose_item(F.w_out, F.cog, F.aog, DCONV, DMIX, DM, F.WoutT, scr, it - I_IN, F.lane);
    }
    for (int m = gw; m < M; m += NGW) rms_row_to_bf16(F, F.x + (size_t)m * DM, F.XN + (size_t)m * DM);
}

__device__ __forceinline__ void p2_qknorm(Frame& F) {
    LAS float* red = (LAS float*)(F.lds + RING_OFF);
    for (int u = F.vcu; u < 2 * BATCH * NH * NBLK; u += F.G) {
        const int which = u / (BATCH * NH * NBLK), r = u % (BATCH * NH * NBLK), b = r / (NH * NBLK), h = (r / NBLK) % NH, blk = r % NBLK;
        bf16* T = F.PROJ + (size_t)(which == 0 ? 5 : 4) * (PROJ_STRIDE / 2);
        const float* gain = which == 0 ? F.kg : F.qg;
        const float g0 = gain[2 * F.lane], g1 = gain[2 * F.lane + 1];
        float c0 = 0.f, c1 = 0.f;
        for (int i = 0; i < 32; ++i) {
            const size_t m = (size_t)b * SEQ + blk * MBLK + F.wave * 32 + i;
            GAS unsigned* p = (GAS unsigned*)(T + m * 1024 + h * HD) + F.lane;
            const unsigned w = *p; float v0 = bf_lo(w), v1 = bf_hi(w);
            const float rs = 1.f / sqrtf(wave_sum(v0 * v0 + v1 * v1) * (1.f / HD) + EPS);
            v0 = v0 * rs * g0; v1 = v1 * rs * g1; c0 += v0; c1 += v1;
            *p = pk2(v0, v1);
        }
        if (which == 0) {
            red[F.wave * 128 + 2 * F.lane] = c0; red[F.wave * 128 + 2 * F.lane + 1] = c1;
            LDS_WAIT(); __syncthreads();
            if (F.tid < 128) { float s = 0.f;
#pragma unroll
                for (int w = 0; w < 8; ++w) s += red[w * 128 + F.tid];
                F.KMEAN[(size_t)((b * NH + h) * NBLK + blk) * HD + F.tid] = s * (1.f / MBLK); }
            LDS_WAIT(); __syncthreads();
        }
    }
}
__device__ __forceinline__ void p2_conv(Frame& F) {
    const int gw = F.vcu * NWAVES + F.wave, NGW = F.G * NWAVES;
    const bf16* HC = F.PROJ; const bf16* BG = F.PROJ + PROJ_STRIDE / 2; const bf16* CG = F.PROJ + 2 * (PROJ_STRIDE / 2); const bf16* ZC = F.PROJ + 3 * (PROJ_STRIDE / 2);
    for (int m = gw; m < M; m += NGW) {
        const int t = m % SEQ;
        float yc[2][8]; float ss = 0.f;
#pragma unroll
        for (int j = 0; j < 2; ++j) {
            const int c = 8 * F.lane + 512 * j;
            float u0[8], u1[8], u2[8];
            { const v4u a = *(const GAS v4u*)(HC + (size_t)m * 1024 + c), g = *(const GAS v4u*)(CG + (size_t)m * 1024 + c);
              u0[0] = bf_lo(a.x) * bf_lo(g.x); u0[1] = bf_hi(a.x) * bf_hi(g.x); u0[2] = bf_lo(a.y) * bf_lo(g.y); u0[3] = bf_hi(a.y) * bf_hi(g.y);
              u0[4] = bf_lo(a.z) * bf_lo(g.z); u0[5] = bf_hi(a.z) * bf_hi(g.z); u0[6] = bf_lo(a.w) * bf_lo(g.w); u0[7] = bf_hi(a.w) * bf_hi(g.w); }
            if (t >= 1) { const v4u a = *(const GAS v4u*)(HC + (size_t)(m - 1) * 1024 + c), g = *(const GAS v4u*)(CG + (size_t)(m - 1) * 1024 + c);
              u1[0] = bf_lo(a.x) * bf_lo(g.x); u1[1] = bf_hi(a.x) * bf_hi(g.x); u1[2] = bf_lo(a.y) * bf_lo(g.y); u1[3] = bf_hi(a.y) * bf_hi(g.y);
              u1[4] = bf_lo(a.z) * bf_lo(g.z); u1[5] = bf_hi(a.z) * bf_hi(g.z); u1[6] = bf_lo(a.w) * bf_lo(g.w); u1[7] = bf_hi(a.w) * bf_hi(g.w); }
            else {
#pragma unroll
                for (int e = 0; e < 8; ++e) u1[e] = 0.f; }
            if (t >= 2) { const v4u a = *(const GAS v4u*)(HC + (size_t)(m - 2) * 1024 + c), g = *(const GAS v4u*)(CG + (size_t)(m - 2) * 1024 + c);
              u2[0] = bf_lo(a.x) * bf_lo(g.x); u2[1] = bf_hi(a.x) * bf_hi(g.x); u2[2] = bf_lo(a.y) * bf_lo(g.y); u2[3] = bf_hi(a.y) * bf_hi(g.y);
              u2[4] = bf_lo(a.z) * bf_lo(g.z); u2[5] = bf_hi(a.z) * bf_hi(g.z); u2[6] = bf_lo(a.w) * bf_lo(g.w); u2[7] = bf_hi(a.w) * bf_hi(g.w); }
            else {
#pragma unroll
                for (int e = 0; e < 8; ++e) u2[e] = 0.f; }
            const v4u bb = *(const GAS v4u*)(BG + (size_t)m * 1024 + c);
            float bv[8] = {bf_lo(bb.x), bf_hi(bb.x), bf_lo(bb.y), bf_hi(bb.y), bf_lo(bb.z), bf_hi(bb.z), bf_lo(bb.w), bf_hi(bb.w)};
#pragma unroll
            for (int e = 0; e < 8; ++e) { const float w0 = F.conv_w[c + e], w1 = F.conv_w[DCONV + c + e], w2 = F.conv_w[2 * DCONV + c + e];
                const float cv = w0 * u2[e] + w1 * u1[e] + w2 * u0[e]; const float y = bv[e] * cv; yc[j][e] = y; ss += y * y; }
        }
        const float rs = 1.f / sqrtf(wave_sum(ss) * (1.f / DCONV) + EPS);
#pragma unroll
        for (int j = 0; j < 2; ++j) {
            const int c = 8 * F.lane + 512 * j;
            const v4u zz = *(const GAS v4u*)(ZC + (size_t)m * 1024 + c);
            float zv[8] = {bf_lo(zz.x), bf_hi(zz.x), bf_lo(zz.y), bf_hi(zz.y), bf_lo(zz.z), bf_hi(zz.z), bf_lo(zz.w), bf_hi(zz.w)};
            float o[8];
#pragma unroll
            for (int e = 0; e < 8; ++e) o[e] = yc[j][e] * rs * silu_f(zv[e]);
            v4u w; w.x = pk2(o[0], o[1]); w.y = pk2(o[2], o[3]); w.z = pk2(o[4], o[5]); w.w = pk2(o[6], o[7]);
            *(GAS v4u*)(F.Y + (size_t)m * DMIX + c) = w;
        }
    }
}
__device__ __forceinline__ void p3_attn_naive(Frame& F) {
    LAS float* qs = (LAS float*)(F.lds + RING_OFF + F.wave * 1024);
    const bf16* Q = F.PROJ + 4 * (PROJ_STRIDE / 2); const bf16* K = F.PROJ + 5 * (PROJ_STRIDE / 2); const bf16* V = F.PROJ + 6 * (PROJ_STRIDE / 2);
    const int gw = F.vcu * NWAVES + F.wave, NGW = F.G * NWAVES;
    for (int it = gw; it < BATCH * NH * SEQ; it += NGW) {
        const int b = it / (NH * SEQ), h = (it / SEQ) % NH, t = it % SEQ, own = t / MBLK;
        const size_t mq = (size_t)b * SEQ + t;
        const unsigned qw = *((const GAS unsigned*)(Q + mq * 1024 + h * HD) + F.lane);
        const float q0 = bf_lo(qw), q1 = bf_hi(qw);
        qs[2 * F.lane] = q0; qs[2 * F.lane + 1] = q1;
        LDS_WAIT(); asm volatile("" ::: "memory");
        float gate[NBLK];
#pragma unroll
        for (int n = 0; n < NBLK; ++n) {
            gate[n] = -INFINITY;
            if (n < own) { const float* km = F.KMEAN + (size_t)((b * NH + h) * NBLK + n) * HD; gate[n] = wave_sum(q0 * km[2 * F.lane] + q1 * km[2 * F.lane + 1]); }
        }
        unsigned sel = 0;
#pragma unroll
        for (int n = 0; n < NBLK; ++n) {
            if (n < own) { int rank = 0;
#pragma unroll
                for (int n2 = 0; n2 < NBLK; ++n2) if (n2 != n && n2 < own) rank += (gate[n2] > gate[n] || (gate[n2] == gate[n] && n2 < n)) ? 1 : 0;
                if (rank < TOPK) sel |= 1u << n; }
        }
        sel |= 1u << own;
        float s[NBLK][4];
        float mx = -INFINITY;
#pragma unroll
        for (int n = 0; n < NBLK; ++n)
#pragma unroll
            for (int g = 0; g < 4; ++g) {
                s[n][g] = -INFINITY;
                if ((sel >> n) & 1u) {
                    const int j = n * MBLK + g * 64 + F.lane;
                    const GAS v4u* kr = (const GAS v4u*)(K + ((size_t)b * SEQ + j) * 1024 + h * HD);
                    float acc = 0.f;
#pragma unroll 4
                    for (int c = 0; c < 16; ++c) { const v4u kk = kr[c]; const LAS f32x4* qq = (const LAS f32x4*)(qs + 8 * c); const f32x4 qa = qq[0], qb = qq[1];
                        acc += bf_lo(kk.x) * qa.x + bf_hi(kk.x) * qa.y + bf_lo(kk.y) * qa.z + bf_hi(kk.y) * qa.w + bf_lo(kk.z) * qb.x + bf_hi(kk.z) * qb.y + bf_lo(kk.w) * qb.z + bf_hi(kk.w) * qb.w; }
                    acc *= SM_SCALE;
                    if (j <= t) { s[n][g] = acc; mx = fmaxf(mx, acc); }
                }
            }
        mx = wave_max(mx);
        float l = 0.f;
#pragma unroll
        for (int n = 0; n < NBLK; ++n)
#pragma unroll
            for (int g = 0; g < 4; ++g) { const float p = __expf(s[n][g] - mx); s[n][g] = p; l += p; }
        l = wave_sum(l);
        float o0 = 0.f, o1 = 0.f;
#pragma unroll
        for (int n = 0; n < NBLK; ++n)
#pragma unroll
            for (int g = 0; g < 4; ++g) {
                if (((sel >> n) & 1u) && (n * MBLK + g * 64 <= t)) {
                    const GAS unsigned* vr = (const GAS unsigned*)(V + ((size_t)b * SEQ + n * MBLK + g * 64) * 1024 + h * HD) + F.lane;
#pragma unroll 8
                    for (int jj = 0; jj < 64; ++jj) { const float p = __shfl(s[n][g], jj); const unsigned vw = vr[(size_t)jj * 512]; o0 += p * bf_lo(vw); o1 += p * bf_hi(vw); }
                }
            }
        const float il = 1.f / l;
        typedef float f32x2g __attribute__((ext_vector_type(2)));
        *((GAS f32x2g*)(F.ARAW + mq * DATTN + h * HD) + F.lane) = (f32x2g){o0 * il, o1 * il};
        LDS_WAIT(); asm volatile("" ::: "memory");
    }
}
__device__ __forceinline__ void p4_attn_norm(Frame& F) {
    const int gw = F.vcu * NWAVES + F.wave, NGW = F.G * NWAVES;
    const bf16* ZA = F.PROJ + 7 * (PROJ_STRIDE / 2);
    for (int m = gw; m < M; m += NGW) {
        f32x4 v[4]; float ss = 0.f;
#pragma unroll
        for (int j = 0; j < 4; ++j) { v[j] = *((const GAS f32x4*)(F.ARAW + (size_t)m * DATTN) + F.lane + 64 * j); ss += (v[j].x * v[j].x + v[j].y * v[j].y) + (v[j].z * v[j].z + v[j].w * v[j].w); }
        const float rs = 1.f / sqrtf(wave_sum(ss) * (1.f / DATTN) + EPS);
#pragma unroll
        for (int j = 0; j < 4; ++j) {
            const int c = 4 * F.lane + 256 * j;
            const unsigned long long zz = *(const GAS unsigned long long*)(ZA + (size_t)m * 1024 + c);
            const unsigned z01 = (unsigned)zz, z23 = (unsigned)(zz >> 32);
            const float o0 = v[j].x * rs * silu_f(bf_lo(z01)), o1 = v[j].y * rs * silu_f(bf_hi(z01)), o2 = v[j].z * rs * silu_f(bf_lo(z23)), o3 = v[j].w * rs * silu_f(bf_hi(z23));
            *(GAS unsigned long long*)(F.Y + (size_t)m * DMIX + DCONV + c) = (unsigned long long)pk2(o0, o1) | ((unsigned long long)pk2(o2, o3) << 32);
        }
    }
}

struct Args { const float* in[9]; float* out; unsigned char* ws; int ph_lo, ph_hi, li, pad; };
__global__ void __launch_bounds__(NWAVES * 64, 2) skel_fwd(Args args) {
    extern __shared__ __attribute__((aligned(16))) unsigned char lds[];
    Frame F;
    F.lds = (LAS unsigned char*)lds;
    F.MISC = (volatile LAS unsigned*)(F.lds + MISC_OFF);
    F.tid = threadIdx.x; F.lane = F.tid & 63; F.wave = __builtin_amdgcn_readfirstlane(F.tid >> 6);
    F.G = gridDim.x; { const int bx = blockIdx.x; F.vcu = (F.G % 8 == 0) ? (bx % 8) * (F.G / 8) + bx / 8 : bx; }
#define GRID_BAR(seam) do { if (!ONE_LAUNCH) { if (F.tid == 0) __hip_atomic_store(F.ctl + CW_TMO, 0xBADBA0u | (unsigned)(seam), RLX_AGENT); } \
    else { xcd_barrier(bar); } } while (0)
    unsigned char* ws = args.ws;
    F.ctl = (gu32*)(ws + WS_CTL);
    F.x = args.in[0]; F.norm_gain = args.in[1]; F.w_in = args.in[2]; F.conv_w = args.in[3]; F.qg = args.in[4]; F.kg = args.in[5];
    F.cog = args.in[6]; F.aog = args.in[7]; F.w_out = args.in[8]; F.out = args.out;
    F.WinT = (bf16*)(ws + WS_WIN); F.WoutT = (bf16*)(ws + WS_WOUT); F.XN = (bf16*)(ws + WS_XN); F.PROJ = (bf16*)(ws + WS_PROJ); F.Y = (bf16*)(ws + WS_Y);
    F.KMEAN = (float*)(ws + WS_KMEAN); F.ARAW = (float*)(ws + WS_ARAW);
    for (int u = F.tid; u < (LDS_BYTES - LDSCTL_OFF) / 4; u += NWAVES * 64) ((LAS unsigned*)(F.lds + LDSCTL_OFF))[u] = 0u;
    __syncthreads();
    XcdBarrier bar; bar.bar = (unsigned*)(F.ctl + CW_BAR); bar.x = 0; bar.st = nullptr;
    if (ONE_LAUNCH) bar = xcd_barrier_post((unsigned*)(F.ctl + CW_BAR), F.MISC + 8);

    const int lo = args.ph_lo, hi = args.ph_hi;
#define IN(k) (lo <= (k) && (k) < hi)
#define BOTH(k) (IN(k) && IN((k) + 1))

    if (IN(0)) { p0_prologue(F); if (BOTH(0)) GRID_BAR(0); }

    if (IN(1)) {
        pg8::Gemm g{F.XN, F.WinT, M, DIN, DM}; pg8::StaticOrder S; S.init(M, DIN, F.G, (int)blockIdx.x);
        pg8::EpiBf16<0> E{F.PROJ, 1024, nullptr, 1024, PROJ_STRIDE / 2, 1.0f};
        pg8::gemm_phase<pg8::EpiBf16<0>, pg8::StaticOrder, PG8_ALIGN, PG8_SP2>(F.lds + RING_OFF, g, S, E);
        if (BOTH(1)) GRID_BAR(1);
    }
    if (IN(2)) { p2_qknorm(F); p2_conv(F); if (BOTH(2)) GRID_BAR(2); }
    if (IN(3)) { p3_attn_naive(F); if (BOTH(3)) GRID_BAR(3); }
    if (IN(4)) { p4_attn_norm(F); if (BOTH(4)) GRID_BAR(4); }
    if (IN(5)) {
        pg8::Gemm g{F.Y, F.WoutT, M, DM, DMIX}; pg8::StaticOrder S; S.init(M, DM, F.G, (int)blockIdx.x);
        pg8::EpiResF32 E{F.x, F.out, DM};
        pg8::gemm_phase<pg8::EpiResF32, pg8::StaticOrder, PG8_ALIGN, PG8_SP2>(F.lds + RING_OFF, g, S, E);
    }
#undef IN
#undef BOTH
}

extern "C" void kernel_launch(void* const* d_in, const int* in_sizes, int n_in, void* d_out, int out_size, void* d_ws, size_t ws_size, hipStream_t stream) {
    static int grid = 0;
    if (grid == 0) {
        if (n_in != 9 || in_sizes[0] != M * DM || out_size != M * DM || ws_size < WS_END) { fprintf(stderr, "kernel_launch: shape/workspace mismatch (n_in %d, in0 %d, out %d, ws %zu)\n", n_in, n_in > 0 ? in_sizes[0] : -1, out_size, ws_size); grid = -1; return; }
        int dev = 0, cus = 0;
        if (hipGetDevice(&dev) != hipSuccess || hipDeviceGetAttribute(&cus, hipDeviceAttributeMultiprocessorCount, dev) != hipSuccess) { fprintf(stderr, "kernel_launch: device query failed\n"); grid = -1; return; }
        if (hipFuncSetAttribute((const void*)skel_fwd, hipFuncAttributeMaxDynamicSharedMemorySize, LDS_BYTES) != hipSuccess) { fprintf(stderr, "kernel_launch: hipFuncSetAttribute failed\n"); grid = -1; return; }
        (void)hipGetLastError();
        grid = cus;
    }
    if (grid < 0) return;
    if (hipMemsetAsync((char*)d_ws + WS_CTL, 0, CTL_ZERO_BYTES, stream) != hipSuccess) { fprintf(stderr, "kernel_launch: hipMemsetAsync failed\n"); return; }
    Args a{};
    for (int i = 0; i < 9; ++i) a.in[i] = (const float*)d_in[i];
    a.out = (float*)d_out; a.ws = (unsigned char*)d_ws;
    if (ONE_LAUNCH) {
        a.ph_lo = 0; a.ph_hi = PER_PHASE; a.li = 0;
        hipLaunchKernelGGL(skel_fwd, dim3(grid), dim3(NWAVES * 64), LDS_BYTES, stream, a);
    } else {
        for (int li = 0; li < PER_PHASE; ++li) { a.ph_lo = li; a.ph_hi = li + 1; a.li = li;
            hipLaunchKernelGGL(skel_fwd, dim3(grid), dim3(NWAVES * 64), LDS_BYTES, stream, a); }
    }
}
```

```cpp
#define MK_NF8 6
#define MK_FP8_OUT 0
#define MK_HYB 2
#include <hip/hip_runtime.h>
#include <cstdio>
#include <cstdint>
namespace pg8 {
#define PG8_LAS __attribute__((address_space(3)))
typedef unsigned short bf16_t;
typedef short bf16x8 __attribute__((ext_vector_type(8)));
typedef float f32x4 __attribute__((ext_vector_type(4)));
typedef unsigned u32x4 __attribute__((ext_vector_type(4)));
constexpr int BM = 256, BK = 64, HALF = 128, HTB = HALF * BK * 2  , STAGE_BYTES = 8 * HTB, NXCD = 8, WGM = 8;

__host__ __device__ __forceinline__ int lds_byte(int r, int c) { const int st = (r >> 4) * 2 + (c >> 5), rr = r & 15, cc = c & 31, ob = rr * 64 + cc * 2; return st * 1024 + (ob ^ (((ob >> 9) & 1) << 5)); }
__host__ __device__ __forceinline__ void stage_rc(int b, int& R, int& C) { const int st = b / 1024, sb = b % 1024, swz = sb ^ (((sb >> 9) & 1) << 5); R = (st >> 1) * 16 + swz / 64; C = (st & 1) * 32 + (swz % 64) / 2; }
__host__ __device__ __forceinline__ int perm32(int rho) { const int n = rho >> 4, i = rho & 15; return 8 * (i >> 2) + 4 * n + (i & 3); }

struct Unit { int pm, pn; };
struct Gemm { const bf16_t* A; const bf16_t* Bt; int M, N, K; };

struct StaticOrder {
    int nM, nN, nwg, G, c;
    __host__ __device__ void init(int M, int N, int G_, int c_) { nM = M / BM; nN = N / BM; nwg = nM * nN; G = G_; c = c_; }
    __host__ __device__ bool next(int i, Unit& u) const {
        const long L = (long)i * G + c; if (L >= nwg) return false;
        int wgid = (int)L; { const int q = nwg / NXCD, r = nwg % NXCD, xcd = wgid % NXCD, off = wgid / NXCD; wgid = (xcd < r ? xcd * (q + 1) : r * (q + 1) + (xcd - r) * q) + off; }
        const int nig = WGM * nN, gid = wgid / nig, fm = gid * WGM, gsz = (nM - fm) < WGM ? (nM - fm) : WGM;
        u.pm = fm + ((wgid % nig) % gsz); u.pn = (wgid % nig) / gsz; return true;
    }
    __device__ __forceinline__ void a_ready(const Unit&) const {}
    __device__ __forceinline__ void done(const Unit&) const {}
};

__device__ __forceinline__ unsigned cvt_pk_bf16(float lo, float hi) { unsigned r; asm volatile("v_cvt_pk_bf16_f32 %0, %1, %2" : "=v"(r) : "v"(lo), "v"(hi)); return r; }

typedef float f32x2 __attribute__((ext_vector_type(2)));
struct EpiProj {
    static constexpr bool PERM = true, AFTER_DRAIN = false, MID = false, INIT = false;
    bf16_t* O; size_t tstride; const float* qg; const float* kg; float* kmean; PG8_LAS unsigned char* xl; float eps; int pn_off; unsigned order; float oscale;
    __device__ __forceinline__ void operator()(const f32x4 (&acc)[2][2][4][2], const Unit& u, int wr, int wc, int fr_, int fq_, int wid, int lane) const {
        asm volatile("" : "+v"(lane));
        const int fr = lane & 15, fq = lane >> 4;
        const int lt = u.pn + pn_off, t = (int)((order >> (4 * (lt >> 2))) & 15u), colw = (lt & 3) * BM;
        const int row0 = u.pm * BM + wr * 64 + fr;
        if (lt >= 16 && lt < 24) {
            bf16_t* pb = O + (size_t)row0 * 1024 + (lt & 7) * 128 + wc * 32 + 8 * fq;
            const float os2 = oscale * oscale;
#pragma unroll
            for (int ai = 0; ai < 2; ++ai)
#pragma unroll
                for (int m = 0; m < 4; ++m) { const f32x4 r0 = acc[ai][0][m][0] * acc[ai][1][m][0] * os2, r1 = acc[ai][0][m][1] * acc[ai][1][m][1] * os2;
                    u32x4 w; w.x = cvt_pk_bf16(r0[0], r0[1]); w.y = cvt_pk_bf16(r0[2], r0[3]); w.z = cvt_pk_bf16(r1[0], r1[1]); w.w = cvt_pk_bf16(r1[2], r1[3]);
                    *(u32x4*)(pb + (size_t)(ai * HALF + m * 16) * 1024) = w; }
            return;
        }
        bf16_t* base = O + (size_t)t * tstride;
        const int col0 = colw + wc * 32 + 8 * fq;
        const size_t hm0 = ((size_t)((u.pm >> 3) * 8 + (colw >> 7)) * 2048 + (size_t)((u.pm & 7) * BM + wr * 64 + fr)) * 128 + wc * 32 + 8 * fq;
        if (t != 4 && t != 5) {
#pragma unroll
            for (int ai = 0; ai < 2; ++ai)
#pragma unroll
                for (int m = 0; m < 4; ++m) { bf16_t* rowp = (t == 6) ? base + hm0 + (size_t)(ai * HALF + m * 16) * 128 : base + (size_t)(row0 + ai * HALF + m * 16) * 1024 + col0;
#pragma unroll
                    for (int bj = 0; bj < 2; ++bj) { const f32x4 v0 = acc[ai][bj][m][0] * oscale, v1 = acc[ai][bj][m][1] * oscale;
                        u32x4 w; w.x = cvt_pk_bf16(v0[0], v0[1]); w.y = cvt_pk_bf16(v0[2], v0[3]); w.z = cvt_pk_bf16(v1[0], v1[1]); w.w = cvt_pk_bf16(v1[2], v1[3]);
                        *(u32x4*)(rowp + ((t == 6) ? (size_t)bj * 2048 * 128 : (size_t)bj * HALF)) = w; } }
            return;
        }
        PG8_LAS float* P = (PG8_LAS float*)xl;
        PG8_LAS float* CS = (PG8_LAS float*)(xl + 8192);
        const float* gp = (t == 4 ? qg : kg) + wc * 32 + 8 * fq;
        const f32x4 g0 = *(const f32x4*)gp, g1 = *(const f32x4*)(gp + 4);
#pragma unroll
        for (int ai = 0; ai < 2; ++ai)
#pragma unroll
            for (int m = 0; m < 4; ++m)
#pragma unroll
                for (int bj = 0; bj < 2; ++bj) { const f32x4 a = acc[ai][bj][m][0], b = acc[ai][bj][m][1];
                    float s = ((a[0] * a[0] + a[1] * a[1]) + (a[2] * a[2] + a[3] * a[3])) + ((b[0] * b[0] + b[1] * b[1]) + (b[2] * b[2] + b[3] * b[3]));
                    s += __shfl_xor(s, 16); s += __shfl_xor(s, 32);
                    if (fq == 0) P[(ai * HALF + wr * 64 + m * 16 + fr) * 8 + bj * 4 + wc] = s; }
        asm volatile("s_waitcnt lgkmcnt(0)" ::: "memory"); __builtin_amdgcn_s_barrier(); asm volatile("" ::: "memory");
        f32x4 cs[2][2];
#pragma unroll
        for (int bj = 0; bj < 2; ++bj) { cs[bj][0] = (f32x4){0.f, 0.f, 0.f, 0.f}; cs[bj][1] = (f32x4){0.f, 0.f, 0.f, 0.f}; }
#pragma unroll
        for (int ai = 0; ai < 2; ++ai)
#pragma unroll
            for (int m = 0; m < 4; ++m) { const int rl = ai * HALF + wr * 64 + m * 16 + fr; bf16_t* rowp = base + hm0 + (size_t)(ai * HALF + m * 16) * 128;
#pragma unroll
                for (int bj = 0; bj < 2; ++bj) { const f32x4 p4 = *(const PG8_LAS f32x4*)(P + rl * 8 + bj * 4);
                    const float rs = 1.0f / sqrtf(((p4[0] + p4[1]) + (p4[2] + p4[3])) * (1.0f / 128.0f) + eps);
                    const f32x4 v0 = acc[ai][bj][m][0] * rs * g0, v1 = acc[ai][bj][m][1] * rs * g1;
                    cs[bj][0] += v0; cs[bj][1] += v1; asm volatile("" : "+v"(cs[bj][0]), "+v"(cs[bj][1]));
                    u32x4 w; w.x = cvt_pk_bf16(v0[0], v0[1]); w.y = cvt_pk_bf16(v0[2], v0[3]); w.z = cvt_pk_bf16(v1[0], v1[1]); w.w = cvt_pk_bf16(v1[2], v1[3]);
                    *(u32x4*)(rowp + (size_t)bj * 2048 * 128) = w; } }
        if (t == 5) {
#pragma unroll
            for (int bj = 0; bj < 2; ++bj)
#pragma unroll
                for (int n = 0; n < 2; ++n)
#pragma unroll
                    for (int e = 0; e < 4; ++e) { float s = cs[bj][n][e]; s += __shfl_xor(s, 1); s += __shfl_xor(s, 2); s += __shfl_xor(s, 4); s += __shfl_xor(s, 8); cs[bj][n][e] = s; }
            if (fr == 0) {
#pragma unroll
                for (int bj = 0; bj < 2; ++bj)
#pragma unroll
                    for (int n = 0; n < 2; ++n) *(PG8_LAS f32x4*)(CS + wr * 256 + bj * HALF + wc * 32 + 8 * fq + 4 * n) = cs[bj][n]; }
            asm volatile("s_waitcnt lgkmcnt(0)" ::: "memory"); __builtin_amdgcn_s_barrier(); asm volatile("" ::: "memory");
            const int tid = wid * 64 + lane;
            if (tid < 256) { const int b = u.pm >> 3, blk = u.pm & 7, head = (colw >> 7) + (tid >> 7);
                kmean[(size_t)((b * 8 + head) * 8 + blk) * 128 + (tid & 127)] = (CS[tid] + CS[256 + tid]) * (1.0f / 256.0f); }
        }
    }
};
struct EpiOut {
    static constexpr bool PERM = false, AFTER_DRAIN = false, MID = true, INIT = true;
    const bf16_t* xn; const float* xrs; float* out; int ldc;
     const float* ssq; float eps; PG8_LAS float* rrs; float fin, midk;
    __device__ __forceinline__ void mid(f32x4 (&acc)[2][2][4][2], const Unit& u, int wr, int wc, int fr, int fq) const {
        asm volatile("" : "+v"(fr));
        if (__builtin_amdgcn_readfirstlane(__builtin_bit_cast(int, rrs[512])) == u.pm) {
#pragma unroll
            for (int ai = 0; ai < 2; ++ai)
#pragma unroll
                for (int m = 0; m < 4; ++m) { const float s = rrs[256 + ai * HALF + wr * 64 + m * 16 + fr];
#pragma unroll
                    for (int bj = 0; bj < 2; ++bj)
#pragma unroll
                        for (int n = 0; n < 2; ++n) acc[ai][bj][m][n] *= s; }
            return;
        }
        if (wr == 0 && wc == 0 && fr == 0 && fq == 0) rrs[512] = __builtin_bit_cast(float, -1);
        const int row0 = u.pm * BM + wr * 64 + fr;
        f32x4 sa[2][4], sb[2][4];
#pragma unroll
        for (int ai = 0; ai < 2; ++ai)
#pragma unroll
            for (int m = 0; m < 4; ++m) { const float* sp = ssq + (size_t)(row0 + ai * HALF + m * 16) * 8; sa[ai][m] = *(const f32x4*)sp; sb[ai][m] = *(const f32x4*)(sp + 4); }
#pragma unroll
        for (int ai = 0; ai < 2; ++ai)
#pragma unroll
            for (int m = 0; m < 4; ++m) { const f32x4 a = sa[ai][m], b = sb[ai][m];
                const float v = (((a[0] + a[1]) + (a[2] + a[3])) + ((b[0] + b[1]) + (b[2] + b[3]))) * (1.0f / 1024.0f) + eps;
                const float s0 = sqrtf(v), s = s0 * midk;
                if (wc == 0 && fq == 0) rrs[ai * HALF + wr * 64 + m * 16 + fr] = fin / s0;
#pragma unroll
                for (int bj = 0; bj < 2; ++bj)
#pragma unroll
                    for (int n = 0; n < 2; ++n) acc[ai][bj][m][n] *= s; }
    }
    typedef unsigned u32x2 __attribute__((ext_vector_type(2)));
    __device__ __forceinline__ void init(f32x4 (&acc)[2][2][4][2], const Unit& u, int wr, int wc, int lane) const {
        asm volatile("" : "+v"(lane));
        const int fr = lane & 15, fq = lane >> 4;
        const int row0 = u.pm * BM + wr * 64 + fr, col0 = u.pn * BM + wc * 32 + 4 * fq; const float ik = 1.0f / (midk * fin);
#pragma unroll
        for (int g = 0; g < 8; ++g) { const int row = row0 + (g >> 2) * HALF + (g & 3) * 16; const float xs = xrs[row] * ik; const size_t off = (size_t)row * ldc + col0;
#pragma unroll
            for (int bj = 0; bj < 2; ++bj)
#pragma unroll
                for (int n = 0; n < 2; ++n) { const u32x2 w = *(const u32x2*)(xn + off + bj * HALF + n * 16);
                    acc[g >> 2][bj][g & 3][n] = (f32x4){__builtin_bit_cast(float, w.x << 16), __builtin_bit_cast(float, w.x & 0xffff0000u), __builtin_bit_cast(float, w.y << 16), __builtin_bit_cast(float, w.y & 0xffff0000u)} * xs; } }
        f32x4 sa[8], sb[8];
#pragma unroll
        for (int g = 0; g < 8; ++g) { const float* sp = ssq + (size_t)(row0 + (g >> 2) * HALF + (g & 3) * 16) * 8; sa[g] = *(const f32x4*)sp; sb[g] = *(const f32x4*)(sp + 4); }
#pragma unroll
        for (int g = 0; g < 8; ++g) { const f32x4 a = sa[g], b = sb[g];
            const float v = (((a[0] + a[1]) + (a[2] + a[3])) + ((b[0] + b[1]) + (b[2] + b[3]))) * (1.0f / 1024.0f) + eps; const float s0 = sqrtf(v);
            if (wc == 0 && fq == 0) { const int rl = (g >> 2) * HALF + wr * 64 + (g & 3) * 16 + fr; rrs[rl] = fin / s0; rrs[256 + rl] = s0 * midk; } }
        if (wr == 0 && wc == 0 && fr == 0 && fq == 0) rrs[512] = __builtin_bit_cast(float, u.pm);
    }
    __device__ __forceinline__ void operator()(f32x4 (&acc)[2][2][4][2], const Unit& u, int wr, int wc, int fr_, int fq_, int wid, int lane, bool has_next, const Unit& nx) const {
        asm volatile("" : "+v"(lane));
        const int fr = lane & 15, fq = lane >> 4;
        const int row0 = u.pm * BM + wr * 64 + fr, col0 = u.pn * BM + wc * 32 + 4 * fq;
        u32x2 xb[8][2][2]; float xs[8], rr[8];
        if (has_next) {
            const int rowN = nx.pm * BM + wr * 64 + fr, colN = nx.pn * BM + wc * 32 + 4 * fq;
#pragma unroll
            for (int g = 0; g < 8; ++g) { const float* sp = xrs + rowN + (g >> 2) * HALF + (g & 3) * 16; asm volatile("global_load_dword %0, %1, off" : "=v"(xs[g]) : "v"(sp) : "memory"); }
#pragma unroll
            for (int g = 0; g < 8; ++g) { const bf16_t* bp = xn + (size_t)(rowN + (g >> 2) * HALF + (g & 3) * 16) * ldc + colN;
#pragma unroll
                for (int bj = 0; bj < 2; ++bj)
#pragma unroll
                    for (int n = 0; n < 2; ++n) { const bf16_t* lp = bp + bj * HALF + n * 16; asm volatile("global_load_dwordx2 %0, %1, off" : "=v"(xb[g][bj][n]) : "v"(lp) : "memory"); } }
        }
#pragma unroll
        for (int g = 0; g < 8; ++g) rr[g] = rrs[(g >> 2) * HALF + wr * 64 + (g & 3) * 16 + fr];
#pragma unroll
        for (int g = 0; g < 8; ++g) { const size_t off = (size_t)(row0 + (g >> 2) * HALF + (g & 3) * 16) * ldc + col0;
#pragma unroll
            for (int bj = 0; bj < 2; ++bj)
#pragma unroll
                for (int n = 0; n < 2; ++n) *(f32x4*)(out + off + bj * HALF + n * 16) = acc[g >> 2][bj][g & 3][n] * rr[g]; }
        if (has_next) {
            asm volatile("s_waitcnt vmcnt(32)" : "+v"(xs[0]), "+v"(xs[1]), "+v"(xs[2]), "+v"(xs[3]), "+v"(xs[4]), "+v"(xs[5]), "+v"(xs[6]), "+v"(xs[7]),
                         "+v"(xb[0][0][0]), "+v"(xb[0][0][1]), "+v"(xb[0][1][0]), "+v"(xb[0][1][1]), "+v"(xb[1][0][0]), "+v"(xb[1][0][1]), "+v"(xb[1][1][0]), "+v"(xb[1][1][1]),
                         "+v"(xb[2][0][0]), "+v"(xb[2][0][1]), "+v"(xb[2][1][0]), "+v"(xb[2][1][1]) :: "memory");
            asm volatile("" : "+v"(xb[3][0][0]), "+v"(xb[3][0][1]), "+v"(xb[3][1][0]), "+v"(xb[3][1][1]), "+v"(xb[4][0][0]), "+v"(xb[4][0][1]), "+v"(xb[4][1][0]), "+v"(xb[4][1][1]),
                         "+v"(xb[5][0][0]), "+v"(xb[5][0][1]), "+v"(xb[5][1][0]), "+v"(xb[5][1][1]), "+v"(xb[6][0][0]), "+v"(xb[6][0][1]), "+v"(xb[6][1][0]), "+v"(xb[6][1][1]),
                         "+v"(xb[7][0][0]), "+v"(xb[7][0][1]), "+v"(xb[7][1][0]), "+v"(xb[7][1][1]) :: "memory");
            const float ik = 1.0f / (midk * fin);
#pragma unroll
            for (int g = 0; g < 8; ++g) { const float xsk = xs[g] * ik;
#pragma unroll
                for (int bj = 0; bj < 2; ++bj)
#pragma unroll
                    for (int n = 0; n < 2; ++n) { const u32x2 w = xb[g][bj][n];
                        acc[g >> 2][bj][g & 3][n] = (f32x4){__builtin_bit_cast(float, w.x << 16), __builtin_bit_cast(float, w.x & 0xffff0000u), __builtin_bit_cast(float, w.y << 16), __builtin_bit_cast(float, w.y & 0xffff0000u)} * xsk; } }
        }
    }
};

typedef int i32x4 __attribute__((ext_vector_type(4)));
typedef int i32x8 __attribute__((ext_vector_type(8)));
__device__ __forceinline__ i32x8 cat8(bf16x8 lo, bf16x8 hi) { const i32x4 a = __builtin_bit_cast(i32x4, lo), b = __builtin_bit_cast(i32x4, hi); return __builtin_shufflevector(a, b, 0, 1, 2, 3, 4, 5, 6, 7); }

#ifndef PG8_FP8ASM
#define PG8_FP8ASM 1
#endif
constexpr bool FP8ASM = (PG8_FP8ASM != 0);
template <class Epi, class Sched, bool ALIGN_EPI = false, bool SP2 = false, bool FP8 = false, int HYBP = 0>
__device__ __forceinline__ void gemm_phase(PG8_LAS unsigned char* lds, const Gemm g, const Sched& S, const Epi& E) {
    const int tid = threadIdx.x, wid = __builtin_amdgcn_readfirstlane(tid >> 6), lane = tid & 63, wr = wid >> 2, wc = wid & 3, fr = lane & 15, fq = lane >> 4;
    const int K = g.K, nt = K / BK;
    unsigned voffA[2], voffB[2];
#pragma unroll
    for (int i = 0; i < 2; ++i) { int R, C; stage_rc(tid * 16 + i * 8192, R, C); const int Rb = Epi::PERM ? ((R & ~31) + perm32(R & 31)) : R;
        voffA[i] = (unsigned)(R * K + C) * 2u; voffB[i] = (unsigned)(Rb * K + C) * 2u; }
    const size_t kstep = (size_t)(BK * 2);
    const size_t hstep = (size_t)HALF * K * 2;
    const size_t tstep = 2 * hstep;
    const unsigned ldsw = (unsigned)wid * 1024u;
    const int aoff = lds_byte(wr * 64 + fr, fq * 8), boff = lds_byte(wc * 32 + fr, fq * 8);
#define PG8_SA(b, h) (((b) * 2 + (h)) * HTB)
#define PG8_SB(b, h) ((4 + (b) * 2 + (h)) * HTB)
#define PG8_STAGE(bufoff, gbase, voff) do { _Pragma("unroll") for (int _i = 0; _i < 2; ++_i) \
        __builtin_amdgcn_global_load_lds((const unsigned*)((const char*)(gbase) + (voff)[_i]), (PG8_LAS unsigned*)(lds + (bufoff) + ldsw + _i * 8192), 16, 0, 0); } while (0)
#define PG8_LDA_(F8c, dst, b, h) do { if constexpr (F8c) { _Pragma("unroll") for (int m = 0; m < 4; ++m) dst##F[m] = cat8(*(const PG8_LAS bf16x8*)(lds + PG8_SA(b, h) + aoff + m * 2048), *(const PG8_LAS bf16x8*)(lds + PG8_SA(b, h) + aoff + m * 2048 + 1024)); } \
        else { _Pragma("unroll") for (int m = 0; m < 4; ++m) _Pragma("unroll") for (int k = 0; k < 2; ++k) dst[m][k] = *(const PG8_LAS bf16x8*)(lds + PG8_SA(b, h) + aoff + m * 2048 + k * 1024); } } while (0)
#define PG8_LDB_(F8c, dst, b, h) do { if constexpr (F8c) { _Pragma("unroll") for (int n = 0; n < 2; ++n) dst##F[n] = cat8(*(const PG8_LAS bf16x8*)(lds + PG8_SB(b, h) + boff + n * 2048), *(const PG8_LAS bf16x8*)(lds + PG8_SB(b, h) + boff + n * 2048 + 1024)); } \
        else { _Pragma("unroll") for (int n = 0; n < 2; ++n) _Pragma("unroll") for (int k = 0; k < 2; ++k) dst[n][k] = *(const PG8_LAS bf16x8*)(lds + PG8_SB(b, h) + boff + n * 2048 + k * 1024); } } while (0)
#define PG8_MMA_(F8c, ai, bj, At, Bt) do { __builtin_amdgcn_s_setprio(1); _Pragma("unroll") for (int m = 0; m < 4; ++m) _Pragma("unroll") for (int n = 0; n < 2; ++n) { \
        if constexpr (F8c) { if constexpr (FP8ASM) asm volatile("v_mfma_f32_16x16x128_f8f6f4 %0, %1, %2, %0" : "+v"(acc[ai][bj][m][n]) : "v"(Bt##F[n]), "v"(At##F[m])); \
            else acc[ai][bj][m][n] = __builtin_amdgcn_mfma_scale_f32_16x16x128_f8f6f4(Bt##F[n], At##F[m], acc[ai][bj][m][n], 0, 0, 0, 0, 0, 0); } \
        else { _Pragma("unroll") for (int k = 0; k < 2; ++k) acc[ai][bj][m][n] = __builtin_amdgcn_mfma_f32_16x16x32_bf16(Bt[n][k], At[m][k], acc[ai][bj][m][n], 0, 0, 0); } } \
        __builtin_amdgcn_s_setprio(0); } while (0)
#define PG8_LDA(dst, b, h) PG8_LDA_(FP8, dst, b, h)
#define PG8_LDB(dst, b, h) PG8_LDB_(FP8, dst, b, h)
#define PG8_MMA(ai, bj, At, Bt) PG8_MMA_(FP8, ai, bj, At, Bt)
#define PG8_WAIT_V(n) asm volatile("s_waitcnt vmcnt(" #n ")" ::: "memory")
#define PG8_WAIT_L(n) asm volatile("s_waitcnt lgkmcnt(" #n ")" ::: "memory")
#define PG8_BAR __builtin_amdgcn_s_barrier()
#define PG8_SCHED __builtin_amdgcn_sched_barrier(0)
#define PG8_ITER_SP2(F8c) do { \
            PG8_LDB_(F8c, B0, 0, 0); PG8_LDB_(F8c, B1, 0, 1); PG8_SCHED; PG8_LDA_(F8c, At, 0, 0); PG8_STAGE(PG8_SA(1, 1), a1 + hstep, voffA); \
            PG8_WAIT_V(8); PG8_WAIT_L(0); PG8_BAR; PG8_MMA_(F8c, 0, 0, At, B0); PG8_MMA_(F8c, 0, 1, At, B1); PG8_BAR; PG8_SCHED; \
            PG8_LDA_(F8c, At, 0, 1); PG8_STAGE(PG8_SB(0, 0), b2, voffB); PG8_STAGE(PG8_SB(0, 1), b2 + hstep, voffB); PG8_STAGE(PG8_SA(0, 0), a2, voffA); \
            PG8_WAIT_V(8); PG8_WAIT_L(0); PG8_BAR; PG8_MMA_(F8c, 1, 0, At, B0); PG8_MMA_(F8c, 1, 1, At, B1); PG8_BAR; PG8_SCHED; \
            PG8_LDB_(F8c, B0, 1, 0); PG8_LDB_(F8c, B1, 1, 1); PG8_SCHED; PG8_LDA_(F8c, At, 1, 0); PG8_STAGE(PG8_SA(0, 1), a2 + hstep, voffA); \
            PG8_WAIT_V(8); PG8_WAIT_L(0); PG8_BAR; PG8_MMA_(F8c, 0, 0, At, B0); PG8_MMA_(F8c, 0, 1, At, B1); PG8_BAR; PG8_SCHED; \
            PG8_LDA_(F8c, At, 1, 1); PG8_STAGE(PG8_SB(1, 0), b3, voffB); PG8_STAGE(PG8_SB(1, 1), b3 + hstep, voffB); PG8_STAGE(PG8_SA(1, 0), a3, voffA); \
            PG8_WAIT_V(8); PG8_WAIT_L(0); PG8_BAR; PG8_MMA_(F8c, 1, 0, At, B0); PG8_MMA_(F8c, 1, 1, At, B1); PG8_BAR; PG8_SCHED; \
            } while (0)
#define PG8_TSTEP(F8c) do { \
            const bool last = (t == ntl - 2); \
            const char* a1 = cA + (size_t)PG8_KT(t + 1) * kstep; \
            const char* a2 = last ? nA : cA + (size_t)PG8_KT(t + 2) * kstep; const char* b2 = last ? nB : cB + (size_t)PG8_KT(t + 2) * kstep; \
            const char* a3 = a2 + kstep; const char* b3 = b2 + kstep; \
            if (last && has_next) S.a_ready(nxt); \
            if constexpr (SP2) { \
            PG8_ITER_SP2(F8c); \
            } else { \
            PG8_LDB(B0, 0, 0); PG8_SCHED; PG8_LDA(At, 0, 0); PG8_STAGE(PG8_SA(1, 1), a1 + hstep, voffA); \
            PG8_WAIT_L(8); PG8_BAR; PG8_WAIT_L(0); PG8_MMA(0, 0, At, B0); PG8_BAR; PG8_SCHED; \
            PG8_LDB(B1, 0, 1); PG8_STAGE(PG8_SB(0, 0), b2, voffB); \
            PG8_BAR; PG8_WAIT_L(0); PG8_MMA(0, 1, At, B1); PG8_BAR; \
            PG8_LDA(At, 0, 1); PG8_STAGE(PG8_SA(0, 0), a2, voffA); \
            PG8_BAR; PG8_WAIT_L(0); PG8_MMA(1, 0, At, B0); PG8_BAR; PG8_SCHED; \
            PG8_STAGE(PG8_SB(0, 1), b2 + hstep, voffB); \
            PG8_WAIT_V(6); PG8_BAR; PG8_MMA(1, 1, At, B1); PG8_BAR; \
            PG8_LDB(B0, 1, 0); PG8_SCHED; PG8_LDA(At, 1, 0); PG8_STAGE(PG8_SA(0, 1), a2 + hstep, voffA); \
            PG8_WAIT_L(8); PG8_BAR; PG8_WAIT_L(0); PG8_MMA(0, 0, At, B0); PG8_BAR; PG8_SCHED; \
            PG8_LDB(B1, 1, 1); PG8_STAGE(PG8_SB(1, 0), b3, voffB); \
            PG8_BAR; PG8_WAIT_L(0); PG8_MMA(0, 1, At, B1); PG8_BAR; \
            PG8_LDA(At, 1, 1); PG8_STAGE(PG8_SA(1, 0), a3, voffA); \
            PG8_BAR; PG8_WAIT_L(0); PG8_MMA(1, 0, At, B0); PG8_BAR; PG8_SCHED; \
            PG8_STAGE(PG8_SB(1, 1), b3 + hstep, voffB); \
            PG8_WAIT_V(6); PG8_BAR; PG8_MMA(1, 1, At, B1); PG8_BAR; \
            } \
            if constexpr (Epi::MID) { if (t == nt / 2 - HSK - 2) { if constexpr (FP8 || (F8c)) asm volatile("s_nop 15\n\ts_nop 15" ::: "memory"); E.mid(acc, cur, wr, wc, fr, fq); } } \
        } while (0)
    Unit cur, nxt; int ui = 0;
    if (!S.next(0, cur)) return;
    f32x4 acc[2][2][4][2];
    if constexpr (Epi::INIT) E.init(acc, cur, wr, wc, lane);
    else {
#pragma unroll
    for (int a = 0; a < 2; ++a)
#pragma unroll
        for (int b = 0; b < 2; ++b)
#pragma unroll
            for (int m = 0; m < 4; ++m)
#pragma unroll
                for (int n = 0; n < 2; ++n) acc[a][b][m][n] = (f32x4){0.f, 0.f, 0.f, 0.f}; }
    bf16x8 At[4][2], B0[2][2], B1[2][2]; i32x8 AtF[4], B0F[2], B1F[2];
    const char* cA = (const char*)g.A + (size_t)cur.pm * tstep; const char* cB = (const char*)g.Bt + (size_t)cur.pn * tstep;
    S.a_ready(cur);
    if constexpr (SP2) {
        PG8_STAGE(PG8_SB(0, 0), cB, voffB); PG8_STAGE(PG8_SB(0, 1), cB + hstep, voffB); PG8_STAGE(PG8_SA(0, 0), cA, voffA); PG8_STAGE(PG8_SA(0, 1), cA + hstep, voffA);
        if (wr == 1) PG8_BAR;
        PG8_WAIT_V(2); PG8_BAR;
        PG8_STAGE(PG8_SB(1, 0), cB + kstep, voffB); PG8_STAGE(PG8_SA(1, 0), cA + kstep, voffA); PG8_STAGE(PG8_SB(1, 1), cB + hstep + kstep, voffB);
        PG8_WAIT_V(6); PG8_BAR;
    } else {
        PG8_STAGE(PG8_SB(0, 0), cB, voffB); PG8_STAGE(PG8_SA(0, 0), cA, voffA); PG8_STAGE(PG8_SB(0, 1), cB + hstep, voffB); PG8_STAGE(PG8_SA(0, 1), cA + hstep, voffA);
        if (wr == 1) PG8_BAR;
        PG8_WAIT_V(4); PG8_BAR;
        PG8_STAGE(PG8_SB(1, 0), cB + kstep, voffB); PG8_STAGE(PG8_SA(1, 0), cA + kstep, voffA); PG8_STAGE(PG8_SB(1, 1), cB + hstep + kstep, voffB);
        PG8_WAIT_V(6); PG8_BAR;
    }
    for (;;) {
        const bool has_next = S.next(ui + 1, nxt);
        const char* nA = has_next ? (const char*)g.A + (size_t)nxt.pm * tstep : cA; const char* nB = has_next ? (const char*)g.Bt + (size_t)nxt.pn * tstep : cB;
        constexpr int HSK = 2 * HYBP;
#define PG8_KT(i) ((HYBP > 0 && (i) >= HSK) ? (i) + HSK : (i))
        const int ntl = nt - HSK;
        if constexpr (HYBP > 0) { int t = 0; for (; t < HSK; t += 2) PG8_TSTEP(true); for (; t < ntl; t += 2) PG8_TSTEP(false); }
        else { for (int t = 0; t < ntl; t += 2) PG8_TSTEP(FP8); }
        if constexpr (ALIGN_EPI) { if (wr == 0) PG8_BAR; }
        if constexpr (FP8) asm volatile("s_nop 15\n\ts_nop 15" ::: "memory");
        if constexpr (!Epi::AFTER_DRAIN) { if constexpr (Epi::INIT) E(acc, cur, wr, wc, fr, fq, wid, lane, has_next, nxt); else E(acc, cur, wr, wc, fr, fq, wid, lane); S.done(cur); }
        if (!has_next) break;
        if constexpr (!Epi::INIT) {
#pragma unroll
        for (int a = 0; a < 2; ++a)
#pragma unroll
            for (int b = 0; b < 2; ++b)
#pragma unroll
                for (int m = 0; m < 4; ++m)
#pragma unroll
                    for (int n = 0; n < 2; ++n) acc[a][b][m][n] = (f32x4){0.f, 0.f, 0.f, 0.f}; }
        cur = nxt; cA = nA; cB = nB; ++ui;
        if constexpr (ALIGN_EPI) { if (wr == 1) PG8_BAR; }
    }
    PG8_WAIT_V(0);
    if constexpr (!ALIGN_EPI) { if (wr == 0) PG8_BAR; }
    PG8_BAR;
    if constexpr (Epi::AFTER_DRAIN) { E.fused(acc, cur, wr, wc, fr, fq, lds, wid, lane); S.done(cur); }
#undef PG8_SA
#undef PG8_SB
#undef PG8_STAGE
#undef PG8_LDA
#undef PG8_LDB
#undef PG8_MMA
#undef PG8_MMA_
#undef PG8_LDA_
#undef PG8_LDB_
#undef PG8_ITER_SP2
#undef PG8_TSTEP
#undef PG8_KT
#undef PG8_WAIT_V
#undef PG8_WAIT_L
#undef PG8_BAR
#undef PG8_SCHED
}
}

#include <cmath>


#ifndef PG8_SP2
#define PG8_SP2 true
#endif
#ifndef PG8_SP2_FP8
#define PG8_SP2_FP8 true
#endif
#ifndef PG8_ALIGN
#define PG8_ALIGN true
#endif

constexpr int NWAVES = 8;
#ifndef MK_ONE_LAUNCH
#define MK_ONE_LAUNCH 1
#endif
constexpr int PER_PHASE = 4;
constexpr bool ONE_LAUNCH = (MK_ONE_LAUNCH != 0);

constexpr int BATCH = 8, SEQ = 2048, DM = 2048, M = BATCH * SEQ;
constexpr int DCONV = 1024, DATTN = 1024, NH = 8, HD = 128, DIN = 8192, DMIX = 2048;
constexpr int MBLK = 256, NBLK = SEQ / MBLK, TOPK = 3;
constexpr float EPS = 1e-6f;
constexpr float SM_SCALE = 0.08838834764831845f;
#ifndef MK_FP8_OUT
#define MK_FP8_OUT 1
#endif
#ifndef MK_NF8
#define MK_NF8 2
#endif
constexpr int NF8 = MK_NF8;
constexpr unsigned PORD = 0x54201367u;
constexpr unsigned PPOS = 0x01762534u;
constexpr float X8_SCALE = 1.0f, WI8_SCALE = 64.0f;
#ifndef MK_LOCBAR
#define MK_LOCBAR 1
#endif
#ifndef MK_HYB
#define MK_HYB 2
#endif
constexpr int HYBP = MK_HYB;
constexpr int HYBC = 256 * HYBP;
constexpr float HYB_Y = 4.0f, HYB_W = 64.0f, HYB_ALL = HYB_Y * HYB_W;
constexpr bool FP8_OUT = (MK_FP8_OUT != 0);
constexpr float Y8C_SCALE = 4.0f, Y8A_SCALE = 8.0f, W8_SCALE = 64.0f;

constexpr size_t MiB = 1u << 20;
constexpr size_t WS_CTL = 0, CTL_ZERO_BYTES = 32768;
constexpr size_t WS_WIN = 388 * MiB;
constexpr size_t WS_WOUT = 34 * MiB;
constexpr size_t WS_KMEAN = 42 * MiB;
constexpr size_t WS_XRS = 43 * MiB;
constexpr size_t WS_SSQ = 44 * MiB;
constexpr size_t WS_XN = 400 * MiB;
constexpr size_t WS_PROJ = 48 * MiB;
constexpr size_t PROJ_STRIDE = 32 * MiB;
constexpr size_t WS_Y = 320 * MiB;
constexpr size_t WS_XN8 = 464 * MiB;
constexpr size_t WS_WIN8 = 496 * MiB;
constexpr size_t WS_END = 510 * MiB;
static_assert(MK_NF8 == 6, "this workspace map gives the bf16 W_in^T copy only 12 MiB (the q and k rows)");
constexpr int CW_TMO = 0, CW_CODE = 1;
constexpr int CW_BAR = 4096;

constexpr int RING_OFF = 0, RING_BYTES = 141312;
constexpr int LDSCTL_OFF = RING_BYTES, MISC_OFF = LDSCTL_OFF + 320;
constexpr int LDS_BYTES = 147456;
static_assert(MISC_OFF + 128 <= LDS_BYTES, "LDS map");
static_assert(HYBP == 0 || HYBC == 512 || HYBC == 1024, "the conv mixer stores its j = 0 half (or both halves) as e4m3");

#define GAS __attribute__((address_space(1)))
#define LAS __attribute__((address_space(3)))
typedef unsigned short bf16;
typedef unsigned v4u __attribute__((ext_vector_type(4)));
typedef float f32x4 __attribute__((ext_vector_type(4)));
typedef short bf16x8 __attribute__((ext_vector_type(8)));
typedef GAS unsigned gu32;
typedef GAS unsigned long long gu64;
#define RLX_AGENT __ATOMIC_RELAXED, __HIP_MEMORY_SCOPE_AGENT
#define LDS_WAIT() asm volatile("s_waitcnt lgkmcnt(0)" ::: "memory")
#define VM_WAIT() asm volatile("s_waitcnt vmcnt(0)" ::: "memory")
__device__ __forceinline__ unsigned long long rt() { return __builtin_amdgcn_s_memrealtime(); }
__device__ __forceinline__ unsigned f2bf(float f) { unsigned u = __builtin_bit_cast(unsigned, f); return (u + 0x7fffu + ((u >> 16) & 1u)) >> 16; }
__device__ __forceinline__ unsigned pk2(float lo, float hi) { return f2bf(lo) | (f2bf(hi) << 16); }

#define XB_TMO      128
#define XB_XCNT(j)  (256  + 64 * (j))
#define XB_XSUB(j)  (1280 + 64 * (j))
#define XB_XGEN(j)  (2304 + 64 * (j))
#define XB_TOP      3328
#define XB_TOPGEN   3392
#define XB_MIS      3456
#define XCD_BAR_WORDS 3520
#define XB_SPIN_CAP (1u << 18)

__device__ __forceinline__ unsigned xb_ld(unsigned* p)              { return __hip_atomic_load(p, __ATOMIC_RELAXED, __HIP_MEMORY_SCOPE_AGENT); }
__device__ __forceinline__ unsigned xb_add(unsigned* p, unsigned v) { return __hip_atomic_fetch_add(p, v, __ATOMIC_RELAXED, __HIP_MEMORY_SCOPE_AGENT); }
__device__ __forceinline__ unsigned xb_xcc_id() { return (unsigned)__builtin_amdgcn_s_getreg((3 << 11) | 20) & 0xFu; }
#define XB_SPIN(cond, bar) do { unsigned _sp = 0; while (cond) { __builtin_amdgcn_s_sleep(1); \
    if ((++_sp & 255u) == 0u) { if (xb_ld(&(bar)[XB_TMO])) break; if (_sp > XB_SPIN_CAP) { atomicAdd(&(bar)[XB_TMO], 1u); break; } } } } while (0)

struct XcdBarrier {
    unsigned* bar; unsigned x;
    volatile LAS unsigned* st;
};

__device__ __forceinline__ XcdBarrier xcd_barrier_post(unsigned* bar, volatile LAS unsigned* st) {
    XcdBarrier b; b.bar = bar; b.x = xb_xcc_id(); b.st = st;
    if (threadIdx.x == 0) (void)xb_add(&bar[XB_XCNT(b.x)], 1u);
    return b;
}
__device__ __forceinline__ void xcd_barrier_complete(unsigned* bar, unsigned x, unsigned& nloc, unsigned& nx) {
    const unsigned G = gridDim.x * gridDim.y * gridDim.z;
    unsigned sum, cnt, mine, sp = 0u;
    for (;;) {
        sum = 0u; cnt = 0u; mine = 0u;
#pragma unroll
        for (unsigned j = 0; j < 16; ++j) { const unsigned c = xb_ld(&bar[XB_XCNT(j)]); sum += c; cnt += (c > 0u) ? 1u : 0u; mine = (j == x) ? c : mine; }
        if (sum == G) break;
        __builtin_amdgcn_s_sleep(1);
        if ((++sp & 255u) == 0u) { if (xb_ld(&bar[XB_TMO])) break; if (sp > XB_SPIN_CAP) { atomicAdd(&bar[XB_TMO], 1u); break; } }
    }
    nloc = mine > 0u ? mine : 1u; nx = cnt > 0u ? cnt : 1u;
}

__device__ __forceinline__ void xcd_barrier(const XcdBarrier& b) {
    asm volatile("s_waitcnt vmcnt(0)" ::: "memory");
    __syncthreads();
    if (threadIdx.x == 0) {
        unsigned* bar = b.bar;
        __builtin_amdgcn_s_waitcnt(0);
        unsigned nloc = b.st[0], nx = b.st[1];
        if (nloc == 0u) { xcd_barrier_complete(bar, b.x, nloc, nx); b.st[0] = nloc; b.st[1] = nx; }
        const unsigned old = xb_add(&bar[XB_XSUB(b.x)], 1u);
        const unsigned gen = old / nloc;
        if (old + 1u == (gen + 1u) * nloc) {
            __builtin_amdgcn_fence(__ATOMIC_RELEASE, "agent");
            asm volatile("s_waitcnt vmcnt(0)" ::: "memory");
            const unsigned og = xb_add(&bar[XB_TOP], 1u);
            const unsigned tg = og / nx;
            if (og + 1u == (tg + 1u) * nx) xb_add(&bar[XB_TOPGEN], 1u);
            else XB_SPIN(xb_ld(&bar[XB_TOPGEN]) == tg, bar);
            __builtin_amdgcn_fence(__ATOMIC_ACQUIRE, "agent");
            xb_add(&bar[XB_XGEN(b.x)], 1u);
            asm volatile("s_waitcnt vmcnt(0)" ::: "memory");
        } else {
            XB_SPIN(xb_ld(&bar[XB_XGEN(b.x)]) == gen, bar);
            __builtin_amdgcn_fence(__ATOMIC_ACQUIRE, "agent");
            asm volatile("s_waitcnt vmcnt(0)" ::: "memory");
        }
    }
    __syncthreads();
}

__device__ __forceinline__ void xcd_barrier_local(const XcdBarrier& b) {
    asm volatile("s_waitcnt vmcnt(0)" ::: "memory");
    __syncthreads();
    if (threadIdx.x == 0) {
        unsigned* bar = b.bar;
        __builtin_amdgcn_s_waitcnt(0);
        unsigned nloc = b.st[0], nx = b.st[1];
        if (nloc == 0u) { xcd_barrier_complete(bar, b.x, nloc, nx); b.st[0] = nloc; b.st[1] = nx; }
        const unsigned old = xb_add(&bar[XB_XSUB(b.x)], 1u);
        const unsigned gen = old / nloc;
        if (old + 1u == (gen + 1u) * nloc) xb_add(&bar[XB_XGEN(b.x)], 1u);
        else XB_SPIN(xb_ld(&bar[XB_XGEN(b.x)]) == gen, bar);
        __builtin_amdgcn_fence(__ATOMIC_ACQUIRE, "agent");
        asm volatile("s_waitcnt vmcnt(0)" ::: "memory");
    }
    __syncthreads();
}

namespace moba {
typedef short bf16x8 __attribute__((ext_vector_type(8)));
typedef short s16x4 __attribute__((ext_vector_type(4)));
typedef float f32x16 __attribute__((ext_vector_type(16)));
typedef float f32x4 __attribute__((ext_vector_type(4)));
typedef unsigned u32x4 __attribute__((ext_vector_type(4)));
typedef unsigned short bf16;
constexpr int D = 128, PITCH = 128, NW = 8, QBLK = 32, KVBLK = 64, QB = NW * QBLK;
constexpr int SHM_V = KVBLK * D * 2, SHM_K = KVBLK * D * 2;
constexpr int OFF_WSF = 2 * SHM_V + 2 * SHM_K, OFF_OST = OFF_WSF + NW * 64 * 4, OFF_KM = OFF_OST + NW * 8192, LDS_BYTES = OFF_KM + 8192;
constexpr float SCALE = 0.08838834764831845f, THR = 8.f;
#define KSWZ(row, colB) ((row) * 256 + ((colB) ^ (((row) & 7) << 4)))
#define SBAR() __builtin_amdgcn_sched_barrier(0)
__device__ __forceinline__ int v_st(int k, int c) { const int kk = (k & ~0xC) | ((k & 4) << 1) | ((k & 8) >> 1); return ((kk >> 3) * 4 + (c >> 5)) * 512 + ((kk & 7) * 32 + (c & 31)) * 2; }
__device__ __forceinline__ int v_rd_base(int lane) { return ((lane & 3) << 3) | (((lane >> 2) & 3) << 6) | (((lane >> 4) & 1) << 5) | (((lane >> 5) & 1) << 8); }
constexpr int v_rd_off(int d0, int ks, int half) { return d0 * 512 + ks * 4096 + half * 2048; }
__device__ __forceinline__ int crow(int r, int hi) { return (r & 3) + 8 * (r >> 2) + 4 * hi; }
__device__ __forceinline__ unsigned cvtpk(float lo, float hi) { unsigned r; asm volatile("v_cvt_pk_bf16_f32 %0, %1, %2" : "=v"(r) : "v"(lo), "v"(hi)); return r; }
__device__ __forceinline__ float bflo(unsigned w) { return __builtin_bit_cast(float, w << 16); }
__device__ __forceinline__ float bfhi(unsigned w) { return __builtin_bit_cast(float, w & 0xffff0000u); }
__device__ __forceinline__ void mask_tile(f32x16& p0, f32x16& p1, int dq) {
    const float NEG = -__builtin_inff();
#pragma unroll
    for (int r = 0; r < 16; ++r) { const int c = (r & 3) + 8 * (r >> 2); if (dq - c < 0) p0[r] = NEG; if (dq - c - 32 < 0) p1[r] = NEG; }
}
__device__ __forceinline__ void partialSM(f32x16& p0, f32x16& p1, float& m_reg, float& mn, float& alpha, bool masked) {
    float pmax = p0[0]; for (int r = 1; r < 16; ++r) pmax = fmaxf(pmax, p0[r]); for (int r = 0; r < 16; ++r) pmax = fmaxf(pmax, p1[r]);
    { auto rr = __builtin_amdgcn_permlane32_swap(__float_as_uint(pmax), __float_as_uint(pmax), false, false);
      pmax = fmaxf(__uint_as_float(rr[0]), __uint_as_float(rr[1])); }
    if (masked) pmax = -__builtin_inff();
    constexpr float C2 = 1.4426950408889634f * SCALE;
    if (__builtin_expect(__all((pmax - m_reg) * SCALE <= THR), 1)) { mn = m_reg; alpha = 1.f; }
    else { mn = fmaxf(m_reg, pmax); alpha = __builtin_amdgcn_exp2f((m_reg - mn) * C2); m_reg = mn; }
    const float mnL = masked ? -__builtin_inff() : -mn * C2;
    for (int r = 0; r < 16; ++r) p0[r] = fmaf(p0[r], C2, mnL); for (int r = 0; r < 16; ++r) p1[r] = fmaf(p1[r], C2, mnL);
    for (int r = 0; r < 16; ++r) p0[r] = __builtin_amdgcn_exp2f(p0[r]);
}
__device__ __forceinline__ void finishSM(f32x16& p0, f32x16& p1, float alpha, float& l_reg, bf16x8& pa0, bf16x8& pa1, bf16x8& pa2, bf16x8& pa3) {
    for (int r = 0; r < 16; ++r) p1[r] = __builtin_amdgcn_exp2f(p1[r]);
    float ps = 0; for (int r = 0; r < 16; ++r) ps += p0[r]; for (int r = 0; r < 16; ++r) ps += p1[r];
    { auto rr = __builtin_amdgcn_permlane32_swap(__float_as_uint(ps), __float_as_uint(ps), false, false);
      ps = __uint_as_float(rr[0]) + __uint_as_float(rr[1]); }
    l_reg = l_reg * alpha + ps;
#define PK4(P, B_, OUT) do { unsigned a0 = cvtpk(P[B_+0], P[B_+1]), a1 = cvtpk(P[B_+2], P[B_+3]);                          \
        unsigned b0 = cvtpk(P[B_+4], P[B_+5]), b1 = cvtpk(P[B_+6], P[B_+7]);                                             \
        auto r0 = __builtin_amdgcn_permlane32_swap(a0, b0, false, false); auto r1 = __builtin_amdgcn_permlane32_swap(a1, b1, false, false); \
        u32x4 w = {r0[0], r1[0], r0[1], r1[1]}; OUT = *reinterpret_cast<bf16x8*>(&w); } while (0)
    PK4(p0, 0, pa0); PK4(p0, 8, pa1); PK4(p1, 0, pa2); PK4(p1, 8, pa3);
#undef PK4
}
#ifndef MOBA_QLA
#define MOBA_QLA 3
#endif
template <int KB>
__device__ __forceinline__ void qkt(f32x16& p0, f32x16& p1, const char* K_lds, int r32, int hi, const bf16x8* qr) {
    p0 = f32x16{}; p1 = f32x16{};
    const char* kb[4];
#pragma unroll
    for (int dd = 0; dd < 4; ++dd) kb[dd] = K_lds + KB * SHM_K + KSWZ(r32, (dd * 16 + hi * 8) * 2);
    constexpr int QLA = MOBA_QLA;
    bf16x8 f0[8], f1[8];
#define QK_RD(d0) do { const char* a_ = kb[(d0) & 3] + ((d0) >> 2) * 128; f0[d0] = *reinterpret_cast<const bf16x8*>(a_); f1[d0] = *reinterpret_cast<const bf16x8*>(a_ + 32 * 256); } while (0)
#pragma unroll
    for (int d0 = 0; d0 < QLA; ++d0) QK_RD(d0);
    SBAR();
#pragma unroll
    for (int d0 = 0; d0 < 8; ++d0) {
        p0 = __builtin_amdgcn_mfma_f32_32x32x16_bf16(f0[d0], qr[d0], p0, 0, 0, 0);
        p1 = __builtin_amdgcn_mfma_f32_32x32x16_bf16(f1[d0], qr[d0], p1, 0, 0, 0);
        if (d0 + QLA < 8) { SBAR(); QK_RD(d0 + QLA); SBAR(); } }
#undef QK_RD
}
template <int VB>
__device__ __forceinline__ void pv_tile(f32x16* o, int vb0, bf16x8 pa0, bf16x8 pa1, bf16x8 pa2, bf16x8 pa3) {
#define TRRD(dst, off) asm volatile("ds_read_b64_tr_b16 %0, %1 offset:%2" : "=&v"(dst) : "v"(vb0), "i"(off) : "memory")
#define PV_D0(d0) do { s16x4 l0, l1, l2, l3, h0, h1, h2, h3; constexpr int b_ = VB * SHM_V + v_rd_off(d0, 0, 0); \
        TRRD(l0, b_); TRRD(h0, b_ + 2048); TRRD(l1, b_ + 4096); TRRD(h1, b_ + 6144); TRRD(l2, b_ + 8192); TRRD(h2, b_ + 10240); TRRD(l3, b_ + 12288); TRRD(h3, b_ + 14336); \
        asm volatile("s_waitcnt lgkmcnt(0)" ::: "memory"); SBAR();   \
        o[d0] = __builtin_amdgcn_mfma_f32_32x32x16_bf16(pa0, (bf16x8){l0[0], l0[1], l0[2], l0[3], h0[0], h0[1], h0[2], h0[3]}, o[d0], 0, 0, 0);   \
        o[d0] = __builtin_amdgcn_mfma_f32_32x32x16_bf16(pa1, (bf16x8){l1[0], l1[1], l1[2], l1[3], h1[0], h1[1], h1[2], h1[3]}, o[d0], 0, 0, 0);   \
        o[d0] = __builtin_amdgcn_mfma_f32_32x32x16_bf16(pa2, (bf16x8){l2[0], l2[1], l2[2], l2[3], h2[0], h2[1], h2[2], h2[3]}, o[d0], 0, 0, 0);   \
        o[d0] = __builtin_amdgcn_mfma_f32_32x32x16_bf16(pa3, (bf16x8){l3[0], l3[1], l3[2], l3[3], h3[0], h3[1], h3[2], h3[3]}, o[d0], 0, 0, 0); } while (0)
    PV_D0(0); PV_D0(1); PV_D0(2); PV_D0(3);
#undef PV_D0
#undef TRRD
}
template <int VB>
__device__ __forceinline__ void pv_sm(f32x16* o, int vb0, bf16x8 pa0, bf16x8 pa1, bf16x8 pa2, bf16x8 pa3, f32x16& p0, f32x16& p1, float& m_reg, float& mn, float& alpha, bool masked, bool domask, int dq) {
#define TRRD(dst, off) asm volatile("ds_read_b64_tr_b16 %0, %1 offset:%2" : "=&v"(dst) : "v"(vb0), "i"(off) : "memory")
#define PV_D0(d0) do { s16x4 l0, l1, l2, l3, h0, h1, h2, h3; constexpr int b_ = VB * SHM_V + v_rd_off(d0, 0, 0); \
        TRRD(l0, b_); TRRD(h0, b_ + 2048); TRRD(l1, b_ + 4096); TRRD(h1, b_ + 6144); TRRD(l2, b_ + 8192); TRRD(h2, b_ + 10240); TRRD(l3, b_ + 12288); TRRD(h3, b_ + 14336); \
        asm volatile("s_waitcnt lgkmcnt(0)" ::: "memory"); SBAR();   \
        o[d0] = __builtin_amdgcn_mfma_f32_32x32x16_bf16(pa0, (bf16x8){l0[0], l0[1], l0[2], l0[3], h0[0], h0[1], h0[2], h0[3]}, o[d0], 0, 0, 0);   \
        o[d0] = __builtin_amdgcn_mfma_f32_32x32x16_bf16(pa1, (bf16x8){l1[0], l1[1], l1[2], l1[3], h1[0], h1[1], h1[2], h1[3]}, o[d0], 0, 0, 0);   \
        o[d0] = __builtin_amdgcn_mfma_f32_32x32x16_bf16(pa2, (bf16x8){l2[0], l2[1], l2[2], l2[3], h2[0], h2[1], h2[2], h2[3]}, o[d0], 0, 0, 0);   \
        o[d0] = __builtin_amdgcn_mfma_f32_32x32x16_bf16(pa3, (bf16x8){l3[0], l3[1], l3[2], l3[3], h3[0], h3[1], h3[2], h3[3]}, o[d0], 0, 0, 0); } while (0)
    constexpr float C2 = 1.4426950408889634f * SCALE;
    PV_D0(0);
    if (domask) mask_tile(p0, p1, dq);
    float pmax = p0[0]; for (int r = 1; r < 16; ++r) pmax = fmaxf(pmax, p0[r]);
    SBAR();
    PV_D0(1);
    for (int r = 0; r < 16; ++r) pmax = fmaxf(pmax, p1[r]);
    { auto rr = __builtin_amdgcn_permlane32_swap(__float_as_uint(pmax), __float_as_uint(pmax), false, false);
      pmax = fmaxf(__uint_as_float(rr[0]), __uint_as_float(rr[1])); }
    if (masked) pmax = -__builtin_inff();
    if (__builtin_expect(__all((pmax - m_reg) * SCALE <= THR), 1)) { mn = m_reg; alpha = 1.f; }
    else { mn = fmaxf(m_reg, pmax); alpha = __builtin_amdgcn_exp2f((m_reg - mn) * C2); m_reg = mn; }
    const float mnL = masked ? -__builtin_inff() : -mn * C2;
    SBAR();
    PV_D0(2);
    for (int r = 0; r < 16; ++r) p0[r] = fmaf(p0[r], C2, mnL); for (int r = 0; r < 16; ++r) p1[r] = fmaf(p1[r], C2, mnL);
    SBAR();
    PV_D0(3);
    for (int r = 0; r < 16; ++r) p0[r] = __builtin_amdgcn_exp2f(p0[r]);
#undef PV_D0
#undef TRRD
}
struct BlockRef { const bf16* Q; const bf16* K; const bf16* V; int bh, qb, m0; };
struct Seam { bf16x8 qr[8]; bf16x8 st_v0, st_v1, st_k0, st_k1; f32x4 km_a, km_b; };
struct Ctx { const float* kmean; const bf16* ZA; bf16* Y; float* SSQ; float y8; };
__device__ __forceinline__ bf16x8 ld8(const bf16* p) { return *reinterpret_cast<const bf16x8*>(p); }
__device__ __forceinline__ void write_km(const float* km, char* KM_lds, int tid) {
    asm volatile("" : "+v"(tid));
    if (tid < 256) { const int row = tid >> 4, ch = tid & 15, n = row & 7;
        const f32x4 a = *(const f32x4*)(km + n * 128 + ch * 8), b = *(const f32x4*)(km + n * 128 + ch * 8 + 4);
        float v[8] = {a[0], a[1], a[2], a[3], b[0], b[1], b[2], b[3]};
        if (row >= 8) {
#pragma unroll
            for (int e = 0; e < 8; e += 2) { const unsigned w = cvtpk(v[e], v[e + 1]); v[e] -= bflo(w); v[e + 1] -= bfhi(w); } }
        u32x4 w = {cvtpk(v[0], v[1]), cvtpk(v[2], v[3]), cvtpk(v[4], v[5]), cvtpk(v[6], v[7])};
        *(u32x4*)(KM_lds + KSWZ(row, ch * 16)) = w; }
}
#define ROW(p, k0, rr) ((p) + (size_t)((k0) + (rr)) * PITCH + sc)
#define VMW() asm volatile("s_waitcnt vmcnt(0)" ::: "memory")
#define VMWN(n) asm volatile("s_waitcnt vmcnt(%0)" :: "i"(n) : "memory")
#define SLOAD_H(Kp, Vp, k0) do { S.st_v0 = ld8(ROW(Vp, k0, sr)); S.st_v1 = ld8(ROW(Vp, k0, 32 + sr));              \
                         S.st_k0 = ld8(ROW(Kp, k0, sr)); S.st_k1 = ld8(ROW(Kp, k0, 32 + sr)); } while (0)
#define SWRITE_HK(bf) do { *(bf16x8*)(K_lds + (bf) * SHM_K + kws) = S.st_k0; *(bf16x8*)(K_lds + (bf) * SHM_K + kws + 32 * 256) = S.st_k1; } while (0)
#define SWRITE_HV(bf) do { *(bf16x8*)(V_lds + (bf) * SHM_V + vst0) = S.st_v0; *(bf16x8*)(V_lds + (bf) * SHM_V + vst1) = S.st_v1; } while (0)
#define SWRITE_H(bf) do { SWRITE_HV(bf); SWRITE_HK(bf); } while (0)
__device__ __forceinline__ void moba_prime_issue(const BlockRef& cur, const Ctx& C, Seam& S) {
    int tid_ = threadIdx.x; asm volatile("" : "+v"(tid_));
    const int tid = tid_, wid = __builtin_amdgcn_readfirstlane(tid >> 6), lane = tid & 63, r32 = lane & 31, hi = lane >> 5;
    const int sr = tid >> 4, sc = (tid & 15) * 8;
    for (int d0 = 0; d0 < 8; ++d0) S.qr[d0] = ld8(cur.Q + (size_t)(wid * QBLK + r32) * PITCH + d0 * 16 + hi * 8);
    SLOAD_H(cur.K, cur.V, 0);
    { const int row = (tid & 255) >> 4, ch = tid & 15, n = row & 7; const float* km = C.kmean + (size_t)cur.bh * 8 * 128;
      S.km_a = *(const f32x4*)(km + n * 128 + ch * 8); S.km_b = *(const f32x4*)(km + n * 128 + ch * 8 + 4); }
}
__device__ __forceinline__ void moba_prime_finish(char* lds, Seam& S) {
    int tid_ = threadIdx.x; asm volatile("" : "+v"(tid_));
    const int tid = tid_;
    const int sr = tid >> 4, sc = (tid & 15) * 8, kws = KSWZ(sr, sc * 2); char* K_lds = lds + 2 * SHM_V;
    if (tid < 256) { const int row = tid >> 4, ch = tid & 15; const f32x4 a = S.km_a, b = S.km_b;
        float v[8] = {a[0], a[1], a[2], a[3], b[0], b[1], b[2], b[3]};
        if (row >= 8) {
#pragma unroll
            for (int e = 0; e < 8; e += 2) { const unsigned w = cvtpk(v[e], v[e + 1]); v[e] -= bflo(w); v[e + 1] -= bfhi(w); } }
        u32x4 w = {cvtpk(v[0], v[1]), cvtpk(v[2], v[3]), cvtpk(v[4], v[5]), cvtpk(v[6], v[7])};
        *(u32x4*)(lds + OFF_KM + KSWZ(row, ch * 16)) = w; }
    VMW(); SWRITE_HK(0);
    __syncthreads();
}
__device__ __forceinline__ void moba_block(const BlockRef& cur, const BlockRef& nxt, const Ctx& C, char* lds, Seam& S) {
    int tid_ = threadIdx.x; asm volatile("" : "+v"(tid_));
    const int tid = tid_, wid = __builtin_amdgcn_readfirstlane(tid >> 6), lane = tid & 63, r32 = lane & 31, hi = lane >> 5;
    const int own = cur.qb, NT = 4 * (own + 1);
    const int qlo = own * QB + wid * QBLK, qm = qlo + r32 - 4 * hi;
    char* V_lds = lds; char* K_lds = lds + 2 * SHM_V;
    float* ws = (float*)(lds + OFF_WSF) + wid * 64; float* li_l = ws, * al_l = ws + 32;
    float m_reg = -1e30f, l_reg = 0; f32x16 o[4] = {};
    const int sr = tid >> 4, sc = (tid & 15) * 8, vst0 = v_st(sr, sc), vst1 = v_st(32 + sr, sc), kws = KSWZ(sr, sc * 2);
    const int vb0 = (int)(uintptr_t)V_lds + v_rd_base(lane);
    const bf16* Kh = cur.K; const bf16* Vh = cur.V;
    unsigned selmask = 0;
    {   f32x16 g = f32x16{};
        int gl = lane; asm volatile("" : "+v"(gl));
        const int gr = gl & 31, gh = gl >> 5;
        const char* kmb[4];
#pragma unroll
        for (int dd = 0; dd < 4; ++dd) kmb[dd] = lds + OFF_KM + KSWZ(gr, (dd * 16 + gh * 8) * 2);
#pragma unroll
        for (int d0 = 0; d0 < 8; ++d0) { const bf16x8 a = *reinterpret_cast<const bf16x8*>(kmb[d0 & 3] + (d0 >> 2) * 128); g = __builtin_amdgcn_mfma_f32_32x32x16_bf16(a, S.qr[d0], g, 0, 0, 0); }
        float gate[8];
#pragma unroll
        for (int i = 0; i < 4; ++i) { const float a = g[i] + g[4 + i]; auto rr = __builtin_amdgcn_permlane32_swap(__float_as_uint(a), __float_as_uint(a), false, false);
            gate[i] = __uint_as_float(rr[0]); gate[4 + i] = __uint_as_float(rr[1]); }
#pragma unroll
        for (int n = 0; n < 8; ++n) if (n >= own) gate[n] = -__builtin_inff();
#pragma unroll
        for (int n = 0; n < 8; ++n) { int rank = 0;
#pragma unroll
            for (int n2 = 0; n2 < 8; ++n2) if (n2 != n) rank += (gate[n2] > gate[n] || (gate[n2] == gate[n] && n2 < n)) ? 1 : 0;
            if (n < own && rank < 3) selmask |= 1u << n; }
    }
#define RESC(a) do { if (__any((a) < 1.f)) { if (hi == 0) al_l[r32] = (a); asm volatile("s_waitcnt lgkmcnt(0)" ::: "memory");              \
                     for (int d_ = 0; d_ < 4; ++d_) for (int r = 0; r < 16; ++r) o[d_][r] *= al_l[crow(r, hi)]; } } while (0)
#define KBASE(t) ((t) * KVBLK)
#define MASKED(t) (((t) >> 2) < own && !((selmask >> ((t) >> 2)) & 1u))
#define MASKT(P0_, P1_, t) do { const int kb_ = KBASE(t); if (((t) >> 2) == own && kb_ + KVBLK - 1 > qlo) mask_tile(P0_, P1_, qm - kb_); } while (0)
    constexpr int NQL = 8;
#define SEAM_K0() do { VMWN(NQL); SWRITE_HK(0); SBAR(); } while (0)
    f32x16 pA0, pA1, pB0, pB1; float mnA, mnB, alA, alB; bf16x8 pa0, pa1, pa2, pa3;
    SWRITE_HV(0); SBAR();
    SLOAD_H(Kh, Vh, KBASE(1));
    SBAR(); qkt<0>(pA0, pA1, K_lds, r32, hi, S.qr);
    MASKT(pA0, pA1, 0); partialSM(pA0, pA1, m_reg, mnA, alA, MASKED(0));
    VMW(); SWRITE_H(1);
    __syncthreads();
#define HALF_STEP(PX0, PX1, mnX, alX, PY0, PY1, alY, t, KB, VB, SB) do {                                                      \
        SBAR(); qkt<KB>(PX0, PX1, K_lds, r32, hi, S.qr);                                                         \
        finishSM(PY0, PY1, alY, l_reg, pa0, pa1, pa2, pa3); SBAR();                                                           \
        if ((t) + 1 < NT) { SLOAD_H(Kh, Vh, KBASE((t) + 1)); SBAR(); }                                               \
        pv_sm<VB>(o, vb0, pa0, pa1, pa2, pa3, PX0, PX1, m_reg, mnX, alX, MASKED(t), (((t) >> 2) == own && KBASE(t) + KVBLK - 1 > qlo), qm - KBASE(t));                \
        __syncthreads();                                                                                                      \
        if ((t) + 1 < NT) { VMW(); SWRITE_H(SB); }                                                                          \
        RESC(alX); __syncthreads(); } while (0)
    for (int t = 1; t + 1 < NT; t += 2) {
        HALF_STEP(pB0, pB1, mnB, alB, pA0, pA1, alA, t, 1, 0, 0);
        HALF_STEP(pA0, pA1, mnA, alA, pB0, pB1, alB, t + 1, 0, 1, 1);
    }
    SBAR(); qkt<1>(pB0, pB1, K_lds, r32, hi, S.qr); SBAR();
    SLOAD_H(nxt.K, nxt.V, 0); SBAR();
#pragma unroll
    for (int d0 = 0; d0 < 8; ++d0) S.qr[d0] = ld8(nxt.Q + (size_t)(wid * QBLK + r32) * PITCH + d0 * 16 + hi * 8);
    SBAR();
    finishSM(pA0, pA1, alA, l_reg, pa0, pa1, pa2, pa3); SBAR();
    pv_tile<0>(o, vb0, pa0, pa1, pa2, pa3);
    MASKT(pB0, pB1, NT - 1); partialSM(pB0, pB1, m_reg, mnB, alB, MASKED(NT - 1)); __syncthreads(); RESC(alB);
    finishSM(pB0, pB1, alB, l_reg, pa0, pa1, pa2, pa3); SBAR(); pv_tile<1>(o, vb0, pa0, pa1, pa2, pa3);
    SBAR(); SEAM_K0();
    if (nxt.bh != cur.bh) write_km(C.kmean + (size_t)nxt.bh * 8 * 128, lds + OFF_KM, tid);
    if (hi == 0) li_l[r32] = l_reg; asm volatile("s_waitcnt lgkmcnt(0)" ::: "memory");
    float rli[16];
#pragma unroll
    for (int r = 0; r < 16; ++r) rli[r] = __builtin_amdgcn_rcpf(li_l[crow(r, hi)]);
    {   int el = lane; asm volatile("" : "+v"(el));
        const int er32 = el & 31, ehi = el >> 5, erow = el >> 4, ech = el & 15;
        char* stg = lds + OFF_OST + wid * 8192;
        const int h = cur.bh & 7;
        const int mrow = cur.m0 + wid * QBLK;
        char* wb = stg + (4 * ehi) * 256 + er32 * 2;
#pragma unroll
        for (int r = 0; r < 16; ++r) {
#pragma unroll
            for (int d0 = 0; d0 < 4; ++d0) { const float v = o[d0][r] * rli[r]; const unsigned w = cvtpk(v, v);
                *(bf16*)(wb + ((r & 3) + 8 * (r >> 2)) * 256 + d0 * 64) = (bf16)(w & 0xffffu); } }
        asm volatile("s_waitcnt lgkmcnt(0)" ::: "memory"); SBAR();
        const char* rb = stg + erow * 256 + ech * 16;
        const bf16* zp = C.ZA + (size_t)(mrow + erow) * 1024 + h * 128 + ech * 8;
        bf16* yp = C.Y + (size_t)(mrow + erow) * 2048 + 1024 + h * 128 + ech * 8;
        unsigned char* yp8 = (unsigned char*)C.Y + (size_t)(mrow + erow) * 2048 + 1024 + h * 128 + ech * 8;
        float* sp = C.SSQ + (size_t)(mrow + erow) * 8 + h;
        u32x4 zz[8];
#pragma unroll
        for (int i = 0; i < 8; ++i) zz[i] = *(const u32x4*)(zp + (size_t)i * 4096);
#pragma unroll
        for (int i = 0; i < 8; ++i) {
            const u32x4 v = *(const u32x4*)(rb + i * 1024);
            float ov[8] = {bflo(v[0]), bfhi(v[0]), bflo(v[1]), bfhi(v[1]), bflo(v[2]), bfhi(v[2]), bflo(v[3]), bfhi(v[3])};
            float zv[8] = {bflo(zz[i][0]), bfhi(zz[i][0]), bflo(zz[i][1]), bfhi(zz[i][1]), bflo(zz[i][2]), bfhi(zz[i][2]), bflo(zz[i][3]), bfhi(zz[i][3])};
            float ss = 0.f, y[8];
#pragma unroll
            for (int e = 0; e < 8; ++e) { ss += ov[e] * ov[e]; y[e] = ov[e] * (zv[e] / (1.0f + __expf(-zv[e]))); }
            ss += __shfl_xor(ss, 1); ss += __shfl_xor(ss, 2); ss += __shfl_xor(ss, 4); ss += __shfl_xor(ss, 8);
            if (ech == 0) sp[i * 32] = ss;
            if (C.y8 != 0.0f) { typedef unsigned u32x2 __attribute__((ext_vector_type(2))); u32x2 w; unsigned t = 0;
#pragma unroll
                for (int e = 0; e < 8; ++e) y[e] = fminf(fmaxf(y[e] * C.y8, -448.0f), 448.0f);
                t = __builtin_amdgcn_cvt_pk_fp8_f32(y[0], y[1], t, false); t = __builtin_amdgcn_cvt_pk_fp8_f32(y[2], y[3], t, true); w.x = t; t = 0;
                t = __builtin_amdgcn_cvt_pk_fp8_f32(y[4], y[5], t, false); t = __builtin_amdgcn_cvt_pk_fp8_f32(y[6], y[7], t, true); w.y = t;
                *(u32x2*)(yp8 + (size_t)i * 8192) = w; }
            else { u32x4 w = {cvtpk(y[0], y[1]), cvtpk(y[2], y[3]), cvtpk(y[4], y[5]), cvtpk(y[6], y[7])};
            *(u32x4*)(yp + (size_t)i * 8192) = w; } }
    }
    __syncthreads();
#undef RESC
#undef KBASE
#undef MASKED
#undef MASKT
#undef SEAM_K0
#undef HALF_STEP
}
#undef ROW
#undef VMW
#undef VMWN
#undef SLOAD_H
#undef SWRITE_HK
#undef SWRITE_HV
#undef SWRITE_H
#undef KSWZ
#undef SBAR
}


struct Frame {
    LAS unsigned char* lds;
    volatile LAS unsigned* MISC;
    gu32* ctl;
    int tid, lane, wave;
    int vcu, G;
    const float *x, *norm_gain, *w_in, *conv_w, *qg, *kg, *cog, *aog, *w_out; float* out;
    bf16 *WinT, *WoutT, *XN, *PROJ, *Y; float *KMEAN, *SSQ, *XRS; unsigned char *XN8, *Win8;
};

__device__ __forceinline__ float wave_sum(float v) {
#pragma unroll
    for (int o = 1; o < 64; o <<= 1) v += __shfl_xor(v, o);
    return v;
}
__device__ __forceinline__ float wave_max(float v) {
#pragma unroll
    for (int o = 1; o < 64; o <<= 1) v = fmaxf(v, __shfl_xor(v, o));
    return v;
}
__device__ __forceinline__ float bf_lo(unsigned w) { return __builtin_bit_cast(float, w << 16); }
__device__ __forceinline__ float bf_hi(unsigned w) { return __builtin_bit_cast(float, w & 0xffff0000u); }
__device__ __forceinline__ float silu_f(float z) { return z / (1.0f + __expf(-z)); }
__device__ __forceinline__ float clamp8(float v) { return fminf(fmaxf(v, -448.0f), 448.0f); }
__device__ __forceinline__ unsigned pk4_fp8(float a, float b, float c, float d) { a = clamp8(a); b = clamp8(b); c = clamp8(c); d = clamp8(d); unsigned w = 0; w = __builtin_amdgcn_cvt_pk_fp8_f32(a, b, w, false); w = __builtin_amdgcn_cvt_pk_fp8_f32(c, d, w, true); return w; }

__device__ __forceinline__ void p0_transpose_item(const float* W, const float* g0, const float* g1, int ksplit, int K, int N, bf16* WT, LAS float* scr, int item, int lane, bool fp8 = false, float wscale = 1.0f, int drow = -1, int pitch8 = 0) {
    const int nblk = N / 32, kb = item / nblk, nb = item % nblk, k0 = 64 * kb, n0 = 32 * nb, d0 = drow >= 0 ? drow : n0;
    float wv[32];
    const float* wp = W + (size_t)(k0 + (lane >> 5)) * N + n0 + (lane & 31);
#pragma unroll
    for (int i = 0; i < 32; ++i) wv[i] = __builtin_nontemporal_load(wp + (size_t)(2 * i) * N);
    const float* gp = (k0 < ksplit) ? g0 + k0 : g1 + (k0 - ksplit);
    const float gl = gp[lane];
#pragma unroll
    for (int i = 0; i < 32; ++i) { const int kk = 2 * i + (lane >> 5); const float gv = __shfl(gl, kk);
        scr[kk * 33 + (lane & 31)] = wv[i] * gv; }
    LDS_WAIT(); asm volatile("" ::: "memory");
    const int c = lane & 7;
#pragma unroll
    for (int j = 0; j < 4; ++j) { const int n = (lane >> 3) + 8 * j; const LAS float* s = scr + (8 * c) * 33 + n;
        if (fp8) { typedef unsigned u32x2g __attribute__((ext_vector_type(2))); u32x2g o;
            o.x = pk4_fp8(s[0 * 33] * wscale, s[1 * 33] * wscale, s[2 * 33] * wscale, s[3 * 33] * wscale); o.y = pk4_fp8(s[4 * 33] * wscale, s[5 * 33] * wscale, s[6 * 33] * wscale, s[7 * 33] * wscale);
            *(GAS u32x2g*)((unsigned char*)WT + (size_t)(d0 + n) * (pitch8 ? pitch8 : K) + k0 + 8 * c) = o; }
        else { v4u o; o.x = pk2(s[0 * 33] * wscale, s[1 * 33] * wscale); o.y = pk2(s[2 * 33] * wscale, s[3 * 33] * wscale); o.z = pk2(s[4 * 33] * wscale, s[5 * 33] * wscale); o.w = pk2(s[6 * 33] * wscale, s[7 * 33] * wscale);
        *(GAS v4u*)(WT + (size_t)(d0 + n) * K + k0 + 8 * c) = o; } }
    LDS_WAIT(); asm volatile("" ::: "memory");
}
__device__ __forceinline__ void rms_row_to_bf16(Frame& F, const float* xrow, bf16* orow) {
    const GAS f32x4* xr = (const GAS f32x4*)xrow + F.lane;
    f32x4 v[8]; float s = 0.f;
#pragma unroll
    for (int j = 0; j < 8; ++j) { v[j] = xr[64 * j]; s += (v[j].x * v[j].x + v[j].y * v[j].y) + (v[j].z * v[j].z + v[j].w * v[j].w); }
    const float rs = 1.f / sqrtf(wave_sum(s) * (1.f / DM) + EPS);
    GAS unsigned long long* o8 = (GAS unsigned long long*)orow + F.lane;
#pragma unroll
    for (int j = 0; j < 8; ++j) o8[64 * j] = (unsigned long long)pk2(v[j].x * rs, v[j].y * rs) | ((unsigned long long)pk2(v[j].z * rs, v[j].w * rs) << 32);
}
__device__ __forceinline__ void rms_row2_to_bf16(Frame& F, const float* xrow, bf16* orow, size_t rstride) {
    const GAS f32x4* xa = (const GAS f32x4*)xrow + F.lane; const GAS f32x4* xb = (const GAS f32x4*)(xrow + rstride) + F.lane;
    f32x4 va[8], vb[8]; float sa = 0.f, sb = 0.f;
#pragma unroll
    for (int j = 0; j < 8; ++j) va[j] = __builtin_nontemporal_load(xa + 64 * j);
#pragma unroll
    for (int j = 0; j < 8; ++j) vb[j] = __builtin_nontemporal_load(xb + 64 * j);
#pragma unroll
    for (int j = 0; j < 8; ++j) sa += (va[j].x * va[j].x + va[j].y * va[j].y) + (va[j].z * va[j].z + va[j].w * va[j].w);
#pragma unroll
    for (int j = 0; j < 8; ++j) sb += (vb[j].x * vb[j].x + vb[j].y * vb[j].y) + (vb[j].z * vb[j].z + vb[j].w * vb[j].w);
    const float qa = sqrtf(wave_sum(sa) * (1.f / DM) + EPS), qb = sqrtf(wave_sum(sb) * (1.f / DM) + EPS), ra = 1.f / qa, rb = 1.f / qb;
    if (F.lane == 0) { const size_t m = (size_t)(orow - F.XN) / DM; F.XRS[m] = qa; F.XRS[m + rstride / DM] = qb; }
    GAS unsigned long long* oa = (GAS unsigned long long*)orow + F.lane; GAS unsigned long long* ob = (GAS unsigned long long*)(orow + rstride) + F.lane;
#pragma unroll
    for (int j = 0; j < 8; ++j) oa[64 * j] = (unsigned long long)pk2(va[j].x * ra, va[j].y * ra) | ((unsigned long long)pk2(va[j].z * ra, va[j].w * ra) << 32);
#pragma unroll
    for (int j = 0; j < 8; ++j) ob[64 * j] = (unsigned long long)pk2(vb[j].x * rb, vb[j].y * rb) | ((unsigned long long)pk2(vb[j].z * rb, vb[j].w * rb) << 32);
    if (NF8 > 0) { GAS unsigned* pa = (GAS unsigned*)(F.XN8 + (orow - F.XN)) + F.lane; GAS unsigned* pb = (GAS unsigned*)(F.XN8 + (orow - F.XN) + rstride) + F.lane;
#pragma unroll
        for (int j = 0; j < 8; ++j) { pa[64 * j] = pk4_fp8(va[j].x * ra, va[j].y * ra, va[j].z * ra, va[j].w * ra); pb[64 * j] = pk4_fp8(vb[j].x * rb, vb[j].y * rb, vb[j].z * rb, vb[j].w * rb); } }
}
__device__ __forceinline__ void p0_prologue(Frame& F, bool wout) {
    LAS float* scr = (LAS float*)(F.lds + RING_OFF + F.wave * 16384);
    const int gw = F.vcu * NWAVES + F.wave, NGW = F.G * NWAVES;
    constexpr int I_IN = (DM / 64) * (DIN / 32), I_OUT = (DMIX / 64) * (DM / 32);
    if (!wout) for (int m = gw; m < M; m += 2 * NGW) rms_row2_to_bf16(F, F.x + (size_t)m * DM, F.XN + (size_t)m * DM, (size_t)NGW * DM);
    for (int it = (wout ? I_IN : 0) + gw; it < (wout ? I_IN + I_OUT : I_IN); it += NGW) {
        if (it < I_IN) { const int n0 = 32 * (it % (DIN / 32)), ts = n0 >> 10, c0 = n0 & 1023; int lt0, roff;
            if (ts == 0 || ts == 2) { lt0 = 16 + (c0 >> 7); roff = (ts >> 1) * 128 + (c0 & 127); }
            else { lt0 = (int)((PPOS >> (4 * ts)) & 15u) * 4 + (c0 >> 8); roff = c0 & 255; }
            if ((lt0 >> 2) < NF8) p0_transpose_item(F.w_in, F.norm_gain, F.norm_gain, DM, DM, DIN, (bf16*)F.Win8, scr, it, F.lane, true, WI8_SCALE, lt0 * 256 + roff);
            else p0_transpose_item(F.w_in, F.norm_gain, F.norm_gain, DM, DM, DIN, F.WinT, scr, it, F.lane, false, 1.0f, (lt0 - 4 * NF8) * 256 + roff); }
        else if (HYBP > 0) { const int k0o = 64 * ((it - I_IN) / (DM / 32));
            if (k0o < HYBC) p0_transpose_item(F.w_out, F.cog, F.aog, DCONV, DMIX, DM, F.WoutT, scr, it - I_IN, F.lane, true, HYB_W, -1, DMIX * 2);
            else p0_transpose_item(F.w_out, F.cog, F.aog, DCONV, DMIX, DM, F.WoutT, scr, it - I_IN, F.lane, false, HYB_ALL); }
        else p0_transpose_item(F.w_out, F.cog, F.aog, DCONV, DMIX, DM, F.WoutT, scr, it - I_IN, F.lane, FP8_OUT, W8_SCALE);
    }
}

__device__ __forceinline__ void unpack8(const v4u a, float (&f)[16], int o) {
    f[o + 0] = bf_lo(a.x); f[o + 1] = bf_hi(a.x); f[o + 2] = bf_lo(a.y); f[o + 3] = bf_hi(a.y); f[o + 4] = bf_lo(a.z); f[o + 5] = bf_hi(a.z); f[o + 6] = bf_lo(a.w); f[o + 7] = bf_hi(a.w); }
__device__ __forceinline__ void p2_conv(Frame& F) {
    const int gw = F.vcu * NWAVES + F.wave, NGW = F.G * NWAVES;
    const bf16* UU = F.PROJ; const bf16* BG = F.PROJ + PROJ_STRIDE / 2; const bf16* ZC = F.PROJ + 3 * (PROJ_STRIDE / 2);
    for (int ck = gw; ck < M / 8; ck += NGW) {
        const int m0 = ck * 8, t0 = m0 % SEQ;
        const size_t co = (size_t)8 * F.lane;
        float w0[16], w1[16], w2[16], u1[16], u2[16];
#pragma unroll
        for (int j = 0; j < 2; ++j)
#pragma unroll
            for (int q = 0; q < 2; ++q) { const int c = 8 * F.lane + 512 * j + 4 * q;
                const f32x4 a = *(const GAS f32x4*)(F.conv_w + c), b = *(const GAS f32x4*)(F.conv_w + DCONV + c), d = *(const GAS f32x4*)(F.conv_w + 2 * DCONV + c);
#pragma unroll
                for (int e = 0; e < 4; ++e) { w0[8 * j + 4 * q + e] = a[e]; w1[8 * j + 4 * q + e] = b[e]; w2[8 * j + 4 * q + e] = d[e]; } }
        if (t0 > 0) {
#pragma unroll
            for (int j = 0; j < 2; ++j) { unpack8(__builtin_nontemporal_load((const GAS v4u*)(UU + (size_t)(m0 - 2) * 1024 + co + 512 * j)), u2, 8 * j); unpack8(__builtin_nontemporal_load((const GAS v4u*)(UU + (size_t)(m0 - 1) * 1024 + co + 512 * j)), u1, 8 * j); }
        } else {
#pragma unroll
            for (int e = 0; e < 16; ++e) { u1[e] = 0.f; u2[e] = 0.f; }
        }
#pragma unroll 2
        for (int i = 0; i < 8; ++i) {
            const size_t m = (size_t)(m0 + i);
            float u0[16], bb[16], zz[16], y[16];
#pragma unroll
            for (int j = 0; j < 2; ++j) { unpack8(__builtin_nontemporal_load((const GAS v4u*)(UU + m * 1024 + co + 512 * j)), u0, 8 * j);
                unpack8(__builtin_nontemporal_load((const GAS v4u*)(BG + m * 1024 + co + 512 * j)), bb, 8 * j); unpack8(__builtin_nontemporal_load((const GAS v4u*)(ZC + m * 1024 + co + 512 * j)), zz, 8 * j); }
            float ss = 0.f;
#pragma unroll
            for (int e = 0; e < 16; ++e) { const float cv = w0[e] * u2[e] + w1[e] * u1[e] + w2[e] * u0[e]; y[e] = bb[e] * cv; ss += y[e] * y[e]; u2[e] = u1[e]; u1[e] = u0[e]; }
            const float rs = 1.f / sqrtf(wave_sum(ss) * (1.f / DCONV) + EPS);
#pragma unroll
            for (int j = 0; j < 2; ++j) { float o[8];
#pragma unroll
                for (int e = 0; e < 8; ++e) o[e] = y[8 * j + e] * rs * silu_f(zz[8 * j + e]);
                if (HYBP > 0 && 512 * j < HYBC) { typedef unsigned u32x2g __attribute__((ext_vector_type(2))); u32x2g w;
                    w.x = pk4_fp8(o[0] * HYB_Y, o[1] * HYB_Y, o[2] * HYB_Y, o[3] * HYB_Y); w.y = pk4_fp8(o[4] * HYB_Y, o[5] * HYB_Y, o[6] * HYB_Y, o[7] * HYB_Y);
                    *(GAS u32x2g*)((unsigned char*)F.Y + m * (DMIX * 2) + co + 512 * j) = w; }
                else if (FP8_OUT) { typedef unsigned u32x2g __attribute__((ext_vector_type(2))); u32x2g w;
                    w.x = pk4_fp8(o[0] * Y8C_SCALE, o[1] * Y8C_SCALE, o[2] * Y8C_SCALE, o[3] * Y8C_SCALE); w.y = pk4_fp8(o[4] * Y8C_SCALE, o[5] * Y8C_SCALE, o[6] * Y8C_SCALE, o[7] * Y8C_SCALE);
                    *(GAS u32x2g*)((unsigned char*)F.Y + m * DMIX + co + 512 * j) = w; }
                else { v4u w; w.x = pk2(o[0], o[1]); w.y = pk2(o[2], o[3]); w.z = pk2(o[4], o[5]); w.w = pk2(o[6], o[7]);
                *(GAS v4u*)(F.Y + m * DMIX + co + 512 * j) = w; } }
        }
    }
}
__device__ __forceinline__ moba::BlockRef moba_ref(Frame& F, int bh, int qb) {
    const int b = bh >> 3, h = bh & 7; moba::BlockRef r;
    const bf16* Q = F.PROJ + 4 * (PROJ_STRIDE / 2); const bf16* K = F.PROJ + 5 * (PROJ_STRIDE / 2); const bf16* V = F.PROJ + 6 * (PROJ_STRIDE / 2);
    r.Q = Q + ((size_t)bh * SEQ + (size_t)qb * 256) * HD; r.K = K + (size_t)bh * SEQ * HD; r.V = V + (size_t)bh * SEQ * HD;
    r.bh = bh; r.qb = qb; r.m0 = b * SEQ + qb * 256; return r;
}
__device__ __forceinline__ void p3_attn(Frame& F, char* lds, bool before_conv, moba::Seam& S) {
    static_assert(moba::LDS_BYTES <= RING_BYTES, "attention LDS vs ring");
    moba::Ctx C{F.KMEAN, F.PROJ + 7 * (PROJ_STRIDE / 2), F.Y, F.SSQ, FP8_OUT ? Y8A_SCALE : 0.0f};
    for (int L = F.vcu; L < BATCH * NH * 4; L += F.G) {
        const int bh = L >> 2, x = L & 3;
        const moba::BlockRef r0 = moba_ref(F, bh, x), r1 = moba_ref(F, bh, 7 - x);
        if (before_conv) { moba::moba_prime_issue(r0, C, S); return; }
        if (L != F.vcu) moba::moba_prime_issue(r0, C, S);
        moba::moba_prime_finish(lds, S);
        moba::moba_block(r0, r1, C, lds, S);
        moba::moba_block(r1, r1, C, lds, S);
    }
}
struct Args { const float* in[9]; float* out; unsigned char* ws; int ph_lo, ph_hi, li, pad; };
__global__ void __launch_bounds__(NWAVES * 64, 2) skel_fwd(Args args) {
    extern __shared__ __attribute__((aligned(16))) unsigned char lds[];
    Frame F;
    F.lds = (LAS unsigned char*)lds;
    F.MISC = (volatile LAS unsigned*)(F.lds + MISC_OFF);
    F.tid = threadIdx.x; F.lane = F.tid & 63; F.wave = __builtin_amdgcn_readfirstlane(F.tid >> 6);
    F.G = gridDim.x; { const int bx = blockIdx.x; F.vcu = (F.G % 8 == 0) ? (bx % 8) * (F.G / 8) + bx / 8 : bx; }
#define GRID_BAR(seam) do { if (!ONE_LAUNCH) { if (F.tid == 0) __hip_atomic_store(F.ctl + CW_TMO, 0xBADBA0u | (unsigned)(seam), RLX_AGENT); } \
    else if ((seam) != 0 && MK_LOCBAR && F.MISC[10]) { xcd_barrier_local(bar); }     \
    else { xcd_barrier(bar); } } while (0)
    unsigned char* ws = args.ws;
    F.ctl = (gu32*)(ws + WS_CTL);
    F.x = args.in[0]; F.norm_gain = args.in[1]; F.w_in = args.in[2]; F.conv_w = args.in[3]; F.qg = args.in[4]; F.kg = args.in[5];
    F.cog = args.in[6]; F.aog = args.in[7]; F.w_out = args.in[8]; F.out = args.out;
    F.WinT = (bf16*)(ws + WS_WIN); F.WoutT = (bf16*)(ws + WS_WOUT); F.XN = (bf16*)(ws + WS_XN); F.PROJ = (bf16*)(ws + WS_PROJ); F.Y = (bf16*)(ws + WS_Y);
    F.KMEAN = (float*)(ws + WS_KMEAN); F.SSQ = (float*)(ws + WS_SSQ); F.XRS = (float*)(ws + WS_XRS); F.XN8 = ws + WS_XN8; F.Win8 = ws + WS_WIN8;
    for (int u = F.tid; u < (LDS_BYTES - LDSCTL_OFF) / 4; u += NWAVES * 64) ((LAS unsigned*)(F.lds + LDSCTL_OFF))[u] = 0u;
    __syncthreads();
    XcdBarrier bar; bar.bar = (unsigned*)(F.ctl + CW_BAR); bar.x = 0; bar.st = nullptr;
    if (ONE_LAUNCH) { bar = xcd_barrier_post((unsigned*)(F.ctl + CW_BAR), F.MISC + 8);
        if (F.tid == 0 && (bar.x != ((unsigned)blockIdx.x & 7u) || (F.G & 7) != 0 || F.G != 256)) (void)xb_add(&bar.bar[XB_MIS], 1u); }

    const int lo = args.ph_lo, hi = args.ph_hi;
#define IN(k) (lo <= (k) && (k) < hi)
#define BOTH(k) (IN(k) && IN((k) + 1))

    if (IN(0)) { p0_prologue(F, false); p0_prologue(F, true);
        if (BOTH(0)) { GRID_BAR(0); if (F.tid == 0) F.MISC[10] = (ONE_LAUNCH && xb_ld(&bar.bar[XB_MIS]) == 0u) ? 1u : 0u; __syncthreads(); } }

    if (IN(1)) {
        {
        { pg8::Gemm g{F.XN, F.WinT, M, DIN - NF8 * 1024, DM}; pg8::StaticOrder S; S.init(M, DIN - NF8 * 1024, F.G, (int)blockIdx.x);
        pg8::EpiProj E{F.PROJ, PROJ_STRIDE / 2, F.qg, F.kg, F.KMEAN, F.lds + 131072, EPS, 4 * NF8, PORD, 1.0f};
        pg8::gemm_phase<pg8::EpiProj, pg8::StaticOrder, true, PG8_SP2>(F.lds + RING_OFF, g, S, E); }
        if constexpr (NF8 > 0) {
            pg8::Gemm g{(const bf16*)F.XN8, (const bf16*)F.Win8, M, NF8 * 1024, DM / 2}; pg8::StaticOrder S; S.init(M, NF8 * 1024, F.G, (int)blockIdx.x);
            pg8::EpiProj E{F.PROJ, PROJ_STRIDE / 2, F.qg, F.kg, F.KMEAN, F.lds + 131072, EPS, 0, PORD, 1.0f / (X8_SCALE * WI8_SCALE)};
            pg8::gemm_phase<pg8::EpiProj, pg8::StaticOrder, true, PG8_SP2_FP8, true>(F.lds + RING_OFF, g, S, E); }
 }
        if (BOTH(1)) GRID_BAR(1);
    }
    if (IN(2)) {
        moba::Seam S;
        p3_attn(F, (char*)lds, true, S);
        p2_conv(F);
        p3_attn(F, (char*)lds, false, S);
        if (BOTH(2)) GRID_BAR(2);
    }
    if (IN(3)) {
        pg8::Gemm g{F.Y, F.WoutT, M, DM, FP8_OUT ? DMIX / 2 : DMIX}; pg8::StaticOrder S; S.init(M, DM, F.G, (int)blockIdx.x);
        pg8::EpiOut E{F.XN, F.XRS, F.out, DM, F.SSQ, EPS, (LAS float*)(F.lds + 131072), FP8_OUT ? 1.0f / (Y8A_SCALE * W8_SCALE) : (HYBP > 0 ? 1.0f / HYB_ALL : 1.0f), FP8_OUT ? Y8A_SCALE / Y8C_SCALE : 1.0f};
        pg8::gemm_phase<pg8::EpiOut, pg8::StaticOrder, true, (FP8_OUT ? PG8_SP2_FP8 : PG8_SP2), FP8_OUT, (FP8_OUT ? 0 : HYBP)>(F.lds + RING_OFF, g, S, E);
    }
#undef IN
#undef BOTH
}

extern "C" void kernel_launch(void* const* d_in, const int* in_sizes, int n_in, void* d_out, int out_size, void* d_ws, size_t ws_size, hipStream_t stream) {
    static int grid = 0;
    if (grid == 0) {
        if (n_in != 9 || in_sizes[0] != M * DM || out_size != M * DM || ws_size < WS_END) { fprintf(stderr, "kernel_launch: shape/workspace mismatch (n_in %d, in0 %d, out %d, ws %zu)\n", n_in, n_in > 0 ? in_sizes[0] : -1, out_size, ws_size); grid = -1; return; }
        int dev = 0, cus = 0;
        if (hipGetDevice(&dev) != hipSuccess || hipDeviceGetAttribute(&cus, hipDeviceAttributeMultiprocessorCount, dev) != hipSuccess) { fprintf(stderr, "kernel_launch: device query failed\n"); grid = -1; return; }
        if (hipFuncSetAttribute((const void*)skel_fwd, hipFuncAttributeMaxDynamicSharedMemorySize, LDS_BYTES) != hipSuccess) { fprintf(stderr, "kernel_launch: hipFuncSetAttribute failed\n"); grid = -1; return; }
        (void)hipGetLastError();
        grid = cus;
    }
    if (grid < 0) return;
    if (hipMemsetAsync((char*)d_ws + WS_CTL, 0, CTL_ZERO_BYTES, stream) != hipSuccess) { fprintf(stderr, "kernel_launch: hipMemsetAsync failed\n"); return; }
    Args a{};
    for (int i = 0; i < 9; ++i) a.in[i] = (const float*)d_in[i];
    a.out = (float*)d_out; a.ws = (unsigned char*)d_ws;
    if (ONE_LAUNCH) {
        a.ph_lo = 0; a.ph_hi = PER_PHASE; a.li = 0;
        hipLaunchKernelGGL(skel_fwd, dim3(grid), dim3(NWAVES * 64), LDS_BYTES, stream, a);
    } else {
        for (int li = 0; li < PER_PHASE; ++li) { a.ph_lo = li; a.ph_hi = li + 1; a.li = li;
            hipLaunchKernelGGL(skel_fwd, dim3(grid), dim3(NWAVES * 64), LDS_BYTES, stream, a); }
    }
}
```

```cpp
#define MK_NF8 6
#define MK_FP8_OUT 0
#define MK_HYB 2
#include <hip/hip_runtime.h>
#include <cstdio>
#include <cstdint>
namespace pg8 {
#define PG8_LAS __attribute__((address_space(3)))
typedef unsigned short bf16_t;
typedef short bf16x8 __attribute__((ext_vector_type(8)));
typedef float f32x4 __attribute__((ext_vector_type(4)));
typedef unsigned u32x4 __attribute__((ext_vector_type(4)));
constexpr int BM = 256, BK = 64, HALF = 128, HTB = HALF * BK * 2  , STAGE_BYTES = 8 * HTB, NXCD = 8, WGM = 8;

__host__ __device__ __forceinline__ int lds_byte(int r, int c) { const int st = (r >> 4) * 2 + (c >> 5), rr = r & 15, cc = c & 31, ob = rr * 64 + cc * 2; return st * 1024 + (ob ^ (((ob >> 9) & 1) << 5)); }
__host__ __device__ __forceinline__ void stage_rc(int b, int& R, int& C) { const int st = b / 1024, sb = b % 1024, swz = sb ^ (((sb >> 9) & 1) << 5); R = (st >> 1) * 16 + swz / 64; C = (st & 1) * 32 + (swz % 64) / 2; }
__host__ __device__ __forceinline__ int perm32(int rho) { const int n = rho >> 4, i = rho & 15; return 8 * (i >> 2) + 4 * n + (i & 3); }

struct Unit { int pm, pn; };
struct Gemm { const bf16_t* A; const bf16_t* Bt; int M, N, K; };

struct StaticOrder {
    int nM, nN, nwg, G, c;
    __host__ __device__ void init(int M, int N, int G_, int c_) { nM = M / BM; nN = N / BM; nwg = nM * nN; G = G_; c = c_; }
    __host__ __device__ bool next(int i, Unit& u) const {
        const long L = (long)i * G + c; if (L >= nwg) return false;
        int wgid = (int)L; { const int q = nwg / NXCD, r = nwg % NXCD, xcd = wgid % NXCD, off = wgid / NXCD; wgid = (xcd < r ? xcd * (q + 1) : r * (q + 1) + (xcd - r) * q) + off; }
        const int nig = WGM * nN, gid = wgid / nig, fm = gid * WGM, gsz = (nM - fm) < WGM ? (nM - fm) : WGM;
        u.pm = fm + ((wgid % nig) % gsz); u.pn = (wgid % nig) / gsz; return true;
    }
    __device__ __forceinline__ void a_ready(const Unit&) const {}
    __device__ __forceinline__ void done(const Unit&) const {}
};

__device__ __forceinline__ unsigned cvt_pk_bf16(float lo, float hi) { unsigned r; asm volatile("v_cvt_pk_bf16_f32 %0, %1, %2" : "=v"(r) : "v"(lo), "v"(hi)); return r; }

typedef float f32x2 __attribute__((ext_vector_type(2)));
struct EpiProj {
    static constexpr bool PERM = true, AFTER_DRAIN = false, MID = false, INIT = false;
    bf16_t* O; size_t tstride; const float* qg; const float* kg; float* kmean; PG8_LAS unsigned char* xl; float eps; int pn_off; unsigned order; float oscale;
    __device__ __forceinline__ void operator()(const f32x4 (&acc)[2][2][4][2], const Unit& u, int wr, int wc, int fr_, int fq_, int wid, int lane) const {
        asm volatile("" : "+v"(lane));
        const int fr = lane & 15, fq = lane >> 4;
        const int lt = u.pn + pn_off, t = (int)((order >> (4 * (lt >> 2))) & 15u), colw = (lt & 3) * BM;
        const int row0 = u.pm * BM + wr * 64 + fr;
        if (lt >= 16 && lt < 24) {
            bf16_t* pb = O + (size_t)row0 * 1024 + (lt & 7) * 128 + wc * 32 + 8 * fq;
            const float os2 = oscale * oscale;
#pragma unroll
            for (int ai = 0; ai < 2; ++ai)
#pragma unroll
                for (int m = 0; m < 4; ++m) { const f32x4 r0 = acc[ai][0][m][0] * acc[ai][1][m][0] * os2, r1 = acc[ai][0][m][1] * acc[ai][1][m][1] * os2;
                    u32x4 w; w.x = cvt_pk_bf16(r0[0], r0[1]); w.y = cvt_pk_bf16(r0[2], r0[3]); w.z = cvt_pk_bf16(r1[0], r1[1]); w.w = cvt_pk_bf16(r1[2], r1[3]);
                    *(u32x4*)(pb + (size_t)(ai * HALF + m * 16) * 1024) = w; }
            return;
        }
        bf16_t* base = O + (size_t)t * tstride;
        const int col0 = colw + wc * 32 + 8 * fq;
        const size_t hm0 = ((size_t)((u.pm >> 3) * 8 + (colw >> 7)) * 2048 + (size_t)((u.pm & 7) * BM + wr * 64 + fr)) * 128 + wc * 32 + 8 * fq;
        if (t != 4 && t != 5) {
#pragma unroll
            for (int ai = 0; ai < 2; ++ai)
#pragma unroll
                for (int m = 0; m < 4; ++m) { bf16_t* rowp = (t == 6) ? base + hm0 + (size_t)(ai * HALF + m * 16) * 128 : base + (size_t)(row0 + ai * HALF + m * 16) * 1024 + col0;
#pragma unroll
                    for (int bj = 0; bj < 2; ++bj) { const f32x4 v0 = acc[ai][bj][m][0] * oscale, v1 = acc[ai][bj][m][1] * oscale;
                        u32x4 w; w.x = cvt_pk_bf16(v0[0], v0[1]); w.y = cvt_pk_bf16(v0[2], v0[3]); w.z = cvt_pk_bf16(v1[0], v1[1]); w.w = cvt_pk_bf16(v1[2], v1[3]);
                        *(u32x4*)(rowp + ((t == 6) ? (size_t)bj * 2048 * 128 : (size_t)bj * HALF)) = w; } }
            return;
        }
        PG8_LAS float* P = (PG8_LAS float*)xl;
        PG8_LAS float* CS = (PG8_LAS float*)(xl + 8192);
        const float* gp = (t == 4 ? qg : kg) + wc * 32 + 8 * fq;
        const f32x4 g0 = *(const f32x4*)gp, g1 = *(const f32x4*)(gp + 4);
#pragma unroll
        for (int ai = 0; ai < 2; ++ai)
#pragma unroll
            for (int m = 0; m < 4; ++m)
#pragma unroll
                for (int bj = 0; bj < 2; ++bj) { const f32x4 a = acc[ai][bj][m][0], b = acc[ai][bj][m][1];
                    float s = ((a[0] * a[0] + a[1] * a[1]) + (a[2] * a[2] + a[3] * a[3])) + ((b[0] * b[0] + b[1] * b[1]) + (b[2] * b[2] + b[3] * b[3]));
                    s += __shfl_xor(s, 16); s += __shfl_xor(s, 32);
                    if (fq == 0) P[(ai * HALF + wr * 64 + m * 16 + fr) * 8 + bj * 4 + wc] = s; }
        asm volatile("s_waitcnt lgkmcnt(0)" ::: "memory"); __builtin_amdgcn_s_barrier(); asm volatile("" ::: "memory");
        f32x4 cs[2][2];
#pragma unroll
        for (int bj = 0; bj < 2; ++bj) { cs[bj][0] = (f32x4){0.f, 0.f, 0.f, 0.f}; cs[bj][1] = (f32x4){0.f, 0.f, 0.f, 0.f}; }
#pragma unroll
        for (int ai = 0; ai < 2; ++ai)
#pragma unroll
            for (int m = 0; m < 4; ++m) { const int rl = ai * HALF + wr * 64 + m * 16 + fr; bf16_t* rowp = base + hm0 + (size_t)(ai * HALF + m * 16) * 128;
#pragma unroll
                for (int bj = 0; bj < 2; ++bj) { const f32x4 p4 = *(const PG8_LAS f32x4*)(P + rl * 8 + bj * 4);
                    const float rs = 1.0f / sqrtf(((p4[0] + p4[1]) + (p4[2] + p4[3])) * (1.0f / 128.0f) + eps);
                    const f32x4 v0 = acc[ai][bj][m][0] * rs * g0, v1 = acc[ai][bj][m][1] * rs * g1;
                    cs[bj][0] += v0; cs[bj][1] += v1; asm volatile("" : "+v"(cs[bj][0]), "+v"(cs[bj][1]));
                    u32x4 w; w.x = cvt_pk_bf16(v0[0], v0[1]); w.y = cvt_pk_bf16(v0[2], v0[3]); w.z = cvt_pk_bf16(v1[0], v1[1]); w.w = cvt_pk_bf16(v1[2], v1[3]);
                    *(u32x4*)(rowp + (size_t)bj * 2048 * 128) = w; } }
        if (t == 5) {
#pragma unroll
            for (int bj = 0; bj < 2; ++bj)
#pragma unroll
                for (int n = 0; n < 2; ++n)
#pragma unroll
                    for (int e = 0; e < 4; ++e) { float s = cs[bj][n][e]; s += __shfl_xor(s, 1); s += __shfl_xor(s, 2); s += __shfl_xor(s, 4); s += __shfl_xor(s, 8); cs[bj][n][e] = s; }
            if (fr == 0) {
#pragma unroll
                for (int bj = 0; bj < 2; ++bj)
#pragma unroll
                    for (int n = 0; n < 2; ++n) *(PG8_LAS f32x4*)(CS + wr * 256 + bj * HALF + wc * 32 + 8 * fq + 4 * n) = cs[bj][n]; }
            asm volatile("s_waitcnt lgkmcnt(0)" ::: "memory"); __builtin_amdgcn_s_barrier(); asm volatile("" ::: "memory");
            const int tid = wid * 64 + lane;
            if (tid < 256) { const int b = u.pm >> 3, blk = u.pm & 7, head = (colw >> 7) + (tid >> 7);
                kmean[(size_t)((b * 8 + head) * 8 + blk) * 128 + (tid & 127)] = (CS[tid] + CS[256 + tid]) * (1.0f / 256.0f); }
        }
    }
};
struct EpiOut {
    static constexpr bool PERM = false, AFTER_DRAIN = false, MID = true, INIT = true;
    const bf16_t* xn; const float* xrs; float* out; int ldc;
     const float* ssq; float eps; PG8_LAS float* rrs; float fin, midk;
    __device__ __forceinline__ void mid(f32x4 (&acc)[2][2][4][2], const Unit& u, int wr, int wc, int fr, int fq) const {
        asm volatile("" : "+v"(fr));
        if (__builtin_amdgcn_readfirstlane(__builtin_bit_cast(int, rrs[512])) == u.pm) {
#pragma unroll
            for (int ai = 0; ai < 2; ++ai)
#pragma unroll
                for (int m = 0; m < 4; ++m) { const float s = rrs[256 + ai * HALF + wr * 64 + m * 16 + fr];
#pragma unroll
                    for (int bj = 0; bj < 2; ++bj)
#pragma unroll
                        for (int n = 0; n < 2; ++n) acc[ai][bj][m][n] *= s; }
            return;
        }
        if (wr == 0 && wc == 0 && fr == 0 && fq == 0) rrs[512] = __builtin_bit_cast(float, -1);
        const int row0 = u.pm * BM + wr * 64 + fr;
        f32x4 sa[2][4], sb[2][4];
#pragma unroll
        for (int ai = 0; ai < 2; ++ai)
#pragma unroll
            for (int m = 0; m < 4; ++m) { const float* sp = ssq + (size_t)(row0 + ai * HALF + m * 16) * 8; sa[ai][m] = *(const f32x4*)sp; sb[ai][m] = *(const f32x4*)(sp + 4); }
#pragma unroll
        for (int ai = 0; ai < 2; ++ai)
#pragma unroll
            for (int m = 0; m < 4; ++m) { const f32x4 a = sa[ai][m], b = sb[ai][m];
                const float v = (((a[0] + a[1]) + (a[2] + a[3])) + ((b[0] + b[1]) + (b[2] + b[3]))) * (1.0f / 1024.0f) + eps;
                const float s0 = sqrtf(v), s = s0 * midk;
                if (wc == 0 && fq == 0) rrs[ai * HALF + wr * 64 + m * 16 + fr] = fin / s0;
#pragma unroll
                for (int bj = 0; bj < 2; ++bj)
#pragma unroll
                    for (int n = 0; n < 2; ++n) acc[ai][bj][m][n] *= s; }
    }
    typedef unsigned u32x2 __attribute__((ext_vector_type(2)));
    __device__ __forceinline__ void init(f32x4 (&acc)[2][2][4][2], const Unit& u, int wr, int wc, int lane) const {
        asm volatile("" : "+v"(lane));
        const int fr = lane & 15, fq = lane >> 4;
        const int row0 = u.pm * BM + wr * 64 + fr, col0 = u.pn * BM + wc * 32 + 4 * fq; const float ik = 1.0f / (midk * fin);
#pragma unroll
        for (int g = 0; g < 8; ++g) { const int row = row0 + (g >> 2) * HALF + (g & 3) * 16; const float xs = xrs[row] * ik; const size_t off = (size_t)row * ldc + col0;
#pragma unroll
            for (int bj = 0; bj < 2; ++bj)
#pragma unroll
                for (int n = 0; n < 2; ++n) { const u32x2 w = *(const u32x2*)(xn + off + bj * HALF + n * 16);
                    acc[g >> 2][bj][g & 3][n] = (f32x4){__builtin_bit_cast(float, w.x << 16), __builtin_bit_cast(float, w.x & 0xffff0000u), __builtin_bit_cast(float, w.y << 16), __builtin_bit_cast(float, w.y & 0xffff0000u)} * xs; } }
        f32x4 sa[8], sb[8];
#pragma unroll
        for (int g = 0; g < 8; ++g) { const float* sp = ssq + (size_t)(row0 + (g >> 2) * HALF + (g & 3) * 16) * 8; sa[g] = *(const f32x4*)sp; sb[g] = *(const f32x4*)(sp + 4); }
#pragma unroll
        for (int g = 0; g < 8; ++g) { const f32x4 a = sa[g], b = sb[g];
            const float v = (((a[0] + a[1]) + (a[2] + a[3])) + ((b[0] + b[1]) + (b[2] + b[3]))) * (1.0f / 1024.0f) + eps; const float s0 = sqrtf(v);
            if (wc == 0 && fq == 0) { const int rl = (g >> 2) * HALF + wr * 64 + (g & 3) * 16 + fr; rrs[rl] = fin / s0; rrs[256 + rl] = s0 * midk; } }
        if (wr == 0 && wc == 0 && fr == 0 && fq == 0) rrs[512] = __builtin_bit_cast(float, u.pm);
    }
    __device__ __forceinline__ void operator()(f32x4 (&acc)[2][2][4][2], const Unit& u, int wr, int wc, int fr_, int fq_, int wid, int lane, bool has_next, const Unit& nx) const {
        asm volatile("" : "+v"(lane));
        const int fr = lane & 15, fq = lane >> 4;
        const int row0 = u.pm * BM + wr * 64 + fr, col0 = u.pn * BM + wc * 32 + 4 * fq;
        u32x2 xb[8][2][2]; float xs[8], rr[8];
        if (has_next) {
            const int rowN = nx.pm * BM + wr * 64 + fr, colN = nx.pn * BM + wc * 32 + 4 * fq;
#pragma unroll
            for (int g = 0; g < 8; ++g) { const float* sp = xrs + rowN + (g >> 2) * HALF + (g & 3) * 16; asm volatile("global_load_dword %0, %1, off" : "=v"(xs[g]) : "v"(sp) : "memory"); }
#pragma unroll
            for (int g = 0; g < 8; ++g) { const bf16_t* bp = xn + (size_t)(rowN + (g >> 2) * HALF + (g & 3) * 16) * ldc + colN;
#pragma unroll
                for (int bj = 0; bj < 2; ++bj)
#pragma unroll
                    for (int n = 0; n < 2; ++n) { const bf16_t* lp = bp + bj * HALF + n * 16; asm volatile("global_load_dwordx2 %0, %1, off" : "=v"(xb[g][bj][n]) : "v"(lp) : "memory"); } }
        }
#pragma unroll
        for (int g = 0; g < 8; ++g) rr[g] = rrs[(g >> 2) * HALF + wr * 64 + (g & 3) * 16 + fr];
#pragma unroll
        for (int g = 0; g < 8; ++g) { const size_t off = (size_t)(row0 + (g >> 2) * HALF + (g & 3) * 16) * ldc + col0;
#pragma unroll
            for (int bj = 0; bj < 2; ++bj)
#pragma unroll
                for (int n = 0; n < 2; ++n) *(f32x4*)(out + off + bj * HALF + n * 16) = acc[g >> 2][bj][g & 3][n] * rr[g]; }
        if (has_next) {
            asm volatile("s_waitcnt vmcnt(32)" : "+v"(xs[0]), "+v"(xs[1]), "+v"(xs[2]), "+v"(xs[3]), "+v"(xs[4]), "+v"(xs[5]), "+v"(xs[6]), "+v"(xs[7]),
                         "+v"(xb[0][0][0]), "+v"(xb[0][0][1]), "+v"(xb[0][1][0]), "+v"(xb[0][1][1]), "+v"(xb[1][0][0]), "+v"(xb[1][0][1]), "+v"(xb[1][1][0]), "+v"(xb[1][1][1]),
                         "+v"(xb[2][0][0]), "+v"(xb[2][0][1]), "+v"(xb[2][1][0]), "+v"(xb[2][1][1]) :: "memory");
            asm volatile("" : "+v"(xb[3][0][0]), "+v"(xb[3][0][1]), "+v"(xb[3][1][0]), "+v"(xb[3][1][1]), "+v"(xb[4][0][0]), "+v"(xb[4][0][1]), "+v"(xb[4][1][0]), "+v"(xb[4][1][1]),
                         "+v"(xb[5][0][0]), "+v"(xb[5][0][1]), "+v"(xb[5][1][0]), "+v"(xb[5][1][1]), "+v"(xb[6][0][0]), "+v"(xb[6][0][1]), "+v"(xb[6][1][0]), "+v"(xb[6][1][1]),
                         "+v"(xb[7][0][0]), "+v"(xb[7][0][1]), "+v"(xb[7][1][0]), "+v"(xb[7][1][1]) :: "memory");
            const float ik = 1.0f / (midk * fin);
#pragma unroll
            for (int g = 0; g < 8; ++g) { const float xsk = xs[g] * ik;
#pragma unroll
                for (int bj = 0; bj < 2; ++bj)
#pragma unroll
                    for (int n = 0; n < 2; ++n) { const u32x2 w = xb[g][bj][n];
                        acc[g >> 2][bj][g & 3][n] = (f32x4){__builtin_bit_cast(float, w.x << 16), __builtin_bit_cast(float, w.x & 0xffff0000u), __builtin_bit_cast(float, w.y << 16), __builtin_bit_cast(float, w.y & 0xffff0000u)} * xsk; } }
        }
    }
};

typedef int i32x4 __attribute__((ext_vector_type(4)));
typedef int i32x8 __attribute__((ext_vector_type(8)));
__device__ __forceinline__ i32x8 cat8(bf16x8 lo, bf16x8 hi) { const i32x4 a = __builtin_bit_cast(i32x4, lo), b = __builtin_bit_cast(i32x4, hi); return __builtin_shufflevector(a, b, 0, 1, 2, 3, 4, 5, 6, 7); }

#ifndef PG8_FP8ASM
#define PG8_FP8ASM 1
#endif
constexpr bool FP8ASM = (PG8_FP8ASM != 0);
template <class Epi, class Sched, bool ALIGN_EPI = false, bool SP2 = false, bool FP8 = false, int HYBP = 0>
__device__ __forceinline__ void gemm_phase(PG8_LAS unsigned char* lds, const Gemm g, const Sched& S, const Epi& E) {
    const int tid = threadIdx.x, wid = __builtin_amdgcn_readfirstlane(tid >> 6), lane = tid & 63, wr = wid >> 2, wc = wid & 3, fr = lane & 15, fq = lane >> 4;
    const int K = g.K, nt = K / BK;
    unsigned voffA[2], voffB[2];
#pragma unroll
    for (int i = 0; i < 2; ++i) { int R, C; stage_rc(tid * 16 + i * 8192, R, C); const int Rb = Epi::PERM ? ((R & ~31) + perm32(R & 31)) : R;
        voffA[i] = (unsigned)(R * K + C) * 2u; voffB[i] = (unsigned)(Rb * K + C) * 2u; }
    const size_t kstep = (size_t)(BK * 2);
    const size_t hstep = (size_t)HALF * K * 2;
    const size_t tstep = 2 * hstep;
    const unsigned ldsw = (unsigned)wid * 1024u;
    const int aoff = lds_byte(wr * 64 + fr, fq * 8), boff = lds_byte(wc * 32 + fr, fq * 8);
#define PG8_SA(b, h) (((b) * 2 + (h)) * HTB)
#define PG8_SB(b, h) ((4 + (b) * 2 + (h)) * HTB)
#define PG8_STAGE(bufoff, gbase, voff) do { _Pragma("unroll") for (int _i = 0; _i < 2; ++_i) \
        __builtin_amdgcn_global_load_lds((const unsigned*)((const char*)(gbase) + (voff)[_i]), (PG8_LAS unsigned*)(lds + (bufoff) + ldsw + _i * 8192), 16, 0, 0); } while (0)
#define PG8_LDA_(F8c, dst, b, h) do { if constexpr (F8c) { _Pragma("unroll") for (int m = 0; m < 4; ++m) dst##F[m] = cat8(*(const PG8_LAS bf16x8*)(lds + PG8_SA(b, h) + aoff + m * 2048), *(const PG8_LAS bf16x8*)(lds + PG8_SA(b, h) + aoff + m * 2048 + 1024)); } \
        else { _Pragma("unroll") for (int m = 0; m < 4; ++m) _Pragma("unroll") for (int k = 0; k < 2; ++k) dst[m][k] = *(const PG8_LAS bf16x8*)(lds + PG8_SA(b, h) + aoff + m * 2048 + k * 1024); } } while (0)
#define PG8_LDB_(F8c, dst, b, h) do { if constexpr (F8c) { _Pragma("unroll") for (int n = 0; n < 2; ++n) dst##F[n] = cat8(*(const PG8_LAS bf16x8*)(lds + PG8_SB(b, h) + boff + n * 2048), *(const PG8_LAS bf16x8*)(lds + PG8_SB(b, h) + boff + n * 2048 + 1024)); } \
        else { _Pragma("unroll") for (int n = 0; n < 2; ++n) _Pragma("unroll") for (int k = 0; k < 2; ++k) dst[n][k] = *(const PG8_LAS bf16x8*)(lds + PG8_SB(b, h) + boff + n * 2048 + k * 1024); } } while (0)
#define PG8_MMA_(F8c, ai, bj, At, Bt) do { __builtin_amdgcn_s_setprio(1); _Pragma("unroll") for (int m = 0; m < 4; ++m) _Pragma("unroll") for (int n = 0; n < 2; ++n) { \
        if constexpr (F8c) { if constexpr (FP8ASM) asm volatile("v_mfma_f32_16x16x128_f8f6f4 %0, %1, %2, %0" : "+v"(acc[ai][bj][m][n]) : "v"(Bt##F[n]), "v"(At##F[m])); \
            else acc[ai][bj][m][n] = __builtin_amdgcn_mfma_scale_f32_16x16x128_f8f6f4(Bt##F[n], At##F[m], acc[ai][bj][m][n], 0, 0, 0, 0, 0, 0); } \
        else { _Pragma("unroll") for (int k = 0; k < 2; ++k) acc[ai][bj][m][n] = __builtin_amdgcn_mfma_f32_16x16x32_bf16(Bt[n][k], At[m][k], acc[ai][bj][m][n], 0, 0, 0); } } \
        __builtin_amdgcn_s_setprio(0); } while (0)
#define PG8_LDA(dst, b, h) PG8_LDA_(FP8, dst, b, h)
#define PG8_LDB(dst, b, h) PG8_LDB_(FP8, dst, b, h)
#define PG8_MMA(ai, bj, At, Bt) PG8_MMA_(FP8, ai, bj, At, Bt)
#define PG8_WAIT_V(n) asm volatile("s_waitcnt vmcnt(" #n ")" ::: "memory")
#define PG8_WAIT_L(n) asm volatile("s_waitcnt lgkmcnt(" #n ")" ::: "memory")
#define PG8_BAR __builtin_amdgcn_s_barrier()
#define PG8_SCHED __builtin_amdgcn_sched_barrier(0)
#define PG8_ITER_SP2(F8c) do { \
            PG8_LDB_(F8c, B0, 0, 0); PG8_LDB_(F8c, B1, 0, 1); PG8_SCHED; PG8_LDA_(F8c, At, 0, 0); PG8_STAGE(PG8_SA(1, 1), a1 + hstep, voffA); \
            PG8_WAIT_V(8); PG8_WAIT_L(0); PG8_BAR; PG8_MMA_(F8c, 0, 0, At, B0); PG8_MMA_(F8c, 0, 1, At, B1); PG8_BAR; PG8_SCHED; \
            PG8_LDA_(F8c, At, 0, 1); PG8_STAGE(PG8_SB(0, 0), b2, voffB); PG8_STAGE(PG8_SB(0, 1), b2 + hstep, voffB); PG8_STAGE(PG8_SA(0, 0), a2, voffA); \
            PG8_WAIT_V(8); PG8_WAIT_L(0); PG8_BAR; PG8_MMA_(F8c, 1, 0, At, B0); PG8_MMA_(F8c, 1, 1, At, B1); PG8_BAR; PG8_SCHED; \
            PG8_LDB_(F8c, B0, 1, 0); PG8_LDB_(F8c, B1, 1, 1); PG8_SCHED; PG8_LDA_(F8c, At, 1, 0); PG8_STAGE(PG8_SA(0, 1), a2 + hstep, voffA); \
            PG8_WAIT_V(8); PG8_WAIT_L(0); PG8_BAR; PG8_MMA_(F8c, 0, 0, At, B0); PG8_MMA_(F8c, 0, 1, At, B1); PG8_BAR; PG8_SCHED; \
            PG8_LDA_(F8c, At, 1, 1); PG8_STAGE(PG8_SB(1, 0), b3, voffB); PG8_STAGE(PG8_SB(1, 1), b3 + hstep, voffB); PG8_STAGE(PG8_SA(1, 0), a3, voffA); \
            PG8_WAIT_V(8); PG8_WAIT_L(0); PG8_BAR; PG8_MMA_(F8c, 1, 0, At, B0); PG8_MMA_(F8c, 1, 1, At, B1); PG8_BAR; PG8_SCHED; \
            } while (0)
#define PG8_TSTEP(F8c) do { \
            const bool last = (t == ntl - 2); \
            const char* a1 = cA + (size_t)PG8_KT(t + 1) * kstep; \
            const char* a2 = last ? nA : cA + (size_t)PG8_KT(t + 2) * kstep; const char* b2 = last ? nB : cB + (size_t)PG8_KT(t + 2) * kstep; \
            const char* a3 = a2 + kstep; const char* b3 = b2 + kstep; \
            if (last && has_next) S.a_ready(nxt); \
            if constexpr (SP2) { \
            PG8_ITER_SP2(F8c); \
            } else { \
            PG8_LDB(B0, 0, 0); PG8_SCHED; PG8_LDA(At, 0, 0); PG8_STAGE(PG8_SA(1, 1), a1 + hstep, voffA); \
            PG8_WAIT_L(8); PG8_BAR; PG8_WAIT_L(0); PG8_MMA(0, 0, At, B0); PG8_BAR; PG8_SCHED; \
            PG8_LDB(B1, 0, 1); PG8_STAGE(PG8_SB(0, 0), b2, voffB); \
            PG8_BAR; PG8_WAIT_L(0); PG8_MMA(0, 1, At, B1); PG8_BAR; \
            PG8_LDA(At, 0, 1); PG8_STAGE(PG8_SA(0, 0), a2, voffA); \
            PG8_BAR; PG8_WAIT_L(0); PG8_MMA(1, 0, At, B0); PG8_BAR; PG8_SCHED; \
            PG8_STAGE(PG8_SB(0, 1), b2 + hstep, voffB); \
            PG8_WAIT_V(6); PG8_BAR; PG8_MMA(1, 1, At, B1); PG8_BAR; \
            PG8_LDB(B0, 1, 0); PG8_SCHED; PG8_LDA(At, 1, 0); PG8_STAGE(PG8_SA(0, 1), a2 + hstep, voffA); \
            PG8_WAIT_L(8); PG8_BAR; PG8_WAIT_L(0); PG8_MMA(0, 0, At, B0); PG8_BAR; PG8_SCHED; \
            PG8_LDB(B1, 1, 1); PG8_STAGE(PG8_SB(1, 0), b3, voffB); \
            PG8_BAR; PG8_WAIT_L(0); PG8_MMA(0, 1, At, B1); PG8_BAR; \
            PG8_LDA(At, 1, 1); PG8_STAGE(PG8_SA(1, 0), a3, voffA); \
            PG8_BAR; PG8_WAIT_L(0); PG8_MMA(1, 0, At, B0); PG8_BAR; PG8_SCHED; \
            PG8_STAGE(PG8_SB(1, 1), b3 + hstep, voffB); \
            PG8_WAIT_V(6); PG8_BAR; PG8_MMA(1, 1, At, B1); PG8_BAR; \
            } \
            if constexpr (Epi::MID) { if (t == nt / 2 - HSK - 2) { if constexpr (FP8 || (F8c)) asm volatile("s_nop 15\n\ts_nop 15" ::: "memory"); E.mid(acc, cur, wr, wc, fr, fq); } } \
        } while (0)
    Unit cur, nxt; int ui = 0;
    if (!S.next(0, cur)) return;
    f32x4 acc[2][2][4][2];
    if constexpr (Epi::INIT) { }
    else {
#pragma unroll
    for (int a = 0; a < 2; ++a)
#pragma unroll
        for (int b = 0; b < 2; ++b)
#pragma unroll
            for (int m = 0; m < 4; ++m)
#pragma unroll
                for (int n = 0; n < 2; ++n) acc[a][b][m][n] = (f32x4){0.f, 0.f, 0.f, 0.f}; }
    bf16x8 At[4][2], B0[2][2], B1[2][2]; i32x8 AtF[4], B0F[2], B1F[2];
    const char* cA = (const char*)g.A + (size_t)cur.pm * tstep; const char* cB = (const char*)g.Bt + (size_t)cur.pn * tstep;
    S.a_ready(cur);
    if constexpr (SP2) {
        PG8_STAGE(PG8_SB(0, 0), cB, voffB); PG8_STAGE(PG8_SB(0, 1), cB + hstep, voffB); PG8_STAGE(PG8_SA(0, 0), cA, voffA); PG8_STAGE(PG8_SA(0, 1), cA + hstep, voffA);
        if constexpr (Epi::INIT) {
            PG8_STAGE(PG8_SB(1, 0), cB + kstep, voffB); PG8_STAGE(PG8_SA(1, 0), cA + kstep, voffA); PG8_STAGE(PG8_SB(1, 1), cB + hstep + kstep, voffB);
            E.init(acc, cur, wr, wc, lane); }
        if (wr == 1) PG8_BAR;
        PG8_WAIT_V(2); PG8_BAR;
        if constexpr (!Epi::INIT) { PG8_STAGE(PG8_SB(1, 0), cB + kstep, voffB); PG8_STAGE(PG8_SA(1, 0), cA + kstep, voffA); PG8_STAGE(PG8_SB(1, 1), cB + hstep + kstep, voffB); }
        PG8_WAIT_V(6); PG8_BAR;
    } else {
        PG8_STAGE(PG8_SB(0, 0), cB, voffB); PG8_STAGE(PG8_SA(0, 0), cA, voffA); PG8_STAGE(PG8_SB(0, 1), cB + hstep, voffB); PG8_STAGE(PG8_SA(0, 1), cA + hstep, voffA);
        if (wr == 1) PG8_BAR;
        PG8_WAIT_V(4); PG8_BAR;
        PG8_STAGE(PG8_SB(1, 0), cB + kstep, voffB); PG8_STAGE(PG8_SA(1, 0), cA + kstep, voffA); PG8_STAGE(PG8_SB(1, 1), cB + hstep + kstep, voffB);
        PG8_WAIT_V(6); PG8_BAR;
    }
    for (;;) {
        const bool has_next = S.next(ui + 1, nxt);
        const char* nA = has_next ? (const char*)g.A + (size_t)nxt.pm * tstep : cA; const char* nB = has_next ? (const char*)g.Bt + (size_t)nxt.pn * tstep : cB;
        constexpr int HSK = 2 * HYBP;
#define PG8_KT(i) ((HYBP > 0 && (i) >= HSK) ? (i) + HSK : (i))
        const int ntl = nt - HSK;
        if constexpr (HYBP > 0) { int t = 0; for (; t < HSK; t += 2) PG8_TSTEP(true); for (; t < ntl; t += 2) PG8_TSTEP(false); }
        else { for (int t = 0; t < ntl; t += 2) PG8_TSTEP(FP8); }
        if constexpr (ALIGN_EPI) { if (wr == 0) PG8_BAR; }
        if constexpr (FP8) asm volatile("s_nop 15\n\ts_nop 15" ::: "memory");
        if constexpr (!Epi::AFTER_DRAIN) { if constexpr (Epi::INIT) E(acc, cur, wr, wc, fr, fq, wid, lane, has_next, nxt); else E(acc, cur, wr, wc, fr, fq, wid, lane); S.done(cur); }
        if (!has_next) break;
        if constexpr (!Epi::INIT) {
#pragma unroll
        for (int a = 0; a < 2; ++a)
#pragma unroll
            for (int b = 0; b < 2; ++b)
#pragma unroll
                for (int m = 0; m < 4; ++m)
#pragma unroll
                    for (int n = 0; n < 2; ++n) acc[a][b][m][n] = (f32x4){0.f, 0.f, 0.f, 0.f}; }
        cur = nxt; cA = nA; cB = nB; ++ui;
        if constexpr (ALIGN_EPI) { if (wr == 1) PG8_BAR; }
    }
    PG8_WAIT_V(0);
    if constexpr (!ALIGN_EPI) { if (wr == 0) PG8_BAR; }
    PG8_BAR;
    if constexpr (Epi::AFTER_DRAIN) { E.fused(acc, cur, wr, wc, fr, fq, lds, wid, lane); S.done(cur); }
#undef PG8_SA
#undef PG8_SB
#undef PG8_STAGE
#undef PG8_LDA
#undef PG8_LDB
#undef PG8_MMA
#undef PG8_MMA_
#undef PG8_LDA_
#undef PG8_LDB_
#undef PG8_ITER_SP2
#undef PG8_TSTEP
#undef PG8_KT
#undef PG8_WAIT_V
#undef PG8_WAIT_L
#undef PG8_BAR
#undef PG8_SCHED
}
}

#include <cmath>


#ifndef PG8_SP2
#define PG8_SP2 true
#endif
#ifndef PG8_SP2_FP8
#define PG8_SP2_FP8 true
#endif
#ifndef PG8_ALIGN
#define PG8_ALIGN true
#endif

constexpr int NWAVES = 8;
#ifndef MK_ONE_LAUNCH
#define MK_ONE_LAUNCH 1
#endif
constexpr int PER_PHASE = 4;
constexpr bool ONE_LAUNCH = (MK_ONE_LAUNCH != 0);

constexpr int BATCH = 8, SEQ = 2048, DM = 2048, M = BATCH * SEQ;
constexpr int DCONV = 1024, DATTN = 1024, NH = 8, HD = 128, DIN = 8192, DMIX = 2048;
constexpr int MBLK = 256, NBLK = SEQ / MBLK, TOPK = 3;
constexpr float EPS = 1e-6f;
constexpr float SM_SCALE = 0.08838834764831845f;
#ifndef MK_FP8_OUT
#define MK_FP8_OUT 1
#endif
#ifndef MK_NF8
#define MK_NF8 2
#endif
constexpr int NF8 = MK_NF8;
constexpr unsigned PORD = 0x54201367u;
constexpr unsigned PPOS = 0x01762534u;
constexpr float X8_SCALE = 1.0f, WI8_SCALE = 64.0f;
#ifndef MK_LOCBAR
#define MK_LOCBAR 1
#endif
#ifndef MK_HYB
#define MK_HYB 2
#endif
constexpr int HYBP = MK_HYB;
constexpr int HYBC = 256 * HYBP;
constexpr float HYB_Y = 4.0f, HYB_W = 64.0f, HYB_ALL = HYB_Y * HYB_W;
constexpr bool FP8_OUT = (MK_FP8_OUT != 0);
constexpr float Y8C_SCALE = 4.0f, Y8A_SCALE = 8.0f, W8_SCALE = 64.0f;

constexpr size_t MiB = 1u << 20;
constexpr size_t WS_CTL = 0, CTL_ZERO_BYTES = 32768;
constexpr size_t WS_WIN = 388 * MiB;
constexpr size_t WS_WOUT = 34 * MiB;
constexpr size_t WS_KMEAN = 42 * MiB;
constexpr size_t WS_XRS = 43 * MiB;
constexpr size_t WS_SSQ = 44 * MiB;
constexpr size_t WS_XN = 400 * MiB;
constexpr size_t WS_PROJ = 48 * MiB;
constexpr size_t PROJ_STRIDE = 32 * MiB;
constexpr size_t WS_Y = 320 * MiB;
constexpr size_t WS_XN8 = 464 * MiB;
constexpr size_t WS_WIN8 = 496 * MiB;
constexpr size_t WS_END = 510 * MiB;
static_assert(MK_NF8 == 6, "this workspace map gives the bf16 W_in^T copy only 12 MiB (the q and k rows)");
constexpr int CW_TMO = 0, CW_CODE = 1;
constexpr int CW_BAR = 4096;

constexpr int RING_OFF = 0, RING_BYTES = 141312;
constexpr int LDSCTL_OFF = RING_BYTES, MISC_OFF = LDSCTL_OFF + 320;
constexpr int LDS_BYTES = 147456;
static_assert(MISC_OFF + 128 <= LDS_BYTES, "LDS map");
static_assert(HYBP == 0 || HYBC == 512 || HYBC == 1024, "the conv mixer stores its j = 0 half (or both halves) as e4m3");

#define GAS __attribute__((address_space(1)))
#define LAS __attribute__((address_space(3)))
typedef unsigned short bf16;
typedef unsigned v4u __attribute__((ext_vector_type(4)));
typedef float f32x4 __attribute__((ext_vector_type(4)));
typedef short bf16x8 __attribute__((ext_vector_type(8)));
typedef GAS unsigned gu32;
typedef GAS unsigned long long gu64;
#define RLX_AGENT __ATOMIC_RELAXED, __HIP_MEMORY_SCOPE_AGENT
#define LDS_WAIT() asm volatile("s_waitcnt lgkmcnt(0)" ::: "memory")
#define VM_WAIT() asm volatile("s_waitcnt vmcnt(0)" ::: "memory")
__device__ __forceinline__ unsigned long long rt() { return __builtin_amdgcn_s_memrealtime(); }
__device__ __forceinline__ unsigned f2bf(float f) { unsigned u = __builtin_bit_cast(unsigned, f); return (u + 0x7fffu + ((u >> 16) & 1u)) >> 16; }
__device__ __forceinline__ unsigned pk2(float lo, float hi) { return f2bf(lo) | (f2bf(hi) << 16); }

#define XB_TMO      128
#define XB_XCNT(j)  (256  + 64 * (j))
#define XB_XSUB(j)  (1280 + 64 * (j))
#define XB_XGEN(j)  (2304 + 64 * (j))
#define XB_TOP      3328
#define XB_TOPGEN   3392
#define XB_MIS      3456
#define XCD_BAR_WORDS 3520
#define XB_SPIN_CAP (1u << 18)

__device__ __forceinline__ unsigned xb_ld(unsigned* p)              { return __hip_atomic_load(p, __ATOMIC_RELAXED, __HIP_MEMORY_SCOPE_AGENT); }
__device__ __forceinline__ unsigned xb_add(unsigned* p, unsigned v) { return __hip_atomic_fetch_add(p, v, __ATOMIC_RELAXED, __HIP_MEMORY_SCOPE_AGENT); }
__device__ __forceinline__ unsigned xb_xcc_id() { return (unsigned)__builtin_amdgcn_s_getreg((3 << 11) | 20) & 0xFu; }
#define XB_SPIN(cond, bar) do { unsigned _sp = 0; while (cond) { __builtin_amdgcn_s_sleep(1); \
    if ((++_sp & 255u) == 0u) { if (xb_ld(&(bar)[XB_TMO])) break; if (_sp > XB_SPIN_CAP) { atomicAdd(&(bar)[XB_TMO], 1u); break; } } } } while (0)

struct XcdBarrier {
    unsigned* bar; unsigned x;
    volatile LAS unsigned* st;
};

__device__ __forceinline__ XcdBarrier xcd_barrier_post(unsigned* bar, volatile LAS unsigned* st) {
    XcdBarrier b; b.bar = bar; b.x = xb_xcc_id(); b.st = st;
    if (threadIdx.x == 0) (void)xb_add(&bar[XB_XCNT(b.x)], 1u);
    return b;
}
__device__ __forceinline__ void xcd_barrier_complete(unsigned* bar, unsigned x, unsigned& nloc, unsigned& nx) {
    const unsigned G = gridDim.x * gridDim.y * gridDim.z;
    unsigned sum, cnt, mine, sp = 0u;
    for (;;) {
        sum = 0u; cnt = 0u; mine = 0u;
#pragma unroll
        for (unsigned j = 0; j < 16; ++j) { const unsigned c = xb_ld(&bar[XB_XCNT(j)]); sum += c; cnt += (c > 0u) ? 1u : 0u; mine = (j == x) ? c : mine; }
        if (sum == G) break;
        __builtin_amdgcn_s_sleep(1);
        if ((++sp & 255u) == 0u) { if (xb_ld(&bar[XB_TMO])) break; if (sp > XB_SPIN_CAP) { atomicAdd(&bar[XB_TMO], 1u); break; } }
    }
    nloc = mine > 0u ? mine : 1u; nx = cnt > 0u ? cnt : 1u;
}

__device__ __forceinline__ void xcd_barrier(const XcdBarrier& b) {
    asm volatile("s_waitcnt vmcnt(0)" ::: "memory");
    __syncthreads();
    if (threadIdx.x == 0) {
        unsigned* bar = b.bar;
        __builtin_amdgcn_s_waitcnt(0);
        unsigned nloc = b.st[0], nx = b.st[1];
        if (nloc == 0u) { xcd_barrier_complete(bar, b.x, nloc, nx); b.st[0] = nloc; b.st[1] = nx; }
        const unsigned old = xb_add(&bar[XB_XSUB(b.x)], 1u);
        const unsigned gen = old / nloc;
        if (old + 1u == (gen + 1u) * nloc) {
            __builtin_amdgcn_fence(__ATOMIC_RELEASE, "agent");
            asm volatile("s_waitcnt vmcnt(0)" ::: "memory");
            const unsigned og = xb_add(&bar[XB_TOP], 1u);
            const unsigned tg = og / nx;
            if (og + 1u == (tg + 1u) * nx) xb_add(&bar[XB_TOPGEN], 1u);
            else XB_SPIN(xb_ld(&bar[XB_TOPGEN]) == tg, bar);
            __builtin_amdgcn_fence(__ATOMIC_ACQUIRE, "agent");
            xb_add(&bar[XB_XGEN(b.x)], 1u);
            asm volatile("s_waitcnt vmcnt(0)" ::: "memory");
        } else {
            XB_SPIN(xb_ld(&bar[XB_XGEN(b.x)]) == gen, bar);
            __builtin_amdgcn_fence(__ATOMIC_ACQUIRE, "agent");
            asm volatile("s_waitcnt vmcnt(0)" ::: "memory");
        }
    }
    __syncthreads();
}

__device__ __forceinline__ void xcd_barrier_local(const XcdBarrier& b) {
    asm volatile("s_waitcnt vmcnt(0)" ::: "memory");
    __syncthreads();
    if (threadIdx.x == 0) {
        unsigned* bar = b.bar;
        __builtin_amdgcn_s_waitcnt(0);
        unsigned nloc = b.st[0], nx = b.st[1];
        if (nloc == 0u) { xcd_barrier_complete(bar, b.x, nloc, nx); b.st[0] = nloc; b.st[1] = nx; }
        const unsigned old = xb_add(&bar[XB_XSUB(b.x)], 1u);
        const unsigned gen = old / nloc;
        if (old + 1u == (gen + 1u) * nloc) xb_add(&bar[XB_XGEN(b.x)], 1u);
        else XB_SPIN(xb_ld(&bar[XB_XGEN(b.x)]) == gen, bar);
        __builtin_amdgcn_fence(__ATOMIC_ACQUIRE, "agent");
        asm volatile("s_waitcnt vmcnt(0)" ::: "memory");
    }
    __syncthreads();
}

namespace moba {
typedef short bf16x8 __attribute__((ext_vector_type(8)));
typedef short s16x4 __attribute__((ext_vector_type(4)));
typedef float f32x16 __attribute__((ext_vector_type(16)));
typedef float f32x4 __attribute__((ext_vector_type(4)));
typedef unsigned u32x4 __attribute__((ext_vector_type(4)));
typedef unsigned short bf16;
constexpr int D = 128, PITCH = 128, NW = 8, QBLK = 32, KVBLK = 64, QB = NW * QBLK;
constexpr int SHM_V = KVBLK * D * 2, SHM_K = KVBLK * D * 2;
constexpr int OFF_WSF = 2 * SHM_V + 2 * SHM_K, OFF_OST = OFF_WSF + NW * 64 * 4, OFF_KM = OFF_OST + NW * 8192, LDS_BYTES = OFF_KM + 8192;
constexpr float SCALE = 0.08838834764831845f, THR = 8.f;
#define KSWZ(row, colB) ((row) * 256 + ((colB) ^ (((row) & 7) << 4)))
#define SBAR() __builtin_amdgcn_sched_barrier(0)
__device__ __forceinline__ int v_st(int k, int c) { const int kk = (k & ~0xC) | ((k & 4) << 1) | ((k & 8) >> 1); return ((kk >> 3) * 4 + (c >> 5)) * 512 + ((kk & 7) * 32 + (c & 31)) * 2; }
__device__ __forceinline__ int v_rd_base(int lane) { return ((lane & 3) << 3) | (((lane >> 2) & 3) << 6) | (((lane >> 4) & 1) << 5) | (((lane >> 5) & 1) << 8); }
constexpr int v_rd_off(int d0, int ks, int half) { return d0 * 512 + ks * 4096 + half * 2048; }
__device__ __forceinline__ int crow(int r, int hi) { return (r & 3) + 8 * (r >> 2) + 4 * hi; }
__device__ __forceinline__ unsigned cvtpk(float lo, float hi) { unsigned r; asm volatile("v_cvt_pk_bf16_f32 %0, %1, %2" : "=v"(r) : "v"(lo), "v"(hi)); return r; }
__device__ __forceinline__ float bflo(unsigned w) { return __builtin_bit_cast(float, w << 16); }
__device__ __forceinline__ float bfhi(unsigned w) { return __builtin_bit_cast(float, w & 0xffff0000u); }
__device__ __forceinline__ void mask_tile(f32x16& p0, f32x16& p1, int dq) {
    const float NEG = -__builtin_inff();
#pragma unroll
    for (int r = 0; r < 16; ++r) { const int c = (r & 3) + 8 * (r >> 2); if (dq - c < 0) p0[r] = NEG; if (dq - c - 32 < 0) p1[r] = NEG; }
}
__device__ __forceinline__ void partialSM(f32x16& p0, f32x16& p1, float& m_reg, float& mn, float& alpha, bool masked) {
    float pmax = p0[0]; for (int r = 1; r < 16; ++r) pmax = fmaxf(pmax, p0[r]); for (int r = 0; r < 16; ++r) pmax = fmaxf(pmax, p1[r]);
    { auto rr = __builtin_amdgcn_permlane32_swap(__float_as_uint(pmax), __float_as_uint(pmax), false, false);
      pmax = fmaxf(__uint_as_float(rr[0]), __uint_as_float(rr[1])); }
    if (masked) pmax = -__builtin_inff();
    constexpr float C2 = 1.4426950408889634f * SCALE;
    if (__builtin_expect(__all((pmax - m_reg) * SCALE <= THR), 1)) { mn = m_reg; alpha = 1.f; }
    else { mn = fmaxf(m_reg, pmax); alpha = __builtin_amdgcn_exp2f((m_reg - mn) * C2); m_reg = mn; }
    const float mnL = masked ? -__builtin_inff() : -mn * C2;
    for (int r = 0; r < 16; ++r) p0[r] = fmaf(p0[r], C2, mnL); for (int r = 0; r < 16; ++r) p1[r] = fmaf(p1[r], C2, mnL);
    for (int r = 0; r < 16; ++r) p0[r] = __builtin_amdgcn_exp2f(p0[r]);
}
__device__ __forceinline__ void finishSM(f32x16& p0, f32x16& p1, float alpha, float& l_reg, bf16x8& pa0, bf16x8& pa1, bf16x8& pa2, bf16x8& pa3) {
    for (int r = 0; r < 16; ++r) p1[r] = __builtin_amdgcn_exp2f(p1[r]);
    float ps = 0; for (int r = 0; r < 16; ++r) ps += p0[r]; for (int r = 0; r < 16; ++r) ps += p1[r];
    { auto rr = __builtin_amdgcn_permlane32_swap(__float_as_uint(ps), __float_as_uint(ps), false, false);
      ps = __uint_as_float(rr[0]) + __uint_as_float(rr[1]); }
    l_reg = l_reg * alpha + ps;
#define PK4(P, B_, OUT) do { unsigned a0 = cvtpk(P[B_+0], P[B_+1]), a1 = cvtpk(P[B_+2], P[B_+3]);                          \
        unsigned b0 = cvtpk(P[B_+4], P[B_+5]), b1 = cvtpk(P[B_+6], P[B_+7]);                                             \
        auto r0 = __builtin_amdgcn_permlane32_swap(a0, b0, false, false); auto r1 = __builtin_amdgcn_permlane32_swap(a1, b1, false, false); \
        u32x4 w = {r0[0], r1[0], r0[1], r1[1]}; OUT = *reinterpret_cast<bf16x8*>(&w); } while (0)
    PK4(p0, 0, pa0); PK4(p0, 8, pa1); PK4(p1, 0, pa2); PK4(p1, 8, pa3);
#undef PK4
}
#ifndef MOBA_QLA
#define MOBA_QLA 3
#endif
template <int KB>
__device__ __forceinline__ void qkt(f32x16& p0, f32x16& p1, const char* K_lds, int r32, int hi, const bf16x8* qr) {
    p0 = f32x16{}; p1 = f32x16{};
    const char* kb[4];
#pragma unroll
    for (int dd = 0; dd < 4; ++dd) kb[dd] = K_lds + KB * SHM_K + KSWZ(r32, (dd * 16 + hi * 8) * 2);
    constexpr int QLA = MOBA_QLA;
    bf16x8 f0[8], f1[8];
#define QK_RD(d0) do { const char* a_ = kb[(d0) & 3] + ((d0) >> 2) * 128; f0[d0] = *reinterpret_cast<const bf16x8*>(a_); f1[d0] = *reinterpret_cast<const bf16x8*>(a_ + 32 * 256); } while (0)
#pragma unroll
    for (int d0 = 0; d0 < QLA; ++d0) QK_RD(d0);
    SBAR();
#pragma unroll
    for (int d0 = 0; d0 < 8; ++d0) {
        p0 = __builtin_amdgcn_mfma_f32_32x32x16_bf16(f0[d0], qr[d0], p0, 0, 0, 0);
        p1 = __builtin_amdgcn_mfma_f32_32x32x16_bf16(f1[d0], qr[d0], p1, 0, 0, 0);
        if (d0 + QLA < 8) { SBAR(); QK_RD(d0 + QLA); SBAR(); } }
#undef QK_RD
}
template <int VB>
__device__ __forceinline__ void pv_tile(f32x16* o, int vb0, bf16x8 pa0, bf16x8 pa1, bf16x8 pa2, bf16x8 pa3) {
#define TRRD(dst, off) asm volatile("ds_read_b64_tr_b16 %0, %1 offset:%2" : "=&v"(dst) : "v"(vb0), "i"(off) : "memory")
#define PV_D0(d0) do { s16x4 l0, l1, l2, l3, h0, h1, h2, h3; constexpr int b_ = VB * SHM_V + v_rd_off(d0, 0, 0); \
        TRRD(l0, b_); TRRD(h0, b_ + 2048); TRRD(l1, b_ + 4096); TRRD(h1, b_ + 6144); TRRD(l2, b_ + 8192); TRRD(h2, b_ + 10240); TRRD(l3, b_ + 12288); TRRD(h3, b_ + 14336); \
        asm volatile("s_waitcnt lgkmcnt(0)" ::: "memory"); SBAR();   \
        o[d0] = __builtin_amdgcn_mfma_f32_32x32x16_bf16(pa0, (bf16x8){l0[0], l0[1], l0[2], l0[3], h0[0], h0[1], h0[2], h0[3]}, o[d0], 0, 0, 0);   \
        o[d0] = __builtin_amdgcn_mfma_f32_32x32x16_bf16(pa1, (bf16x8){l1[0], l1[1], l1[2], l1[3], h1[0], h1[1], h1[2], h1[3]}, o[d0], 0, 0, 0);   \
        o[d0] = __builtin_amdgcn_mfma_f32_32x32x16_bf16(pa2, (bf16x8){l2[0], l2[1], l2[2], l2[3], h2[0], h2[1], h2[2], h2[3]}, o[d0], 0, 0, 0);   \
        o[d0] = __builtin_amdgcn_mfma_f32_32x32x16_bf16(pa3, (bf16x8){l3[0], l3[1], l3[2], l3[3], h3[0], h3[1], h3[2], h3[3]}, o[d0], 0, 0, 0); } while (0)
    PV_D0(0); PV_D0(1); PV_D0(2); PV_D0(3);
#undef PV_D0
#undef TRRD
}
template <int VB>
__device__ __forceinline__ void pv_sm(f32x16* o, int vb0, bf16x8 pa0, bf16x8 pa1, bf16x8 pa2, bf16x8 pa3, f32x16& p0, f32x16& p1, float& m_reg, float& mn, float& alpha, bool masked, bool domask, int dq) {
#define TRRD(dst, off) asm volatile("ds_read_b64_tr_b16 %0, %1 offset:%2" : "=&v"(dst) : "v"(vb0), "i"(off) : "memory")
#define PV_D0(d0) do { s16x4 l0, l1, l2, l3, h0, h1, h2, h3; constexpr int b_ = VB * SHM_V + v_rd_off(d0, 0, 0); \
        TRRD(l0, b_); TRRD(h0, b_ + 2048); TRRD(l1, b_ + 4096); TRRD(h1, b_ + 6144); TRRD(l2, b_ + 8192); TRRD(h2, b_ + 10240); TRRD(l3, b_ + 12288); TRRD(h3, b_ + 14336); \
        asm volatile("s_waitcnt lgkmcnt(0)" ::: "memory"); SBAR();   \
        o[d0] = __builtin_amdgcn_mfma_f32_32x32x16_bf16(pa0, (bf16x8){l0[0], l0[1], l0[2], l0[3], h0[0], h0[1], h0[2], h0[3]}, o[d0], 0, 0, 0);   \
        o[d0] = __builtin_amdgcn_mfma_f32_32x32x16_bf16(pa1, (bf16x8){l1[0], l1[1], l1[2], l1[3], h1[0], h1[1], h1[2], h1[3]}, o[d0], 0, 0, 0);   \
        o[d0] = __builtin_amdgcn_mfma_f32_32x32x16_bf16(pa2, (bf16x8){l2[0], l2[1], l2[2], l2[3], h2[0], h2[1], h2[2], h2[3]}, o[d0], 0, 0, 0);   \
        o[d0] = __builtin_amdgcn_mfma_f32_32x32x16_bf16(pa3, (bf16x8){l3[0], l3[1], l3[2], l3[3], h3[0], h3[1], h3[2], h3[3]}, o[d0], 0, 0, 0); } while (0)
    constexpr float C2 = 1.4426950408889634f * SCALE;
    PV_D0(0);
    if (domask) mask_tile(p0, p1, dq);
    float pmax = p0[0]; for (int r = 1; r < 16; ++r) pmax = fmaxf(pmax, p0[r]);
    SBAR();
    PV_D0(1);
    for (int r = 0; r < 16; ++r) pmax = fmaxf(pmax, p1[r]);
    { auto rr = __builtin_amdgcn_permlane32_swap(__float_as_uint(pmax), __float_as_uint(pmax), false, false);
      pmax = fmaxf(__uint_as_float(rr[0]), __uint_as_float(rr[1])); }
    if (masked) pmax = -__builtin_inff();
    if (__builtin_expect(__all((pmax - m_reg) * SCALE <= THR), 1)) { mn = m_reg; alpha = 1.f; }
    else { mn = fmaxf(m_reg, pmax); alpha = __builtin_amdgcn_exp2f((m_reg - mn) * C2); m_reg = mn; }
    const float mnL = masked ? -__builtin_inff() : -mn * C2;
    SBAR();
    PV_D0(2);
    for (int r = 0; r < 16; ++r) p0[r] = fmaf(p0[r], C2, mnL); for (int r = 0; r < 16; ++r) p1[r] = fmaf(p1[r], C2, mnL);
    SBAR();
    PV_D0(3);
    for (int r = 0; r < 16; ++r) p0[r] = __builtin_amdgcn_exp2f(p0[r]);
#undef PV_D0
#undef TRRD
}
struct BlockRef { const bf16* Q; const bf16* K; const bf16* V; int bh, qb, m0; };
struct Seam { bf16x8 qr[8]; bf16x8 st_v0, st_v1, st_k0, st_k1; };
struct Ctx { const float* kmean; const bf16* ZA; bf16* Y; float* SSQ; float y8; };
__device__ __forceinline__ bf16x8 ld8(const bf16* p) { return *reinterpret_cast<const bf16x8*>(p); }
__device__ __forceinline__ void write_km(const float* km, char* KM_lds, int tid) {
    asm volatile("" : "+v"(tid));
    if (tid < 256) { const int row = tid >> 4, ch = tid & 15, n = row & 7;
        const f32x4 a = *(const f32x4*)(km + n * 128 + ch * 8), b = *(const f32x4*)(km + n * 128 + ch * 8 + 4);
        float v[8] = {a[0], a[1], a[2], a[3], b[0], b[1], b[2], b[3]};
        if (row >= 8) {
#pragma unroll
            for (int e = 0; e < 8; e += 2) { const unsigned w = cvtpk(v[e], v[e + 1]); v[e] -= bflo(w); v[e + 1] -= bfhi(w); } }
        u32x4 w = {cvtpk(v[0], v[1]), cvtpk(v[2], v[3]), cvtpk(v[4], v[5]), cvtpk(v[6], v[7])};
        *(u32x4*)(KM_lds + KSWZ(row, ch * 16)) = w; }
}
#define ROW(p, k0, rr) ((p) + (size_t)((k0) + (rr)) * PITCH + sc)
#define VMW() asm volatile("s_waitcnt vmcnt(0)" ::: "memory")
#define VMWN(n) asm volatile("s_waitcnt vmcnt(%0)" :: "i"(n) : "memory")
#define SLOAD_H(Kp, Vp, k0) do { S.st_v0 = ld8(ROW(Vp, k0, sr)); S.st_v1 = ld8(ROW(Vp, k0, 32 + sr));              \
                         S.st_k0 = ld8(ROW(Kp, k0, sr)); S.st_k1 = ld8(ROW(Kp, k0, 32 + sr)); } while (0)
#define SWRITE_HK(bf) do { *(bf16x8*)(K_lds + (bf) * SHM_K + kws) = S.st_k0; *(bf16x8*)(K_lds + (bf) * SHM_K + kws + 32 * 256) = S.st_k1; } while (0)
#define SWRITE_HV(bf) do { *(bf16x8*)(V_lds + (bf) * SHM_V + vst0) = S.st_v0; *(bf16x8*)(V_lds + (bf) * SHM_V + vst1) = S.st_v1; } while (0)
#define SWRITE_H(bf) do { SWRITE_HV(bf); SWRITE_HK(bf); } while (0)
__device__ __forceinline__ void moba_prime(const BlockRef& cur, const Ctx& C, char* lds, Seam& S) {
    int tid_ = threadIdx.x; asm volatile("" : "+v"(tid_));
    const int tid = tid_, wid = __builtin_amdgcn_readfirstlane(tid >> 6), lane = tid & 63, r32 = lane & 31, hi = lane >> 5;
    const int sr = tid >> 4, sc = (tid & 15) * 8, kws = KSWZ(sr, sc * 2); char* K_lds = lds + 2 * SHM_V;
    for (int d0 = 0; d0 < 8; ++d0) S.qr[d0] = ld8(cur.Q + (size_t)(wid * QBLK + r32) * PITCH + d0 * 16 + hi * 8);
    SLOAD_H(cur.K, cur.V, 0); write_km(C.kmean + (size_t)cur.bh * 8 * 128, lds + OFF_KM, tid); VMW(); SWRITE_HK(0);
    __syncthreads();
}
__device__ __forceinline__ void moba_block(const BlockRef& cur, const BlockRef& nxt, const Ctx& C, char* lds, Seam& S) {
    int tid_ = threadIdx.x; asm volatile("" : "+v"(tid_));
    const int tid = tid_, wid = __builtin_amdgcn_readfirstlane(tid >> 6), lane = tid & 63, r32 = lane & 31, hi = lane >> 5;
    const int own = cur.qb, NT = 4 * (own + 1);
    const int qlo = own * QB + wid * QBLK, qm = qlo + r32 - 4 * hi;
    char* V_lds = lds; char* K_lds = lds + 2 * SHM_V;
    float* ws = (float*)(lds + OFF_WSF) + wid * 64; float* li_l = ws, * al_l = ws + 32;
    float m_reg = -1e30f, l_reg = 0; f32x16 o[4] = {};
    const int sr = tid >> 4, sc = (tid & 15) * 8, vst0 = v_st(sr, sc), vst1 = v_st(32 + sr, sc), kws = KSWZ(sr, sc * 2);
    const int vb0 = (int)(uintptr_t)V_lds + v_rd_base(lane);
    const bf16* Kh = cur.K; const bf16* Vh = cur.V;
    unsigned selmask = 0;
    {   f32x16 g = f32x16{};
        int gl = lane; asm volatile("" : "+v"(gl));
        const int gr = gl & 31, gh = gl >> 5;
        const char* kmb[4];
#pragma unroll
        for (int dd = 0; dd < 4; ++dd) kmb[dd] = lds + OFF_KM + KSWZ(gr, (dd * 16 + gh * 8) * 2);
#pragma unroll
        for (int d0 = 0; d0 < 8; ++d0) { const bf16x8 a = *reinterpret_cast<const bf16x8*>(kmb[d0 & 3] + (d0 >> 2) * 128); g = __builtin_amdgcn_mfma_f32_32x32x16_bf16(a, S.qr[d0], g, 0, 0, 0); }
        float gate[8];
#pragma unroll
        for (int i = 0; i < 4; ++i) { const float a = g[i] + g[4 + i]; auto rr = __builtin_amdgcn_permlane32_swap(__float_as_uint(a), __float_as_uint(a), false, false);
            gate[i] = __uint_as_float(rr[0]); gate[4 + i] = __uint_as_float(rr[1]); }
#pragma unroll
        for (int n = 0; n < 8; ++n) if (n >= own) gate[n] = -__builtin_inff();
#pragma unroll
        for (int n = 0; n < 8; ++n) { int rank = 0;
#pragma unroll
            for (int n2 = 0; n2 < 8; ++n2) if (n2 != n) rank += (gate[n2] > gate[n] || (gate[n2] == gate[n] && n2 < n)) ? 1 : 0;
            if (n < own && rank < 3) selmask |= 1u << n; }
    }
#define RESC(a) do { if (__any((a) < 1.f)) { if (hi == 0) al_l[r32] = (a); asm volatile("s_waitcnt lgkmcnt(0)" ::: "memory");              \
                     for (int d_ = 0; d_ < 4; ++d_) for (int r = 0; r < 16; ++r) o[d_][r] *= al_l[crow(r, hi)]; } } while (0)
#define KBASE(t) ((t) * KVBLK)
#define MASKED(t) (((t) >> 2) < own && !((selmask >> ((t) >> 2)) & 1u))
#define MASKT(P0_, P1_, t) do { const int kb_ = KBASE(t); if (((t) >> 2) == own && kb_ + KVBLK - 1 > qlo) mask_tile(P0_, P1_, qm - kb_); } while (0)
    constexpr int NQL = 8;
#define SEAM_K0() do { VMWN(NQL); SWRITE_HK(0); SBAR(); } while (0)
    f32x16 pA0, pA1, pB0, pB1; float mnA, mnB, alA, alB; bf16x8 pa0, pa1, pa2, pa3;
    SWRITE_HV(0); SBAR();
    SLOAD_H(Kh, Vh, KBASE(1));
    SBAR(); qkt<0>(pA0, pA1, K_lds, r32, hi, S.qr);
    MASKT(pA0, pA1, 0); partialSM(pA0, pA1, m_reg, mnA, alA, MASKED(0));
    VMW(); SWRITE_H(1);
    __syncthreads();
#define HALF_STEP(PX0, PX1, mnX, alX, PY0, PY1, alY, t, KB, VB, SB) do {                                                      \
        SBAR(); qkt<KB>(PX0, PX1, K_lds, r32, hi, S.qr);                                                         \
        finishSM(PY0, PY1, alY, l_reg, pa0, pa1, pa2, pa3); SBAR();                                                           \
        if ((t) + 1 < NT) { SLOAD_H(Kh, Vh, KBASE((t) + 1)); SBAR(); }                                               \
        pv_sm<VB>(o, vb0, pa0, pa1, pa2, pa3, PX0, PX1, m_reg, mnX, alX, MASKED(t), (((t) >> 2) == own && KBASE(t) + KVBLK - 1 > qlo), qm - KBASE(t));                \
        __syncthreads();                                                                                                      \
        if ((t) + 1 < NT) { VMW(); SWRITE_H(SB); }                                                                          \
        RESC(alX); __syncthreads(); } while (0)
    for (int t = 1; t + 1 < NT; t += 2) {
        HALF_STEP(pB0, pB1, mnB, alB, pA0, pA1, alA, t, 1, 0, 0);
        HALF_STEP(pA0, pA1, mnA, alA, pB0, pB1, alB, t + 1, 0, 1, 1);
    }
    SBAR(); qkt<1>(pB0, pB1, K_lds, r32, hi, S.qr); SBAR();
    SLOAD_H(nxt.K, nxt.V, 0); SBAR();
#pragma unroll
    for (int d0 = 0; d0 < 8; ++d0) S.qr[d0] = ld8(nxt.Q + (size_t)(wid * QBLK + r32) * PITCH + d0 * 16 + hi * 8);
    SBAR();
    finishSM(pA0, pA1, alA, l_reg, pa0, pa1, pa2, pa3); SBAR();
    pv_tile<0>(o, vb0, pa0, pa1, pa2, pa3);
    MASKT(pB0, pB1, NT - 1); partialSM(pB0, pB1, m_reg, mnB, alB, MASKED(NT - 1)); __syncthreads(); RESC(alB);
    finishSM(pB0, pB1, alB, l_reg, pa0, pa1, pa2, pa3); SBAR(); pv_tile<1>(o, vb0, pa0, pa1, pa2, pa3);
    SBAR(); SEAM_K0();
    if (nxt.bh != cur.bh) write_km(C.kmean + (size_t)nxt.bh * 8 * 128, lds + OFF_KM, tid);
    if (hi == 0) li_l[r32] = l_reg; asm volatile("s_waitcnt lgkmcnt(0)" ::: "memory");
    float rli[16];
#pragma unroll
    for (int r = 0; r < 16; ++r) rli[r] = __builtin_amdgcn_rcpf(li_l[crow(r, hi)]);
    {   int el = lane; asm volatile("" : "+v"(el));
        const int er32 = el & 31, ehi = el >> 5, erow = el >> 4, ech = el & 15;
        char* stg = lds + OFF_OST + wid * 8192;
        const int h = cur.bh & 7;
        const int mrow = cur.m0 + wid * QBLK;
        char* wb = stg + (4 * ehi) * 256 + er32 * 2;
#pragma unroll
        for (int r = 0; r < 16; ++r) {
#pragma unroll
            for (int d0 = 0; d0 < 4; ++d0) { const float v = o[d0][r] * rli[r]; const unsigned w = cvtpk(v, v);
                *(bf16*)(wb + ((r & 3) + 8 * (r >> 2)) * 256 + d0 * 64) = (bf16)(w & 0xffffu); } }
        asm volatile("s_waitcnt lgkmcnt(0)" ::: "memory"); SBAR();
        const char* rb = stg + erow * 256 + ech * 16;
        const bf16* zp = C.ZA + (size_t)(mrow + erow) * 1024 + h * 128 + ech * 8;
        bf16* yp = C.Y + (size_t)(mrow + erow) * 2048 + 1024 + h * 128 + ech * 8;
        unsigned char* yp8 = (unsigned char*)C.Y + (size_t)(mrow + erow) * 2048 + 1024 + h * 128 + ech * 8;
        float* sp = C.SSQ + (size_t)(mrow + erow) * 8 + h;
        u32x4 zz[8];
#pragma unroll
        for (int i = 0; i < 8; ++i) zz[i] = *(const u32x4*)(zp + (size_t)i * 4096);
#pragma unroll
        for (int i = 0; i < 8; ++i) {
            const u32x4 v = *(const u32x4*)(rb + i * 1024);
            float ov[8] = {bflo(v[0]), bfhi(v[0]), bflo(v[1]), bfhi(v[1]), bflo(v[2]), bfhi(v[2]), bflo(v[3]), bfhi(v[3])};
            float zv[8] = {bflo(zz[i][0]), bfhi(zz[i][0]), bflo(zz[i][1]), bfhi(zz[i][1]), bflo(zz[i][2]), bfhi(zz[i][2]), bflo(zz[i][3]), bfhi(zz[i][3])};
            float ss = 0.f, y[8];
#pragma unroll
            for (int e = 0; e < 8; ++e) { ss += ov[e] * ov[e]; y[e] = ov[e] * (zv[e] / (1.0f + __expf(-zv[e]))); }
            ss += __shfl_xor(ss, 1); ss += __shfl_xor(ss, 2); ss += __shfl_xor(ss, 4); ss += __shfl_xor(ss, 8);
            if (ech == 0) sp[i * 32] = ss;
            if (C.y8 != 0.0f) { typedef unsigned u32x2 __attribute__((ext_vector_type(2))); u32x2 w; unsigned t = 0;
#pragma unroll
                for (int e = 0; e < 8; ++e) y[e] = fminf(fmaxf(y[e] * C.y8, -448.0f), 448.0f);
                t = __builtin_amdgcn_cvt_pk_fp8_f32(y[0], y[1], t, false); t = __builtin_amdgcn_cvt_pk_fp8_f32(y[2], y[3], t, true); w.x = t; t = 0;
                t = __builtin_amdgcn_cvt_pk_fp8_f32(y[4], y[5], t, false); t = __builtin_amdgcn_cvt_pk_fp8_f32(y[6], y[7], t, true); w.y = t;
                *(u32x2*)(yp8 + (size_t)i * 8192) = w; }
            else { u32x4 w = {cvtpk(y[0], y[1]), cvtpk(y[2], y[3]), cvtpk(y[4], y[5]), cvtpk(y[6], y[7])};
            *(u32x4*)(yp + (size_t)i * 8192) = w; } }
    }
    __syncthreads();
#undef RESC
#undef KBASE
#undef MASKED
#undef MASKT
#undef SEAM_K0
#undef HALF_STEP
}
#undef ROW
#undef VMW
#undef VMWN
#undef SLOAD_H
#undef SWRITE_HK
#undef SWRITE_HV
#undef SWRITE_H
#undef KSWZ
#undef SBAR
}


struct Frame {
    LAS unsigned char* lds;
    volatile LAS unsigned* MISC;
    gu32* ctl;
    int tid, lane, wave;
    int vcu, G;
    const float *x, *norm_gain, *w_in, *conv_w, *qg, *kg, *cog, *aog, *w_out; float* out;
    bf16 *WinT, *WoutT, *XN, *PROJ, *Y; float *KMEAN, *SSQ, *XRS; unsigned char *XN8, *Win8;
};

__device__ __forceinline__ float wave_sum(float v) {
#pragma unroll
    for (int o = 1; o < 64; o <<= 1) v += __shfl_xor(v, o);
    return v;
}
__device__ __forceinline__ float wave_max(float v) {
#pragma unroll
    for (int o = 1; o < 64; o <<= 1) v = fmaxf(v, __shfl_xor(v, o));
    return v;
}
__device__ __forceinline__ float bf_lo(unsigned w) { return __builtin_bit_cast(float, w << 16); }
__device__ __forceinline__ float bf_hi(unsigned w) { return __builtin_bit_cast(float, w & 0xffff0000u); }
__device__ __forceinline__ float silu_f(float z) { return z / (1.0f + __expf(-z)); }
__device__ __forceinline__ float clamp8(float v) { return fminf(fmaxf(v, -448.0f), 448.0f); }
__device__ __forceinline__ unsigned pk4_fp8(float a, float b, float c, float d) { a = clamp8(a); b = clamp8(b); c = clamp8(c); d = clamp8(d); unsigned w = 0; w = __builtin_amdgcn_cvt_pk_fp8_f32(a, b, w, false); w = __builtin_amdgcn_cvt_pk_fp8_f32(c, d, w, true); return w; }

__device__ __forceinline__ void p0_transpose_item(const float* W, const float* g0, const float* g1, int ksplit, int K, int N, bf16* WT, LAS float* scr, int item, int lane, bool fp8 = false, float wscale = 1.0f, int drow = -1, int pitch8 = 0) {
    const int nblk = N / 32, kb = item / nblk, nb = item % nblk, k0 = 64 * kb, n0 = 32 * nb, d0 = drow >= 0 ? drow : n0;
    float wv[32];
    const float* wp = W + (size_t)(k0 + (lane >> 5)) * N + n0 + (lane & 31);
#pragma unroll
    for (int i = 0; i < 32; ++i) wv[i] = __builtin_nontemporal_load(wp + (size_t)(2 * i) * N);
    const float* gp = (k0 < ksplit) ? g0 + k0 : g1 + (k0 - ksplit);
    const float gl = gp[lane];
#pragma unroll
    for (int i = 0; i < 32; ++i) { const int kk = 2 * i + (lane >> 5); const float gv = __shfl(gl, kk);
        scr[kk * 33 + (lane & 31)] = wv[i] * gv; }
    LDS_WAIT(); asm volatile("" ::: "memory");
    const int c = lane & 7;
#pragma unroll
    for (int j = 0; j < 4; ++j) { const int n = (lane >> 3) + 8 * j; const LAS float* s = scr + (8 * c) * 33 + n;
        if (fp8) { typedef unsigned u32x2g __attribute__((ext_vector_type(2))); u32x2g o;
            o.x = pk4_fp8(s[0 * 33] * wscale, s[1 * 33] * wscale, s[2 * 33] * wscale, s[3 * 33] * wscale); o.y = pk4_fp8(s[4 * 33] * wscale, s[5 * 33] * wscale, s[6 * 33] * wscale, s[7 * 33] * wscale);
            *(GAS u32x2g*)((unsigned char*)WT + (size_t)(d0 + n) * (pitch8 ? pitch8 : K) + k0 + 8 * c) = o; }
        else { v4u o; o.x = pk2(s[0 * 33] * wscale, s[1 * 33] * wscale); o.y = pk2(s[2 * 33] * wscale, s[3 * 33] * wscale); o.z = pk2(s[4 * 33] * wscale, s[5 * 33] * wscale); o.w = pk2(s[6 * 33] * wscale, s[7 * 33] * wscale);
        *(GAS v4u*)(WT + (size_t)(d0 + n) * K + k0 + 8 * c) = o; } }
    LDS_WAIT(); asm volatile("" ::: "memory");
}
__device__ __forceinline__ void rms_row_to_bf16(Frame& F, const float* xrow, bf16* orow) {
    const GAS f32x4* xr = (const GAS f32x4*)xrow + F.lane;
    f32x4 v[8]; float s = 0.f;
#pragma unroll
    for (int j = 0; j < 8; ++j) { v[j] = xr[64 * j]; s += (v[j].x * v[j].x + v[j].y * v[j].y) + (v[j].z * v[j].z + v[j].w * v[j].w); }
    const float rs = 1.f / sqrtf(wave_sum(s) * (1.f / DM) + EPS);
    GAS unsigned long long* o8 = (GAS unsigned long long*)orow + F.lane;
#pragma unroll
    for (int j = 0; j < 8; ++j) o8[64 * j] = (unsigned long long)pk2(v[j].x * rs, v[j].y * rs) | ((unsigned long long)pk2(v[j].z * rs, v[j].w * rs) << 32);
}
__device__ __forceinline__ void rms_row2_to_bf16(Frame& F, const float* xrow, bf16* orow, size_t rstride) {
    const GAS f32x4* xa = (const GAS f32x4*)xrow + F.lane; const GAS f32x4* xb = (const GAS f32x4*)(xrow + rstride) + F.lane;
    f32x4 va[8], vb[8]; float sa = 0.f, sb = 0.f;
#pragma unroll
    for (int j = 0; j < 8; ++j) va[j] = __builtin_nontemporal_load(xa + 64 * j);
#pragma unroll
    for (int j = 0; j < 8; ++j) vb[j] = __builtin_nontemporal_load(xb + 64 * j);
#pragma unroll
    for (int j = 0; j < 8; ++j) sa += (va[j].x * va[j].x + va[j].y * va[j].y) + (va[j].z * va[j].z + va[j].w * va[j].w);
#pragma unroll
    for (int j = 0; j < 8; ++j) sb += (vb[j].x * vb[j].x + vb[j].y * vb[j].y) + (vb[j].z * vb[j].z + vb[j].w * vb[j].w);
    const float qa = sqrtf(wave_sum(sa) * (1.f / DM) + EPS), qb = sqrtf(wave_sum(sb) * (1.f / DM) + EPS), ra = 1.f / qa, rb = 1.f / qb;
    if (F.lane == 0) { const size_t m = (size_t)(orow - F.XN) / DM; F.XRS[m] = qa; F.XRS[m + rstride / DM] = qb; }
    GAS unsigned long long* oa = (GAS unsigned long long*)orow + F.lane; GAS unsigned long long* ob = (GAS unsigned long long*)(orow + rstride) + F.lane;
#pragma unroll
    for (int j = 0; j < 8; ++j) oa[64 * j] = (unsigned long long)pk2(va[j].x * ra, va[j].y * ra) | ((unsigned long long)pk2(va[j].z * ra, va[j].w * ra) << 32);
#pragma unroll
    for (int j = 0; j < 8; ++j) ob[64 * j] = (unsigned long long)pk2(vb[j].x * rb, vb[j].y * rb) | ((unsigned long long)pk2(vb[j].z * rb, vb[j].w * rb) << 32);
    if (NF8 > 0) { GAS unsigned* pa = (GAS unsigned*)(F.XN8 + (orow - F.XN)) + F.lane; GAS unsigned* pb = (GAS unsigned*)(F.XN8 + (orow - F.XN) + rstride) + F.lane;
#pragma unroll
        for (int j = 0; j < 8; ++j) { pa[64 * j] = pk4_fp8(va[j].x * ra, va[j].y * ra, va[j].z * ra, va[j].w * ra); pb[64 * j] = pk4_fp8(vb[j].x * rb, vb[j].y * rb, vb[j].z * rb, vb[j].w * rb); } }
}
__device__ __forceinline__ void p0_prologue(Frame& F, bool wout) {
    LAS float* scr = (LAS float*)(F.lds + RING_OFF + F.wave * 16384);
    const int gw = F.vcu * NWAVES + F.wave, NGW = F.G * NWAVES;
    constexpr int I_IN = (DM / 64) * (DIN / 32), I_OUT = (DMIX / 64) * (DM / 32);
    if (!wout) for (int m = gw; m < M; m += 2 * NGW) rms_row2_to_bf16(F, F.x + (size_t)m * DM, F.XN + (size_t)m * DM, (size_t)NGW * DM);
    for (int it = (wout ? I_IN : 0) + gw; it < (wout ? I_IN + I_OUT : I_IN); it += NGW) {
        if (it < I_IN) { const int n0 = 32 * (it % (DIN / 32)), ts = n0 >> 10, c0 = n0 & 1023; int lt0, roff;
            if (ts == 0 || ts == 2) { lt0 = 16 + (c0 >> 7); roff = (ts >> 1) * 128 + (c0 & 127); }
            else { lt0 = (int)((PPOS >> (4 * ts)) & 15u) * 4 + (c0 >> 8); roff = c0 & 255; }
            if ((lt0 >> 2) < NF8) p0_transpose_item(F.w_in, F.norm_gain, F.norm_gain, DM, DM, DIN, (bf16*)F.Win8, scr, it, F.lane, true, WI8_SCALE, lt0 * 256 + roff);
            else p0_transpose_item(F.w_in, F.norm_gain, F.norm_gain, DM, DM, DIN, F.WinT, scr, it, F.lane, false, 1.0f, (lt0 - 4 * NF8) * 256 + roff); }
        else if (HYBP > 0) { const int k0o = 64 * ((it - I_IN) / (DM / 32));
            if (k0o < HYBC) p0_transpose_item(F.w_out, F.cog, F.aog, DCONV, DMIX, DM, F.WoutT, scr, it - I_IN, F.lane, true, HYB_W, -1, DMIX * 2);
            else p0_transpose_item(F.w_out, F.cog, F.aog, DCONV, DMIX, DM, F.WoutT, scr, it - I_IN, F.lane, false, HYB_ALL); }
        else p0_transpose_item(F.w_out, F.cog, F.aog, DCONV, DMIX, DM, F.WoutT, scr, it - I_IN, F.lane, FP8_OUT, W8_SCALE);
    }
}

__device__ __forceinline__ void unpack8(const v4u a, float (&f)[16], int o) {
    f[o + 0] = bf_lo(a.x); f[o + 1] = bf_hi(a.x); f[o + 2] = bf_lo(a.y); f[o + 3] = bf_hi(a.y); f[o + 4] = bf_lo(a.z); f[o + 5] = bf_hi(a.z); f[o + 6] = bf_lo(a.w); f[o + 7] = bf_hi(a.w); }
__device__ __forceinline__ void p2_conv(Frame& F) {
    const int gw = F.vcu * NWAVES + F.wave, NGW = F.G * NWAVES;
    const bf16* UU = F.PROJ; const bf16* BG = F.PROJ + PROJ_STRIDE / 2; const bf16* ZC = F.PROJ + 3 * (PROJ_STRIDE / 2);
    for (int ck = gw; ck < M / 8; ck += NGW) {
        const int m0 = ck * 8, t0 = m0 % SEQ;
        const size_t co = (size_t)8 * F.lane;
        float w0[16], w1[16], w2[16], u1[16], u2[16];
#pragma unroll
        for (int j = 0; j < 2; ++j)
#pragma unroll
            for (int q = 0; q < 2; ++q) { const int c = 8 * F.lane + 512 * j + 4 * q;
                const f32x4 a = *(const GAS f32x4*)(F.conv_w + c), b = *(const GAS f32x4*)(F.conv_w + DCONV + c), d = *(const GAS f32x4*)(F.conv_w + 2 * DCONV + c);
#pragma unroll
                for (int e = 0; e < 4; ++e) { w0[8 * j + 4 * q + e] = a[e]; w1[8 * j + 4 * q + e] = b[e]; w2[8 * j + 4 * q + e] = d[e]; } }
        if (t0 > 0) {
#pragma unroll
            for (int j = 0; j < 2; ++j) { unpack8(__builtin_nontemporal_load((const GAS v4u*)(UU + (size_t)(m0 - 2) * 1024 + co + 512 * j)), u2, 8 * j); unpack8(__builtin_nontemporal_load((const GAS v4u*)(UU + (size_t)(m0 - 1) * 1024 + co + 512 * j)), u1, 8 * j); }
        } else {
#pragma unroll
            for (int e = 0; e < 16; ++e) { u1[e] = 0.f; u2[e] = 0.f; }
        }
#pragma unroll 2
        for (int i = 0; i < 8; ++i) {
            const size_t m = (size_t)(m0 + i);
            float u0[16], bb[16], zz[16], y[16];
#pragma unroll
            for (int j = 0; j < 2; ++j) { unpack8(__builtin_nontemporal_load((const GAS v4u*)(UU + m * 1024 + co + 512 * j)), u0, 8 * j);
                unpack8(__builtin_nontemporal_load((const GAS v4u*)(BG + m * 1024 + co + 512 * j)), bb, 8 * j); unpack8(__builtin_nontemporal_load((const GAS v4u*)(ZC + m * 1024 + co + 512 * j)), zz, 8 * j); }
            float ss = 0.f;
#pragma unroll
            for (int e = 0; e < 16; ++e) { const float cv = w0[e] * u2[e] + w1[e] * u1[e] + w2[e] * u0[e]; y[e] = bb[e] * cv; ss += y[e] * y[e]; u2[e] = u1[e]; u1[e] = u0[e]; }
            const float rs = 1.f / sqrtf(wave_sum(ss) * (1.f / DCONV) + EPS);
#pragma unroll
            for (int j = 0; j < 2; ++j) { float o[8];
#pragma unroll
                for (int e = 0; e < 8; ++e) o[e] = y[8 * j + e] * rs * silu_f(zz[8 * j + e]);
                if (HYBP > 0 && 512 * j < HYBC) { typedef unsigned u32x2g __attribute__((ext_vector_type(2))); u32x2g w;
                    w.x = pk4_fp8(o[0] * HYB_Y, o[1] * HYB_Y, o[2] * HYB_Y, o[3] * HYB_Y); w.y = pk4_fp8(o[4] * HYB_Y, o[5] * HYB_Y, o[6] * HYB_Y, o[7] * HYB_Y);
                    *(GAS u32x2g*)((unsigned char*)F.Y + m * (DMIX * 2) + co + 512 * j) = w; }
                else if (FP8_OUT) { typedef unsigned u32x2g __attribute__((ext_vector_type(2))); u32x2g w;
                    w.x = pk4_fp8(o[0] * Y8C_SCALE, o[1] * Y8C_SCALE, o[2] * Y8C_SCALE, o[3] * Y8C_SCALE); w.y = pk4_fp8(o[4] * Y8C_SCALE, o[5] * Y8C_SCALE, o[6] * Y8C_SCALE, o[7] * Y8C_SCALE);
                    *(GAS u32x2g*)((unsigned char*)F.Y + m * DMIX + co + 512 * j) = w; }
                else { v4u w; w.x = pk2(o[0], o[1]); w.y = pk2(o[2], o[3]); w.z = pk2(o[4], o[5]); w.w = pk2(o[6], o[7]);
                *(GAS v4u*)(F.Y + m * DMIX + co + 512 * j) = w; } }
        }
    }
}
__device__ __forceinline__ moba::BlockRef moba_ref(Frame& F, int bh, int qb) {
    const int b = bh >> 3, h = bh & 7; moba::BlockRef r;
    const bf16* Q = F.PROJ + 4 * (PROJ_STRIDE / 2); const bf16* K = F.PROJ + 5 * (PROJ_STRIDE / 2); const bf16* V = F.PROJ + 6 * (PROJ_STRIDE / 2);
    r.Q = Q + ((size_t)bh * SEQ + (size_t)qb * 256) * HD; r.K = K + (size_t)bh * SEQ * HD; r.V = V + (size_t)bh * SEQ * HD;
    r.bh = bh; r.qb = qb; r.m0 = b * SEQ + qb * 256; return r;
}
__device__ __forceinline__ void p3_attn(Frame& F, char* lds) {
    static_assert(moba::LDS_BYTES <= RING_BYTES, "attention LDS vs ring");
    moba::Ctx C{F.KMEAN, F.PROJ + 7 * (PROJ_STRIDE / 2), F.Y, F.SSQ, FP8_OUT ? Y8A_SCALE : 0.0f};
    for (int L = F.vcu; L < BATCH * NH * 4; L += F.G) {
        const int bh = L >> 2, x = L & 3;
        const moba::BlockRef r0 = moba_ref(F, bh, x), r1 = moba_ref(F, bh, 7 - x);
        moba::Seam S;
        moba::moba_prime(r0, C, lds, S);
        moba::moba_block(r0, r1, C, lds, S);
        moba::moba_block(r1, r1, C, lds, S);
    }
}
struct Args { const float* in[9]; float* out; unsigned char* ws; int ph_lo, ph_hi, li, pad; };
__global__ void __launch_bounds__(NWAVES * 64, 2) skel_fwd(Args args) {
    extern __shared__ __attribute__((aligned(16))) unsigned char lds[];
    Frame F;
    F.lds = (LAS unsigned char*)lds;
    F.MISC = (volatile LAS unsigned*)(F.lds + MISC_OFF);
    F.tid = threadIdx.x; F.lane = F.tid & 63; F.wave = __builtin_amdgcn_readfirstlane(F.tid >> 6);
    F.G = gridDim.x; { const int bx = blockIdx.x; F.vcu = (F.G % 8 == 0) ? (bx % 8) * (F.G / 8) + bx / 8 : bx; }
#define GRID_BAR(seam) do { if (!ONE_LAUNCH) { if (F.tid == 0) __hip_atomic_store(F.ctl + CW_TMO, 0xBADBA0u | (unsigned)(seam), RLX_AGENT); } \
    else if ((seam) != 0 && MK_LOCBAR && F.MISC[10]) { xcd_barrier_local(bar); }     \
    else { xcd_barrier(bar); } } while (0)
    unsigned char* ws = args.ws;
    F.ctl = (gu32*)(ws + WS_CTL);
    F.x = args.in[0]; F.norm_gain = args.in[1]; F.w_in = args.in[2]; F.conv_w = args.in[3]; F.qg = args.in[4]; F.kg = args.in[5];
    F.cog = args.in[6]; F.aog = args.in[7]; F.w_out = args.in[8]; F.out = args.out;
    F.WinT = (bf16*)(ws + WS_WIN); F.WoutT = (bf16*)(ws + WS_WOUT); F.XN = (bf16*)(ws + WS_XN); F.PROJ = (bf16*)(ws + WS_PROJ); F.Y = (bf16*)(ws + WS_Y);
    F.KMEAN = (float*)(ws + WS_KMEAN); F.SSQ = (float*)(ws + WS_SSQ); F.XRS = (float*)(ws + WS_XRS); F.XN8 = ws + WS_XN8; F.Win8 = ws + WS_WIN8;
    for (int u = F.tid; u < (LDS_BYTES - LDSCTL_OFF) / 4; u += NWAVES * 64) ((LAS unsigned*)(F.lds + LDSCTL_OFF))[u] = 0u;
    __syncthreads();
    XcdBarrier bar; bar.bar = (unsigned*)(F.ctl + CW_BAR); bar.x = 0; bar.st = nullptr;
    if (ONE_LAUNCH) { bar = xcd_barrier_post((unsigned*)(F.ctl + CW_BAR), F.MISC + 8);
        if (F.tid == 0 && (bar.x != ((unsigned)blockIdx.x & 7u) || (F.G & 7) != 0 || F.G != 256)) (void)xb_add(&bar.bar[XB_MIS], 1u); }

    const int lo = args.ph_lo, hi = args.ph_hi;
#define IN(k) (lo <= (k) && (k) < hi)
#define BOTH(k) (IN(k) && IN((k) + 1))

    if (IN(0)) { p0_prologue(F, false); p0_prologue(F, true);
        if (BOTH(0)) { GRID_BAR(0); if (F.tid == 0) F.MISC[10] = (ONE_LAUNCH && xb_ld(&bar.bar[XB_MIS]) == 0u) ? 1u : 0u; __syncthreads(); } }

    if (IN(1)) {
        {
        { pg8::Gemm g{F.XN, F.WinT, M, DIN - NF8 * 1024, DM}; pg8::StaticOrder S; S.init(M, DIN - NF8 * 1024, F.G, (int)blockIdx.x);
        pg8::EpiProj E{F.PROJ, PROJ_STRIDE / 2, F.qg, F.kg, F.KMEAN, F.lds + 131072, EPS, 4 * NF8, PORD, 1.0f};
        pg8::gemm_phase<pg8::EpiProj, pg8::StaticOrder, true, PG8_SP2>(F.lds + RING_OFF, g, S, E); }
        if constexpr (NF8 > 0) {
            pg8::Gemm g{(const bf16*)F.XN8, (const bf16*)F.Win8, M, NF8 * 1024, DM / 2}; pg8::StaticOrder S; S.init(M, NF8 * 1024, F.G, (int)blockIdx.x);
            pg8::EpiProj E{F.PROJ, PROJ_STRIDE / 2, F.qg, F.kg, F.KMEAN, F.lds + 131072, EPS, 0, PORD, 1.0f / (X8_SCALE * WI8_SCALE)};
            pg8::gemm_phase<pg8::EpiProj, pg8::StaticOrder, true, PG8_SP2_FP8, true>(F.lds + RING_OFF, g, S, E); }
 }
        if (BOTH(1)) GRID_BAR(1);
    }
    if (IN(2)) {
        p2_conv(F);
        p3_attn(F, (char*)lds);
        if (BOTH(2)) GRID_BAR(2);
    }
    if (IN(3)) {
        pg8::Gemm g{F.Y, F.WoutT, M, DM, FP8_OUT ? DMIX / 2 : DMIX}; pg8::StaticOrder S; S.init(M, DM, F.G, (int)blockIdx.x);
        pg8::EpiOut E{F.XN, F.XRS, F.out, DM, F.SSQ, EPS, (LAS float*)(F.lds + 131072), FP8_OUT ? 1.0f / (Y8A_SCALE * W8_SCALE) : (HYBP > 0 ? 1.0f / HYB_ALL : 1.0f), FP8_OUT ? Y8A_SCALE / Y8C_SCALE : 1.0f};
        pg8::gemm_phase<pg8::EpiOut, pg8::StaticOrder, true, (FP8_OUT ? PG8_SP2_FP8 : PG8_SP2), FP8_OUT, (FP8_OUT ? 0 : HYBP)>(F.lds + RING_OFF, g, S, E);
    }
#undef IN
#undef BOTH
}

extern "C" void kernel_launch(void* const* d_in, const int* in_sizes, int n_in, void* d_out, int out_size, void* d_ws, size_t ws_size, hipStream_t stream) {
    static int grid = 0;
    if (grid == 0) {
        if (n_in != 9 || in_sizes[0] != M * DM || out_size != M * DM || ws_size < WS_END) { fprintf(stderr, "kernel_launch: shape/workspace mismatch (n_in %d, in0 %d, out %d, ws %zu)\n", n_in, n_in > 0 ? in_sizes[0] : -1, out_size, ws_size); grid = -1; return; }
        int dev = 0, cus = 0;
        if (hipGetDevice(&dev) != hipSuccess || hipDeviceGetAttribute(&cus, hipDeviceAttributeMultiprocessorCount, dev) != hipSuccess) { fprintf(stderr, "kernel_launch: device query failed\n"); grid = -1; return; }
        if (hipFuncSetAttribute((const void*)skel_fwd, hipFuncAttributeMaxDynamicSharedMemorySize, LDS_BYTES) != hipSuccess) { fprintf(stderr, "kernel_launch: hipFuncSetAttribute failed\n"); grid = -1; return; }
        (void)hipGetLastError();
        grid = cus;
    }
    if (grid < 0) return;
    if (hipMemsetAsync((char*)d_ws + WS_CTL, 0, CTL_ZERO_BYTES, stream) != hipSuccess) { fprintf(stderr, "kernel_launch: hipMemsetAsync failed\n"); return; }
    Args a{};
    for (int i = 0; i < 9; ++i) a.in[i] = (const float*)d_in[i];
    a.out = (float*)d_out; a.ws = (unsigned char*)d_ws;
    if (ONE_LAUNCH) {
        a.ph_lo = 0; a.ph_hi = PER_PHASE; a.li = 0;
        hipLaunchKernelGGL(skel_fwd, dim3(grid), dim3(NWAVES * 64), LDS_BYTES, stream, a);
    } else {
        for (int li = 0; li < PER_PHASE; ++li) { a.ph_lo = li; a.ph_hi = li + 1; a.li = li;
            hipLaunchKernelGGL(skel_fwd, dim3(grid), dim3(NWAVES * 64), LDS_BYTES, stream, a); }
    }
}
```

```cpp
#define MK_NF8 6
#define MK_FP8_OUT 0
#define MK_HYB 2
#include <hip/hip_runtime.h>
#include <cstdio>
#include <cstdint>
namespace pg8 {
#define PG8_LAS __attribute__((address_space(3)))
typedef unsigned short bf16_t;
typedef short bf16x8 __attribute__((ext_vector_type(8)));
typedef float f32x4 __attribute__((ext_vector_type(4)));
typedef unsigned u32x4 __attribute__((ext_vector_type(4)));
constexpr int BM = 256, BK = 64, HALF = 128, HTB = HALF * BK * 2  , STAGE_BYTES = 8 * HTB, NXCD = 8, WGM = 8;

__host__ __device__ __forceinline__ int lds_byte(int r, int c) { const int st = (r >> 4) * 2 + (c >> 5), rr = r & 15, cc = c & 31, ob = rr * 64 + cc * 2; return st * 1024 + (ob ^ (((ob >> 9) & 1) << 5)); }
__host__ __device__ __forceinline__ void stage_rc(int b, int& R, int& C) { const int st = b / 1024, sb = b % 1024, swz = sb ^ (((sb >> 9) & 1) << 5); R = (st >> 1) * 16 + swz / 64; C = (st & 1) * 32 + (swz % 64) / 2; }
__host__ __device__ __forceinline__ int perm32(int rho) { const int n = rho >> 4, i = rho & 15; return 8 * (i >> 2) + 4 * n + (i & 3); }

struct Unit { int pm, pn; };
struct Gemm { const bf16_t* A; const bf16_t* Bt; int M, N, K; };

struct StaticOrder {
    int nM, nN, nwg, G, c;
    __host__ __device__ void init(int M, int N, int G_, int c_) { nM = M / BM; nN = N / BM; nwg = nM * nN; G = G_; c = c_; }
    __host__ __device__ bool next(int i, Unit& u) const {
        const long L = (long)i * G + c; if (L >= nwg) return false;
        int wgid = (int)L; { const int q = nwg / NXCD, r = nwg % NXCD, xcd = wgid % NXCD, off = wgid / NXCD; wgid = (xcd < r ? xcd * (q + 1) : r * (q + 1) + (xcd - r) * q) + off; }
        const int nig = WGM * nN, gid = wgid / nig, fm = gid * WGM, gsz = (nM - fm) < WGM ? (nM - fm) : WGM;
        u.pm = fm + ((wgid % nig) % gsz); u.pn = (wgid % nig) / gsz; return true;
    }
    __device__ __forceinline__ void a_ready(const Unit&) const {}
    __device__ __forceinline__ void done(const Unit&) const {}
};

__device__ __forceinline__ unsigned cvt_pk_bf16(float lo, float hi) { unsigned r; asm volatile("v_cvt_pk_bf16_f32 %0, %1, %2" : "=v"(r) : "v"(lo), "v"(hi)); return r; }

typedef float f32x2 __attribute__((ext_vector_type(2)));
struct EpiProj {
    static constexpr bool PERM = true, AFTER_DRAIN = false, MID = false, INIT = false;
    bf16_t* O; size_t tstride; const float* qg; const float* kg; float* kmean; PG8_LAS unsigned char* xl; float eps; int pn_off; unsigned order; float oscale;
    __device__ __forceinline__ void operator()(const f32x4 (&acc)[2][2][4][2], const Unit& u, int wr, int wc, int fr_, int fq_, int wid, int lane) const {
        asm volatile("" : "+v"(lane));
        const int fr = lane & 15, fq = lane >> 4;
        const int lt = u.pn + pn_off, t = (int)((order >> (4 * (lt >> 2))) & 15u), colw = (lt & 3) * BM;
        const int row0 = u.pm * BM + wr * 64 + fr;
        if (lt >= 16 && lt < 24) {
            bf16_t* pb = O + (size_t)row0 * 1024 + (lt & 7) * 128 + wc * 32 + 8 * fq;
            const float os2 = oscale * oscale;
#pragma unroll
            for (int ai = 0; ai < 2; ++ai)
#pragma unroll
                for (int m = 0; m < 4; ++m) { const f32x4 r0 = acc[ai][0][m][0] * acc[ai][1][m][0] * os2, r1 = acc[ai][0][m][1] * acc[ai][1][m][1] * os2;
                    u32x4 w; w.x = cvt_pk_bf16(r0[0], r0[1]); w.y = cvt_pk_bf16(r0[2], r0[3]); w.z = cvt_pk_bf16(r1[0], r1[1]); w.w = cvt_pk_bf16(r1[2], r1[3]);
                    *(u32x4*)(pb + (size_t)(ai * HALF + m * 16) * 1024) = w; }
            return;
        }
        bf16_t* base = O + (size_t)t * tstride;
        const int col0 = colw + wc * 32 + 8 * fq;
        const size_t hm0 = ((size_t)((u.pm >> 3) * 8 + (colw >> 7)) * 2048 + (size_t)((u.pm & 7) * BM + wr * 64 + fr)) * 128 + wc * 32 + 8 * fq;
        if (t != 4 && t != 5) {
#pragma unroll
            for (int ai = 0; ai < 2; ++ai)
#pragma unroll
                for (int m = 0; m < 4; ++m) { bf16_t* rowp = (t == 6) ? base + hm0 + (size_t)(ai * HALF + m * 16) * 128 : base + (size_t)(row0 + ai * HALF + m * 16) * 1024 + col0;
#pragma unroll
                    for (int bj = 0; bj < 2; ++bj) { const f32x4 v0 = acc[ai][bj][m][0] * oscale, v1 = acc[ai][bj][m][1] * oscale;
                        u32x4 w; w.x = cvt_pk_bf16(v0[0], v0[1]); w.y = cvt_pk_bf16(v0[2], v0[3]); w.z = cvt_pk_bf16(v1[0], v1[1]); w.w = cvt_pk_bf16(v1[2], v1[3]);
                        *(u32x4*)(rowp + ((t == 6) ? (size_t)bj * 2048 * 128 : (size_t)bj * HALF)) = w; } }
            return;
        }
        PG8_LAS float* P = (PG8_LAS float*)xl;
        PG8_LAS float* CS = (PG8_LAS float*)(xl + 8192);
        const float* gp = (t == 4 ? qg : kg) + wc * 32 + 8 * fq;
        const f32x4 g0 = *(const f32x4*)gp, g1 = *(const f32x4*)(gp + 4);
#pragma unroll
        for (int ai = 0; ai < 2; ++ai)
#pragma unroll
            for (int m = 0; m < 4; ++m)
#pragma unroll
                for (int bj = 0; bj < 2; ++bj) { const f32x4 a = acc[ai][bj][m][0], b = acc[ai][bj][m][1];
                    float s = ((a[0] * a[0] + a[1] * a[1]) + (a[2] * a[2] + a[3] * a[3])) + ((b[0] * b[0] + b[1] * b[1]) + (b[2] * b[2] + b[3] * b[3]));
                    s += __shfl_xor(s, 16); s += __shfl_xor(s, 32);
                    if (fq == 0) P[(ai * HALF + wr * 64 + m * 16 + fr) * 8 + bj * 4 + wc] = s; }
        asm volatile("s_waitcnt lgkmcnt(0)" ::: "memory"); __builtin_amdgcn_s_barrier(); asm volatile("" ::: "memory");
        f32x4 cs[2][2];
#pragma unroll
        for (int bj = 0; bj < 2; ++bj) { cs[bj][0] = (f32x4){0.f, 0.f, 0.f, 0.f}; cs[bj][1] = (f32x4){0.f, 0.f, 0.f, 0.f}; }
#pragma unroll
        for (int ai = 0; ai < 2; ++ai)
#pragma unroll
            for (int m = 0; m < 4; ++m) { const int rl = ai * HALF + wr * 64 + m * 16 + fr; bf16_t* rowp = base + hm0 + (size_t)(ai * HALF + m * 16) * 128;
#pragma unroll
                for (int bj = 0; bj < 2; ++bj) { const f32x4 p4 = *(const PG8_LAS f32x4*)(P + rl * 8 + bj * 4);
                    const float rs = 1.0f / sqrtf(((p4[0] + p4[1]) + (p4[2] + p4[3])) * (1.0f / 128.0f) + eps);
                    const f32x4 v0 = acc[ai][bj][m][0] * rs * g0, v1 = acc[ai][bj][m][1] * rs * g1;
                    cs[bj][0] += v0; cs[bj][1] += v1; asm volatile("" : "+v"(cs[bj][0]), "+v"(cs[bj][1]));
                    u32x4 w; w.x = cvt_pk_bf16(v0[0], v0[1]); w.y = cvt_pk_bf16(v0[2], v0[3]); w.z = cvt_pk_bf16(v1[0], v1[1]); w.w = cvt_pk_bf16(v1[2], v1[3]);
                    *(u32x4*)(rowp + (size_t)bj * 2048 * 128) = w; } }
        if (t == 5) {
#pragma unroll
            for (int bj = 0; bj < 2; ++bj)
#pragma unroll
                for (int n = 0; n < 2; ++n)
#pragma unroll
                    for (int e = 0; e < 4; ++e) { float s = cs[bj][n][e]; s += __shfl_xor(s, 1); s += __shfl_xor(s, 2); s += __shfl_xor(s, 4); s += __shfl_xor(s, 8); cs[bj][n][e] = s; }
            if (fr == 0) {
#pragma unroll
                for (int bj = 0; bj < 2; ++bj)
#pragma unroll
                    for (int n = 0; n < 2; ++n) *(PG8_LAS f32x4*)(CS + wr * 256 + bj * HALF + wc * 32 + 8 * fq + 4 * n) = cs[bj][n]; }
            asm volatile("s_waitcnt lgkmcnt(0)" ::: "memory"); __builtin_amdgcn_s_barrier(); asm volatile("" ::: "memory");
            const int tid = wid * 64 + lane;
            if (tid < 256) { const int b = u.pm >> 3, blk = u.pm & 7, head = (colw >> 7) + (tid >> 7);
                kmean[(size_t)((b * 8 + head) * 8 + blk) * 128 + (tid & 127)] = (CS[tid] + CS[256 + tid]) * (1.0f / 256.0f); }
        }
    }
};
struct EpiOut {
    static constexpr bool PERM = false, AFTER_DRAIN = false, MID = true, INIT = true;
    const bf16_t* xn; const float* xrs; float* out; int ldc;
     const float* ssq; float eps; PG8_LAS float* rrs; float fin, midk;
    __device__ __forceinline__ void mid(f32x4 (&acc)[2][2][4][2], const Unit& u, int wr, int wc, int fr, int fq) const {
        asm volatile("" : "+v"(fr));
        if (__builtin_amdgcn_readfirstlane(__builtin_bit_cast(int, rrs[512])) == u.pm) {
#pragma unroll
            for (int ai = 0; ai < 2; ++ai)
#pragma unroll
                for (int m = 0; m < 4; ++m) { const float s = rrs[256 + ai * HALF + wr * 64 + m * 16 + fr];
#pragma unroll
                    for (int bj = 0; bj < 2; ++bj)
#pragma unroll
                        for (int n = 0; n < 2; ++n) acc[ai][bj][m][n] *= s; }
            return;
        }
        if (wr == 0 && wc == 0 && fr == 0 && fq == 0) rrs[512] = __builtin_bit_cast(float, -1);
        const int row0 = u.pm * BM + wr * 64 + fr;
        f32x4 sa[2][4], sb[2][4];
#pragma unroll
        for (int ai = 0; ai < 2; ++ai)
#pragma unroll
            for (int m = 0; m < 4; ++m) { const float* sp = ssq + (size_t)(row0 + ai * HALF + m * 16) * 8; sa[ai][m] = *(const f32x4*)sp; sb[ai][m] = *(const f32x4*)(sp + 4); }
#pragma unroll
        for (int ai = 0; ai < 2; ++ai)
#pragma unroll
            for (int m = 0; m < 4; ++m) { const f32x4 a = sa[ai][m], b = sb[ai][m];
                const float v = (((a[0] + a[1]) + (a[2] + a[3])) + ((b[0] + b[1]) + (b[2] + b[3]))) * (1.0f / 1024.0f) + eps;
                const float s0 = sqrtf(v), s = s0 * midk;
                if (wc == 0 && fq == 0) rrs[ai * HALF + wr * 64 + m * 16 + fr] = fin / s0;
#pragma unroll
                for (int bj = 0; bj < 2; ++bj)
#pragma unroll
                    for (int n = 0; n < 2; ++n) acc[ai][bj][m][n] *= s; }
    }
    typedef unsigned u32x2 __attribute__((ext_vector_type(2)));
    struct Pre { u32x2 w[8][2][2]; float xs[8]; };
    __device__ __forceinline__ void init_issue(Pre& P, const Unit& u, int wr, int wc, int lane) const {
        asm volatile("" : "+v"(lane));
        const int fr = lane & 15, fq = lane >> 4;
        const int row0 = u.pm * BM + wr * 64 + fr, col0 = u.pn * BM + wc * 32 + 4 * fq;
#pragma unroll
        for (int g = 0; g < 8; ++g) { const int row = row0 + (g >> 2) * HALF + (g & 3) * 16; P.xs[g] = xrs[row]; const size_t off = (size_t)row * ldc + col0;
#pragma unroll
            for (int bj = 0; bj < 2; ++bj)
#pragma unroll
                for (int n = 0; n < 2; ++n) P.w[g][bj][n] = *(const u32x2*)(xn + off + bj * HALF + n * 16); }
    }
    __device__ __forceinline__ void init(f32x4 (&acc)[2][2][4][2], const Pre& P, const Unit& u, int wr, int wc, int lane) const {
        asm volatile("" : "+v"(lane));
        const int fr = lane & 15, fq = lane >> 4;
        const int row0 = u.pm * BM + wr * 64 + fr; const float ik = 1.0f / (midk * fin);
#pragma unroll
        for (int g = 0; g < 8; ++g) { const float xs = P.xs[g] * ik;
#pragma unroll
            for (int bj = 0; bj < 2; ++bj)
#pragma unroll
                for (int n = 0; n < 2; ++n) { const u32x2 w = P.w[g][bj][n];
                    acc[g >> 2][bj][g & 3][n] = (f32x4){__builtin_bit_cast(float, w.x << 16), __builtin_bit_cast(float, w.x & 0xffff0000u), __builtin_bit_cast(float, w.y << 16), __builtin_bit_cast(float, w.y & 0xffff0000u)} * xs; } }
        f32x4 sa[8], sb[8];
#pragma unroll
        for (int g = 0; g < 8; ++g) { const float* sp = ssq + (size_t)(row0 + (g >> 2) * HALF + (g & 3) * 16) * 8; sa[g] = *(const f32x4*)sp; sb[g] = *(const f32x4*)(sp + 4); }
#pragma unroll
        for (int g = 0; g < 8; ++g) { const f32x4 a = sa[g], b = sb[g];
            const float v = (((a[0] + a[1]) + (a[2] + a[3])) + ((b[0] + b[1]) + (b[2] + b[3]))) * (1.0f / 1024.0f) + eps; const float s0 = sqrtf(v);
            if (wc == 0 && fq == 0) { const int rl = (g >> 2) * HALF + wr * 64 + (g & 3) * 16 + fr; rrs[rl] = fin / s0; rrs[256 + rl] = s0 * midk; } }
        if (wr == 0 && wc == 0 && fr == 0 && fq == 0) rrs[512] = __builtin_bit_cast(float, u.pm);
    }
    __device__ __forceinline__ void operator()(f32x4 (&acc)[2][2][4][2], const Unit& u, int wr, int wc, int fr_, int fq_, int wid, int lane, bool has_next, const Unit& nx) const {
        asm volatile("" : "+v"(lane));
        const int fr = lane & 15, fq = lane >> 4;
        const int row0 = u.pm * BM + wr * 64 + fr, col0 = u.pn * BM + wc * 32 + 4 * fq;
        u32x2 xb[8][2][2]; float xs[8], rr[8];
        if (has_next) {
            const int rowN = nx.pm * BM + wr * 64 + fr, colN = nx.pn * BM + wc * 32 + 4 * fq;
#pragma unroll
            for (int g = 0; g < 8; ++g) { const float* sp = xrs + rowN + (g >> 2) * HALF + (g & 3) * 16; asm volatile("global_load_dword %0, %1, off" : "=v"(xs[g]) : "v"(sp) : "memory"); }
#pragma unroll
            for (int g = 0; g < 8; ++g) { const bf16_t* bp = xn + (size_t)(rowN + (g >> 2) * HALF + (g & 3) * 16) * ldc + colN;
#pragma unroll
                for (int bj = 0; bj < 2; ++bj)
#pragma unroll
                    for (int n = 0; n < 2; ++n) { const bf16_t* lp = bp + bj * HALF + n * 16; asm volatile("global_load_dwordx2 %0, %1, off" : "=v"(xb[g][bj][n]) : "v"(lp) : "memory"); } }
        }
#pragma unroll
        for (int g = 0; g < 8; ++g) rr[g] = rrs[(g >> 2) * HALF + wr * 64 + (g & 3) * 16 + fr];
#pragma unroll
        for (int g = 0; g < 8; ++g) { const size_t off = (size_t)(row0 + (g >> 2) * HALF + (g & 3) * 16) * ldc + col0;
#pragma unroll
            for (int bj = 0; bj < 2; ++bj)
#pragma unroll
                for (int n = 0; n < 2; ++n) *(f32x4*)(out + off + bj * HALF + n * 16) = acc[g >> 2][bj][g & 3][n] * rr[g]; }
        if (has_next) {
            asm volatile("s_waitcnt vmcnt(32)" : "+v"(xs[0]), "+v"(xs[1]), "+v"(xs[2]), "+v"(xs[3]), "+v"(xs[4]), "+v"(xs[5]), "+v"(xs[6]), "+v"(xs[7]),
                         "+v"(xb[0][0][0]), "+v"(xb[0][0][1]), "+v"(xb[0][1][0]), "+v"(xb[0][1][1]), "+v"(xb[1][0][0]), "+v"(xb[1][0][1]), "+v"(xb[1][1][0]), "+v"(xb[1][1][1]),
                         "+v"(xb[2][0][0]), "+v"(xb[2][0][1]), "+v"(xb[2][1][0]), "+v"(xb[2][1][1]) :: "memory");
            asm volatile("" : "+v"(xb[3][0][0]), "+v"(xb[3][0][1]), "+v"(xb[3][1][0]), "+v"(xb[3][1][1]), "+v"(xb[4][0][0]), "+v"(xb[4][0][1]), "+v"(xb[4][1][0]), "+v"(xb[4][1][1]),
                         "+v"(xb[5][0][0]), "+v"(xb[5][0][1]), "+v"(xb[5][1][0]), "+v"(xb[5][1][1]), "+v"(xb[6][0][0]), "+v"(xb[6][0][1]), "+v"(xb[6][1][0]), "+v"(xb[6][1][1]),
                         "+v"(xb[7][0][0]), "+v"(xb[7][0][1]), "+v"(xb[7][1][0]), "+v"(xb[7][1][1]) :: "memory");
            const float ik = 1.0f / (midk * fin);
#pragma unroll
            for (int g = 0; g < 8; ++g) { const float xsk = xs[g] * ik;
#pragma unroll
                for (int bj = 0; bj < 2; ++bj)
#pragma unroll
                    for (int n = 0; n < 2; ++n) { const u32x2 w = xb[g][bj][n];
                        acc[g >> 2][bj][g & 3][n] = (f32x4){__builtin_bit_cast(float, w.x << 16), __builtin_bit_cast(float, w.x & 0xffff0000u), __builtin_bit_cast(float, w.y << 16), __builtin_bit_cast(float, w.y & 0xffff0000u)} * xsk; } }
        }
    }
};

typedef int i32x4 __attribute__((ext_vector_type(4)));
typedef int i32x8 __attribute__((ext_vector_type(8)));
__device__ __forceinline__ i32x8 cat8(bf16x8 lo, bf16x8 hi) { const i32x4 a = __builtin_bit_cast(i32x4, lo), b = __builtin_bit_cast(i32x4, hi); return __builtin_shufflevector(a, b, 0, 1, 2, 3, 4, 5, 6, 7); }

#ifndef PG8_FP8ASM
#define PG8_FP8ASM 1
#endif
constexpr bool FP8ASM = (PG8_FP8ASM != 0);
template <class Epi, class Sched, bool ALIGN_EPI = false, bool SP2 = false, bool FP8 = false, int HYBP = 0>
__device__ __forceinline__ void gemm_phase(PG8_LAS unsigned char* lds, const Gemm g, const Sched& S, const Epi& E, const void* pre_ = nullptr) {
    const int tid = threadIdx.x, wid = __builtin_amdgcn_readfirstlane(tid >> 6), lane = tid & 63, wr = wid >> 2, wc = wid & 3, fr = lane & 15, fq = lane >> 4;
    const int K = g.K, nt = K / BK;
    unsigned voffA[2], voffB[2];
#pragma unroll
    for (int i = 0; i < 2; ++i) { int R, C; stage_rc(tid * 16 + i * 8192, R, C); const int Rb = Epi::PERM ? ((R & ~31) + perm32(R & 31)) : R;
        voffA[i] = (unsigned)(R * K + C) * 2u; voffB[i] = (unsigned)(Rb * K + C) * 2u; }
    const size_t kstep = (size_t)(BK * 2);
    const size_t hstep = (size_t)HALF * K * 2;
    const size_t tstep = 2 * hstep;
    const unsigned ldsw = (unsigned)wid * 1024u;
    const int aoff = lds_byte(wr * 64 + fr, fq * 8), boff = lds_byte(wc * 32 + fr, fq * 8);
#define PG8_SA(b, h) (((b) * 2 + (h)) * HTB)
#define PG8_SB(b, h) ((4 + (b) * 2 + (h)) * HTB)
#define PG8_STAGE(bufoff, gbase, voff) do { _Pragma("unroll") for (int _i = 0; _i < 2; ++_i) \
        __builtin_amdgcn_global_load_lds((const unsigned*)((const char*)(gbase) + (voff)[_i]), (PG8_LAS unsigned*)(lds + (bufoff) + ldsw + _i * 8192), 16, 0, 0); } while (0)
#define PG8_LDA_(F8c, dst, b, h) do { if constexpr (F8c) { _Pragma("unroll") for (int m = 0; m < 4; ++m) dst##F[m] = cat8(*(const PG8_LAS bf16x8*)(lds + PG8_SA(b, h) + aoff + m * 2048), *(const PG8_LAS bf16x8*)(lds + PG8_SA(b, h) + aoff + m * 2048 + 1024)); } \
        else { _Pragma("unroll") for (int m = 0; m < 4; ++m) _Pragma("unroll") for (int k = 0; k < 2; ++k) dst[m][k] = *(const PG8_LAS bf16x8*)(lds + PG8_SA(b, h) + aoff + m * 2048 + k * 1024); } } while (0)
#define PG8_LDB_(F8c, dst, b, h) do { if constexpr (F8c) { _Pragma("unroll") for (int n = 0; n < 2; ++n) dst##F[n] = cat8(*(const PG8_LAS bf16x8*)(lds + PG8_SB(b, h) + boff + n * 2048), *(const PG8_LAS bf16x8*)(lds + PG8_SB(b, h) + boff + n * 2048 + 1024)); } \
        else { _Pragma("unroll") for (int n = 0; n < 2; ++n) _Pragma("unroll") for (int k = 0; k < 2; ++k) dst[n][k] = *(const PG8_LAS bf16x8*)(lds + PG8_SB(b, h) + boff + n * 2048 + k * 1024); } } while (0)
#define PG8_MMA_(F8c, ai, bj, At, Bt) do { __builtin_amdgcn_s_setprio(1); _Pragma("unroll") for (int m = 0; m < 4; ++m) _Pragma("unroll") for (int n = 0; n < 2; ++n) { \
        if constexpr (F8c) { if constexpr (FP8ASM) asm volatile("v_mfma_f32_16x16x128_f8f6f4 %0, %1, %2, %0" : "+v"(acc[ai][bj][m][n]) : "v"(Bt##F[n]), "v"(At##F[m])); \
            else acc[ai][bj][m][n] = __builtin_amdgcn_mfma_scale_f32_16x16x128_f8f6f4(Bt##F[n], At##F[m], acc[ai][bj][m][n], 0, 0, 0, 0, 0, 0); } \
        else { _Pragma("unroll") for (int k = 0; k < 2; ++k) acc[ai][bj][m][n] = __builtin_amdgcn_mfma_f32_16x16x32_bf16(Bt[n][k], At[m][k], acc[ai][bj][m][n], 0, 0, 0); } } \
        __builtin_amdgcn_s_setprio(0); } while (0)
#define PG8_LDA(dst, b, h) PG8_LDA_(FP8, dst, b, h)
#define PG8_LDB(dst, b, h) PG8_LDB_(FP8, dst, b, h)
#define PG8_MMA(ai, bj, At, Bt) PG8_MMA_(FP8, ai, bj, At, Bt)
#define PG8_WAIT_V(n) asm volatile("s_waitcnt vmcnt(" #n ")" ::: "memory")
#define PG8_WAIT_L(n) asm volatile("s_waitcnt lgkmcnt(" #n ")" ::: "memory")
#define PG8_BAR __builtin_amdgcn_s_barrier()
#define PG8_SCHED __builtin_amdgcn_sched_barrier(0)
#define PG8_ITER_SP2(F8c) do { \
            PG8_LDB_(F8c, B0, 0, 0); PG8_LDB_(F8c, B1, 0, 1); PG8_SCHED; PG8_LDA_(F8c, At, 0, 0); PG8_STAGE(PG8_SA(1, 1), a1 + hstep, voffA); \
            PG8_WAIT_V(8); PG8_WAIT_L(0); PG8_BAR; PG8_MMA_(F8c, 0, 0, At, B0); PG8_MMA_(F8c, 0, 1, At, B1); PG8_BAR; PG8_SCHED; \
            PG8_LDA_(F8c, At, 0, 1); PG8_STAGE(PG8_SB(0, 0), b2, voffB); PG8_STAGE(PG8_SB(0, 1), b2 + hstep, voffB); PG8_STAGE(PG8_SA(0, 0), a2, voffA); \
            PG8_WAIT_V(8); PG8_WAIT_L(0); PG8_BAR; PG8_MMA_(F8c, 1, 0, At, B0); PG8_MMA_(F8c, 1, 1, At, B1); PG8_BAR; PG8_SCHED; \
            PG8_LDB_(F8c, B0, 1, 0); PG8_LDB_(F8c, B1, 1, 1); PG8_SCHED; PG8_LDA_(F8c, At, 1, 0); PG8_STAGE(PG8_SA(0, 1), a2 + hstep, voffA); \
            PG8_WAIT_V(8); PG8_WAIT_L(0); PG8_BAR; PG8_MMA_(F8c, 0, 0, At, B0); PG8_MMA_(F8c, 0, 1, At, B1); PG8_BAR; PG8_SCHED; \
            PG8_LDA_(F8c, At, 1, 1); PG8_STAGE(PG8_SB(1, 0), b3, voffB); PG8_STAGE(PG8_SB(1, 1), b3 + hstep, voffB); PG8_STAGE(PG8_SA(1, 0), a3, voffA); \
            PG8_WAIT_V(8); PG8_WAIT_L(0); PG8_BAR; PG8_MMA_(F8c, 1, 0, At, B0); PG8_MMA_(F8c, 1, 1, At, B1); PG8_BAR; PG8_SCHED; \
            } while (0)
#define PG8_TSTEP(F8c) do { \
            const bool last = (t == ntl - 2); \
            const char* a1 = cA + (size_t)PG8_KT(t + 1) * kstep; \
            const char* a2 = last ? nA : cA + (size_t)PG8_KT(t + 2) * kstep; const char* b2 = last ? nB : cB + (size_t)PG8_KT(t + 2) * kstep; \
            const char* a3 = a2 + kstep; const char* b3 = b2 + kstep; \
            if (last && has_next) S.a_ready(nxt); \
            if constexpr (SP2) { \
            PG8_ITER_SP2(F8c); \
            } else { \
            PG8_LDB(B0, 0, 0); PG8_SCHED; PG8_LDA(At, 0, 0); PG8_STAGE(PG8_SA(1, 1), a1 + hstep, voffA); \
            PG8_WAIT_L(8); PG8_BAR; PG8_WAIT_L(0); PG8_MMA(0, 0, At, B0); PG8_BAR; PG8_SCHED; \
            PG8_LDB(B1, 0, 1); PG8_STAGE(PG8_SB(0, 0), b2, voffB); \
            PG8_BAR; PG8_WAIT_L(0); PG8_MMA(0, 1, At, B1); PG8_BAR; \
            PG8_LDA(At, 0, 1); PG8_STAGE(PG8_SA(0, 0), a2, voffA); \
            PG8_BAR; PG8_WAIT_L(0); PG8_MMA(1, 0, At, B0); PG8_BAR; PG8_SCHED; \
            PG8_STAGE(PG8_SB(0, 1), b2 + hstep, voffB); \
            PG8_WAIT_V(6); PG8_BAR; PG8_MMA(1, 1, At, B1); PG8_BAR; \
            PG8_LDB(B0, 1, 0); PG8_SCHED; PG8_LDA(At, 1, 0); PG8_STAGE(PG8_SA(0, 1), a2 + hstep, voffA); \
            PG8_WAIT_L(8); PG8_BAR; PG8_WAIT_L(0); PG8_MMA(0, 0, At, B0); PG8_BAR; PG8_SCHED; \
            PG8_LDB(B1, 1, 1); PG8_STAGE(PG8_SB(1, 0), b3, voffB); \
            PG8_BAR; PG8_WAIT_L(0); PG8_MMA(0, 1, At, B1); PG8_BAR; \
            PG8_LDA(At, 1, 1); PG8_STAGE(PG8_SA(1, 0), a3, voffA); \
            PG8_BAR; PG8_WAIT_L(0); PG8_MMA(1, 0, At, B0); PG8_BAR; PG8_SCHED; \
            PG8_STAGE(PG8_SB(1, 1), b3 + hstep, voffB); \
            PG8_WAIT_V(6); PG8_BAR; PG8_MMA(1, 1, At, B1); PG8_BAR; \
            } \
            if constexpr (Epi::MID) { if (t == nt / 2 - HSK - 2) { if constexpr (FP8 || (F8c)) asm volatile("s_nop 15\n\ts_nop 15" ::: "memory"); E.mid(acc, cur, wr, wc, fr, fq); } } \
        } while (0)
    Unit cur, nxt; int ui = 0;
    if (!S.next(0, cur)) return;
    f32x4 acc[2][2][4][2];
    if constexpr (Epi::INIT) { }
    else {
#pragma unroll
    for (int a = 0; a < 2; ++a)
#pragma unroll
        for (int b = 0; b < 2; ++b)
#pragma unroll
            for (int m = 0; m < 4; ++m)
#pragma unroll
                for (int n = 0; n < 2; ++n) acc[a][b][m][n] = (f32x4){0.f, 0.f, 0.f, 0.f}; }
    bf16x8 At[4][2], B0[2][2], B1[2][2]; i32x8 AtF[4], B0F[2], B1F[2];
    const char* cA = (const char*)g.A + (size_t)cur.pm * tstep; const char* cB = (const char*)g.Bt + (size_t)cur.pn * tstep;
    S.a_ready(cur);
    if constexpr (SP2) {
        PG8_STAGE(PG8_SB(0, 0), cB, voffB); PG8_STAGE(PG8_SB(0, 1), cB + hstep, voffB); PG8_STAGE(PG8_SA(0, 0), cA, voffA); PG8_STAGE(PG8_SA(0, 1), cA + hstep, voffA);
        if constexpr (Epi::INIT) {
            PG8_STAGE(PG8_SB(1, 0), cB + kstep, voffB); PG8_STAGE(PG8_SA(1, 0), cA + kstep, voffA); PG8_STAGE(PG8_SB(1, 1), cB + hstep + kstep, voffB);
            E.init(acc, *(const typename Epi::Pre*)pre_, cur, wr, wc, lane); }
        if (wr == 1) PG8_BAR;
        PG8_WAIT_V(2); PG8_BAR;
        if constexpr (!Epi::INIT) { PG8_STAGE(PG8_SB(1, 0), cB + kstep, voffB); PG8_STAGE(PG8_SA(1, 0), cA + kstep, voffA); PG8_STAGE(PG8_SB(1, 1), cB + hstep + kstep, voffB); }
        PG8_WAIT_V(6); PG8_BAR;
    } else {
        PG8_STAGE(PG8_SB(0, 0), cB, voffB); PG8_STAGE(PG8_SA(0, 0), cA, voffA); PG8_STAGE(PG8_SB(0, 1), cB + hstep, voffB); PG8_STAGE(PG8_SA(0, 1), cA + hstep, voffA);
        if (wr == 1) PG8_BAR;
        PG8_WAIT_V(4); PG8_BAR;
        PG8_STAGE(PG8_SB(1, 0), cB + kstep, voffB); PG8_STAGE(PG8_SA(1, 0), cA + kstep, voffA); PG8_STAGE(PG8_SB(1, 1), cB + hstep + kstep, voffB);
        PG8_WAIT_V(6); PG8_BAR;
    }
    for (;;) {
        const bool has_next = S.next(ui + 1, nxt);
        const char* nA = has_next ? (const char*)g.A + (size_t)nxt.pm * tstep : cA; const char* nB = has_next ? (const char*)g.Bt + (size_t)nxt.pn * tstep : cB;
        constexpr int HSK = 2 * HYBP;
#define PG8_KT(i) ((HYBP > 0 && (i) >= HSK) ? (i) + HSK : (i))
        const int ntl = nt - HSK;
        if constexpr (HYBP > 0) { int t = 0; for (; t < HSK; t += 2) PG8_TSTEP(true); for (; t < ntl; t += 2) PG8_TSTEP(false); }
        else { for (int t = 0; t < ntl; t += 2) PG8_TSTEP(FP8); }
        if constexpr (ALIGN_EPI) { if (wr == 0) PG8_BAR; }
        if constexpr (FP8) asm volatile("s_nop 15\n\ts_nop 15" ::: "memory");
        if constexpr (!Epi::AFTER_DRAIN) { if constexpr (Epi::INIT) E(acc, cur, wr, wc, fr, fq, wid, lane, has_next, nxt); else E(acc, cur, wr, wc, fr, fq, wid, lane); S.done(cur); }
        if (!has_next) break;
        if constexpr (!Epi::INIT) {
#pragma unroll
        for (int a = 0; a < 2; ++a)
#pragma unroll
            for (int b = 0; b < 2; ++b)
#pragma unroll
                for (int m = 0; m < 4; ++m)
#pragma unroll
                    for (int n = 0; n < 2; ++n) acc[a][b][m][n] = (f32x4){0.f, 0.f, 0.f, 0.f}; }
        cur = nxt; cA = nA; cB = nB; ++ui;
        if constexpr (ALIGN_EPI) { if (wr == 1) PG8_BAR; }
    }
    PG8_WAIT_V(0);
    if constexpr (!ALIGN_EPI) { if (wr == 0) PG8_BAR; }
    PG8_BAR;
    if constexpr (Epi::AFTER_DRAIN) { E.fused(acc, cur, wr, wc, fr, fq, lds, wid, lane); S.done(cur); }
#undef PG8_SA
#undef PG8_SB
#undef PG8_STAGE
#undef PG8_LDA
#undef PG8_LDB
#undef PG8_MMA
#undef PG8_MMA_
#undef PG8_LDA_
#undef PG8_LDB_
#undef PG8_ITER_SP2
#undef PG8_TSTEP
#undef PG8_KT
#undef PG8_WAIT_V
#undef PG8_WAIT_L
#undef PG8_BAR
#undef PG8_SCHED
}
}

#include <cmath>


#ifndef PG8_SP2
#define PG8_SP2 true
#endif
#ifndef PG8_SP2_FP8
#define PG8_SP2_FP8 true
#endif
#ifndef PG8_ALIGN
#define PG8_ALIGN true
#endif

constexpr int NWAVES = 8;
#ifndef MK_ONE_LAUNCH
#define MK_ONE_LAUNCH 1
#endif
constexpr int PER_PHASE = 4;
constexpr bool ONE_LAUNCH = (MK_ONE_LAUNCH != 0);

constexpr int BATCH = 8, SEQ = 2048, DM = 2048, M = BATCH * SEQ;
constexpr int DCONV = 1024, DATTN = 1024, NH = 8, HD = 128, DIN = 8192, DMIX = 2048;
constexpr int MBLK = 256, NBLK = SEQ / MBLK, TOPK = 3;
constexpr float EPS = 1e-6f;
constexpr float SM_SCALE = 0.08838834764831845f;
#ifndef MK_FP8_OUT
#define MK_FP8_OUT 1
#endif
#ifndef MK_NF8
#define MK_NF8 2
#endif
constexpr int NF8 = MK_NF8;
constexpr unsigned PORD = 0x54201367u;
constexpr unsigned PPOS = 0x01762534u;
constexpr float X8_SCALE = 1.0f, WI8_SCALE = 64.0f;
#ifndef MK_LOCBAR
#define MK_LOCBAR 1
#endif
#ifndef MK_HYB
#define MK_HYB 2
#endif
constexpr int HYBP = MK_HYB;
constexpr int HYBC = 256 * HYBP;
constexpr float HYB_Y = 4.0f, HYB_W = 64.0f, HYB_ALL = HYB_Y * HYB_W;
constexpr bool FP8_OUT = (MK_FP8_OUT != 0);
constexpr float Y8C_SCALE = 4.0f, Y8A_SCALE = 8.0f, W8_SCALE = 64.0f;

constexpr size_t MiB = 1u << 20;
constexpr size_t WS_CTL = 0, CTL_ZERO_BYTES = 32768;
constexpr size_t WS_WIN = 388 * MiB;
constexpr size_t WS_WOUT = 34 * MiB;
constexpr size_t WS_KMEAN = 42 * MiB;
constexpr size_t WS_XRS = 43 * MiB;
constexpr size_t WS_SSQ = 44 * MiB;
constexpr size_t WS_XN = 400 * MiB;
constexpr size_t WS_PROJ = 48 * MiB;
constexpr size_t PROJ_STRIDE = 32 * MiB;
constexpr size_t WS_Y = 320 * MiB;
constexpr size_t WS_XN8 = 464 * MiB;
constexpr size_t WS_WIN8 = 496 * MiB;
constexpr size_t WS_END = 510 * MiB;
static_assert(MK_NF8 == 6, "this workspace map gives the bf16 W_in^T copy only 12 MiB (the q and k rows)");
constexpr int CW_TMO = 0, CW_CODE = 1;
constexpr int CW_BAR = 4096;

constexpr int RING_OFF = 0, RING_BYTES = 141312;
constexpr int LDSCTL_OFF = RING_BYTES, MISC_OFF = LDSCTL_OFF + 320;
constexpr int LDS_BYTES = 147456;
static_assert(MISC_OFF + 128 <= LDS_BYTES, "LDS map");
static_assert(HYBP == 0 || HYBC == 512 || HYBC == 1024, "the conv mixer stores its j = 0 half (or both halves) as e4m3");

#define GAS __attribute__((address_space(1)))
#define LAS __attribute__((address_space(3)))
typedef unsigned short bf16;
typedef unsigned v4u __attribute__((ext_vector_type(4)));
typedef float f32x4 __attribute__((ext_vector_type(4)));
typedef short bf16x8 __attribute__((ext_vector_type(8)));
typedef GAS unsigned gu32;
typedef GAS unsigned long long gu64;
#define RLX_AGENT __ATOMIC_RELAXED, __HIP_MEMORY_SCOPE_AGENT
#define LDS_WAIT() asm volatile("s_waitcnt lgkmcnt(0)" ::: "memory")
#define VM_WAIT() asm volatile("s_waitcnt vmcnt(0)" ::: "memory")
__device__ __forceinline__ unsigned long long rt() { return __builtin_amdgcn_s_memrealtime(); }
__device__ __forceinline__ unsigned f2bf(float f) { unsigned u = __builtin_bit_cast(unsigned, f); return (u + 0x7fffu + ((u >> 16) & 1u)) >> 16; }
__device__ __forceinline__ unsigned pk2(float lo, float hi) { return f2bf(lo) | (f2bf(hi) << 16); }

#define XB_TMO      128
#define XB_XCNT(j)  (256  + 64 * (j))
#define XB_XSUB(j)  (1280 + 64 * (j))
#define XB_XGEN(j)  (2304 + 64 * (j))
#define XB_TOP      3328
#define XB_TOPGEN   3392
#define XB_MIS      3456
#define XCD_BAR_WORDS 3520
#define XB_SPIN_CAP (1u << 18)

__device__ __forceinline__ unsigned xb_ld(unsigned* p)              { return __hip_atomic_load(p, __ATOMIC_RELAXED, __HIP_MEMORY_SCOPE_AGENT); }
__device__ __forceinline__ unsigned xb_add(unsigned* p, unsigned v) { return __hip_atomic_fetch_add(p, v, __ATOMIC_RELAXED, __HIP_MEMORY_SCOPE_AGENT); }
__device__ __forceinline__ unsigned xb_xcc_id() { return (unsigned)__builtin_amdgcn_s_getreg((3 << 11) | 20) & 0xFu; }
#define XB_SPIN(cond, bar) do { unsigned _sp = 0; while (cond) { __builtin_amdgcn_s_sleep(1); \
    if ((++_sp & 255u) == 0u) { if (xb_ld(&(bar)[XB_TMO])) break; if (_sp > XB_SPIN_CAP) { atomicAdd(&(bar)[XB_TMO], 1u); break; } } } } while (0)

struct XcdBarrier {
    unsigned* bar; unsigned x;
    volatile LAS unsigned* st;
};

__device__ __forceinline__ XcdBarrier xcd_barrier_post(unsigned* bar, volatile LAS unsigned* st) {
    XcdBarrier b; b.bar = bar; b.x = xb_xcc_id(); b.st = st;
    if (threadIdx.x == 0) (void)xb_add(&bar[XB_XCNT(b.x)], 1u);
    return b;
}
__device__ __forceinline__ void xcd_barrier_complete(unsigned* bar, unsigned x, unsigned& nloc, unsigned& nx) {
    const unsigned G = gridDim.x * gridDim.y * gridDim.z;
    unsigned sum, cnt, mine, sp = 0u;
    for (;;) {
        sum = 0u; cnt = 0u; mine = 0u;
#pragma unroll
        for (unsigned j = 0; j < 16; ++j) { const unsigned c = xb_ld(&bar[XB_XCNT(j)]); sum += c; cnt += (c > 0u) ? 1u : 0u; mine = (j == x) ? c : mine; }
        if (sum == G) break;
        __builtin_amdgcn_s_sleep(1);
        if ((++sp & 255u) == 0u) { if (xb_ld(&bar[XB_TMO])) break; if (sp > XB_SPIN_CAP) { atomicAdd(&bar[XB_TMO], 1u); break; } }
    }
    nloc = mine > 0u ? mine : 1u; nx = cnt > 0u ? cnt : 1u;
}

__device__ __forceinline__ void xcd_barrier(const XcdBarrier& b) {
    asm volatile("s_waitcnt vmcnt(0)" ::: "memory");
    __syncthreads();
    if (threadIdx.x == 0) {
        unsigned* bar = b.bar;
        __builtin_amdgcn_s_waitcnt(0);
        unsigned nloc = b.st[0], nx = b.st[1];
        if (nloc == 0u) { xcd_barrier_complete(bar, b.x, nloc, nx); b.st[0] = nloc; b.st[1] = nx; }
        const unsigned old = xb_add(&bar[XB_XSUB(b.x)], 1u);
        const unsigned gen = old / nloc;
        if (old + 1u == (gen + 1u) * nloc) {
            __builtin_amdgcn_fence(__ATOMIC_RELEASE, "agent");
            asm volatile("s_waitcnt vmcnt(0)" ::: "memory");
            const unsigned og = xb_add(&bar[XB_TOP], 1u);
            const unsigned tg = og / nx;
            if (og + 1u == (tg + 1u) * nx) xb_add(&bar[XB_TOPGEN], 1u);
            else XB_SPIN(xb_ld(&bar[XB_TOPGEN]) == tg, bar);
            __builtin_amdgcn_fence(__ATOMIC_ACQUIRE, "agent");
            xb_add(&bar[XB_XGEN(b.x)], 1u);
            asm volatile("s_waitcnt vmcnt(0)" ::: "memory");
        } else {
            XB_SPIN(xb_ld(&bar[XB_XGEN(b.x)]) == gen, bar);
            __builtin_amdgcn_fence(__ATOMIC_ACQUIRE, "agent");
            asm volatile("s_waitcnt vmcnt(0)" ::: "memory");
        }
    }
    __syncthreads();
}

__device__ __forceinline__ void xcd_barrier_local(const XcdBarrier& b) {
    asm volatile("s_waitcnt vmcnt(0)" ::: "memory");
    __syncthreads();
    if (threadIdx.x == 0) {
        unsigned* bar = b.bar;
        __builtin_amdgcn_s_waitcnt(0);
        unsigned nloc = b.st[0], nx = b.st[1];
        if (nloc == 0u) { xcd_barrier_complete(bar, b.x, nloc, nx); b.st[0] = nloc; b.st[1] = nx; }
        const unsigned old = xb_add(&bar[XB_XSUB(b.x)], 1u);
        const unsigned gen = old / nloc;
        if (old + 1u == (gen + 1u) * nloc) xb_add(&bar[XB_XGEN(b.x)], 1u);
        else XB_SPIN(xb_ld(&bar[XB_XGEN(b.x)]) == gen, bar);
        __builtin_amdgcn_fence(__ATOMIC_ACQUIRE, "agent");
        asm volatile("s_waitcnt vmcnt(0)" ::: "memory");
    }
    __syncthreads();
}

namespace moba {
typedef short bf16x8 __attribute__((ext_vector_type(8)));
typedef short s16x4 __attribute__((ext_vector_type(4)));
typedef float f32x16 __attribute__((ext_vector_type(16)));
typedef float f32x4 __attribute__((ext_vector_type(4)));
typedef unsigned u32x4 __attribute__((ext_vector_type(4)));
typedef unsigned short bf16;
constexpr int D = 128, PITCH = 128, NW = 8, QBLK = 32, KVBLK = 64, QB = NW * QBLK;
constexpr int SHM_V = KVBLK * D * 2, SHM_K = KVBLK * D * 2;
constexpr int OFF_WSF = 2 * SHM_V + 2 * SHM_K, OFF_OST = OFF_WSF + NW * 64 * 4, OFF_KM = OFF_OST + NW * 8192, LDS_BYTES = OFF_KM + 8192;
constexpr float SCALE = 0.08838834764831845f, THR = 8.f;
#define KSWZ(row, colB) ((row) * 256 + ((colB) ^ (((row) & 7) << 4)))
#define SBAR() __builtin_amdgcn_sched_barrier(0)
__device__ __forceinline__ int v_st(int k, int c) { const int kk = (k & ~0xC) | ((k & 4) << 1) | ((k & 8) >> 1); return ((kk >> 3) * 4 + (c >> 5)) * 512 + ((kk & 7) * 32 + (c & 31)) * 2; }
__device__ __forceinline__ int v_rd_base(int lane) { return ((lane & 3) << 3) | (((lane >> 2) & 3) << 6) | (((lane >> 4) & 1) << 5) | (((lane >> 5) & 1) << 8); }
constexpr int v_rd_off(int d0, int ks, int half) { return d0 * 512 + ks * 4096 + half * 2048; }
__device__ __forceinline__ int crow(int r, int hi) { return (r & 3) + 8 * (r >> 2) + 4 * hi; }
__device__ __forceinline__ unsigned cvtpk(float lo, float hi) { unsigned r; asm volatile("v_cvt_pk_bf16_f32 %0, %1, %2" : "=v"(r) : "v"(lo), "v"(hi)); return r; }
__device__ __forceinline__ float bflo(unsigned w) { return __builtin_bit_cast(float, w << 16); }
__device__ __forceinline__ float bfhi(unsigned w) { return __builtin_bit_cast(float, w & 0xffff0000u); }
__device__ __forceinline__ void mask_tile(f32x16& p0, f32x16& p1, int dq) {
    const float NEG = -__builtin_inff();
#pragma unroll
    for (int r = 0; r < 16; ++r) { const int c = (r & 3) + 8 * (r >> 2); if (dq - c < 0) p0[r] = NEG; if (dq - c - 32 < 0) p1[r] = NEG; }
}
__device__ __forceinline__ void partialSM(f32x16& p0, f32x16& p1, float& m_reg, float& mn, float& alpha, bool masked) {
    float pmax = p0[0]; for (int r = 1; r < 16; ++r) pmax = fmaxf(pmax, p0[r]); for (int r = 0; r < 16; ++r) pmax = fmaxf(pmax, p1[r]);
    { auto rr = __builtin_amdgcn_permlane32_swap(__float_as_uint(pmax), __float_as_uint(pmax), false, false);
      pmax = fmaxf(__uint_as_float(rr[0]), __uint_as_float(rr[1])); }
    if (masked) pmax = -__builtin_inff();
    constexpr float C2 = 1.4426950408889634f * SCALE;
    if (__builtin_expect(__all((pmax - m_reg) * SCALE <= THR), 1)) { mn = m_reg; alpha = 1.f; }
    else { mn = fmaxf(m_reg, pmax); alpha = __builtin_amdgcn_exp2f((m_reg - mn) * C2); m_reg = mn; }
    const float mnL = masked ? -__builtin_inff() : -mn * C2;
    for (int r = 0; r < 16; ++r) p0[r] = fmaf(p0[r], C2, mnL); for (int r = 0; r < 16; ++r) p1[r] = fmaf(p1[r], C2, mnL);
    for (int r = 0; r < 16; ++r) p0[r] = __builtin_amdgcn_exp2f(p0[r]);
}
__device__ __forceinline__ void finishSM(f32x16& p0, f32x16& p1, float alpha, float& l_reg, bf16x8& pa0, bf16x8& pa1, bf16x8& pa2, bf16x8& pa3) {
    for (int r = 0; r < 16; ++r) p1[r] = __builtin_amdgcn_exp2f(p1[r]);
    float ps = 0; for (int r = 0; r < 16; ++r) ps += p0[r]; for (int r = 0; r < 16; ++r) ps += p1[r];
    { auto rr = __builtin_amdgcn_permlane32_swap(__float_as_uint(ps), __float_as_uint(ps), false, false);
      ps = __uint_as_float(rr[0]) + __uint_as_float(rr[1]); }
    l_reg = l_reg * alpha + ps;
#define PK4(P, B_, OUT) do { unsigned a0 = cvtpk(P[B_+0], P[B_+1]), a1 = cvtpk(P[B_+2], P[B_+3]);                          \
        unsigned b0 = cvtpk(P[B_+4], P[B_+5]), b1 = cvtpk(P[B_+6], P[B_+7]);                                             \
        auto r0 = __builtin_amdgcn_permlane32_swap(a0, b0, false, false); auto r1 = __builtin_amdgcn_permlane32_swap(a1, b1, false, false); \
        u32x4 w = {r0[0], r1[0], r0[1], r1[1]}; OUT = *reinterpret_cast<bf16x8*>(&w); } while (0)
    PK4(p0, 0, pa0); PK4(p0, 8, pa1); PK4(p1, 0, pa2); PK4(p1, 8, pa3);
#undef PK4
}
#ifndef MOBA_QLA
#define MOBA_QLA 3
#endif
template <int KB>
__device__ __forceinline__ void qkt(f32x16& p0, f32x16& p1, const char* K_lds, int r32, int hi, const bf16x8* qr) {
    p0 = f32x16{}; p1 = f32x16{};
    const char* kb[4];
#pragma unroll
    for (int dd = 0; dd < 4; ++dd) kb[dd] = K_lds + KB * SHM_K + KSWZ(r32, (dd * 16 + hi * 8) * 2);
    constexpr int QLA = MOBA_QLA;
    bf16x8 f0[8], f1[8];
#define QK_RD(d0) do { const char* a_ = kb[(d0) & 3] + ((d0) >> 2) * 128; f0[d0] = *reinterpret_cast<const bf16x8*>(a_); f1[d0] = *reinterpret_cast<const bf16x8*>(a_ + 32 * 256); } while (0)
#pragma unroll
    for (int d0 = 0; d0 < QLA; ++d0) QK_RD(d0);
    SBAR();
#pragma unroll
    for (int d0 = 0; d0 < 8; ++d0) {
        p0 = __builtin_amdgcn_mfma_f32_32x32x16_bf16(f0[d0], qr[d0], p0, 0, 0, 0);
        p1 = __builtin_amdgcn_mfma_f32_32x32x16_bf16(f1[d0], qr[d0], p1, 0, 0, 0);
        if (d0 + QLA < 8) { SBAR(); QK_RD(d0 + QLA); SBAR(); } }
#undef QK_RD
}
template <int VB>
__device__ __forceinline__ void pv_tile(f32x16* o, int vb0, bf16x8 pa0, bf16x8 pa1, bf16x8 pa2, bf16x8 pa3) {
#define TRRD(dst, off) asm volatile("ds_read_b64_tr_b16 %0, %1 offset:%2" : "=&v"(dst) : "v"(vb0), "i"(off) : "memory")
#define PV_D0(d0) do { s16x4 l0, l1, l2, l3, h0, h1, h2, h3; constexpr int b_ = VB * SHM_V + v_rd_off(d0, 0, 0); \
        TRRD(l0, b_); TRRD(h0, b_ + 2048); TRRD(l1, b_ + 4096); TRRD(h1, b_ + 6144); TRRD(l2, b_ + 8192); TRRD(h2, b_ + 10240); TRRD(l3, b_ + 12288); TRRD(h3, b_ + 14336); \
        asm volatile("s_waitcnt lgkmcnt(0)" ::: "memory"); SBAR();   \
        o[d0] = __builtin_amdgcn_mfma_f32_32x32x16_bf16(pa0, (bf16x8){l0[0], l0[1], l0[2], l0[3], h0[0], h0[1], h0[2], h0[3]}, o[d0], 0, 0, 0);   \
        o[d0] = __builtin_amdgcn_mfma_f32_32x32x16_bf16(pa1, (bf16x8){l1[0], l1[1], l1[2], l1[3], h1[0], h1[1], h1[2], h1[3]}, o[d0], 0, 0, 0);   \
        o[d0] = __builtin_amdgcn_mfma_f32_32x32x16_bf16(pa2, (bf16x8){l2[0], l2[1], l2[2], l2[3], h2[0], h2[1], h2[2], h2[3]}, o[d0], 0, 0, 0);   \
        o[d0] = __builtin_amdgcn_mfma_f32_32x32x16_bf16(pa3, (bf16x8){l3[0], l3[1], l3[2], l3[3], h3[0], h3[1], h3[2], h3[3]}, o[d0], 0, 0, 0); } while (0)
    PV_D0(0); PV_D0(1); PV_D0(2); PV_D0(3);
#undef PV_D0
#undef TRRD
}
template <int VB>
__device__ __forceinline__ void pv_sm(f32x16* o, int vb0, bf16x8 pa0, bf16x8 pa1, bf16x8 pa2, bf16x8 pa3, f32x16& p0, f32x16& p1, float& m_reg, float& mn, float& alpha, bool masked, bool domask, int dq) {
#define TRRD(dst, off) asm volatile("ds_read_b64_tr_b16 %0, %1 offset:%2" : "=&v"(dst) : "v"(vb0), "i"(off) : "memory")
#define PV_D0(d0) do { s16x4 l0, l1, l2, l3, h0, h1, h2, h3; constexpr int b_ = VB * SHM_V + v_rd_off(d0, 0, 0); \
        TRRD(l0, b_); TRRD(h0, b_ + 2048); TRRD(l1, b_ + 4096); TRRD(h1, b_ + 6144); TRRD(l2, b_ + 8192); TRRD(h2, b_ + 10240); TRRD(l3, b_ + 12288); TRRD(h3, b_ + 14336); \
        asm volatile("s_waitcnt lgkmcnt(0)" ::: "memory"); SBAR();   \
        o[d0] = __builtin_amdgcn_mfma_f32_32x32x16_bf16(pa0, (bf16x8){l0[0], l0[1], l0[2], l0[3], h0[0], h0[1], h0[2], h0[3]}, o[d0], 0, 0, 0);   \
        o[d0] = __builtin_amdgcn_mfma_f32_32x32x16_bf16(pa1, (bf16x8){l1[0], l1[1], l1[2], l1[3], h1[0], h1[1], h1[2], h1[3]}, o[d0], 0, 0, 0);   \
        o[d0] = __builtin_amdgcn_mfma_f32_32x32x16_bf16(pa2, (bf16x8){l2[0], l2[1], l2[2], l2[3], h2[0], h2[1], h2[2], h2[3]}, o[d0], 0, 0, 0);   \
        o[d0] = __builtin_amdgcn_mfma_f32_32x32x16_bf16(pa3, (bf16x8){l3[0], l3[1], l3[2], l3[3], h3[0], h3[1], h3[2], h3[3]}, o[d0], 0, 0, 0); } while (0)
    constexpr float C2 = 1.4426950408889634f * SCALE;
    PV_D0(0);
    if (domask) mask_tile(p0, p1, dq);
    float pmax = p0[0]; for (int r = 1; r < 16; ++r) pmax = fmaxf(pmax, p0[r]);
    SBAR();
    PV_D0(1);
    for (int r = 0; r < 16; ++r) pmax = fmaxf(pmax, p1[r]);
    { auto rr = __builtin_amdgcn_permlane32_swap(__float_as_uint(pmax), __float_as_uint(pmax), false, false);
      pmax = fmaxf(__uint_as_float(rr[0]), __uint_as_float(rr[1])); }
    if (masked) pmax = -__builtin_inff();
    if (__builtin_expect(__all((pmax - m_reg) * SCALE <= THR), 1)) { mn = m_reg; alpha = 1.f; }
    else { mn = fmaxf(m_reg, pmax); alpha = __builtin_amdgcn_exp2f((m_reg - mn) * C2); m_reg = mn; }
    const float mnL = masked ? -__builtin_inff() : -mn * C2;
    SBAR();
    PV_D0(2);
    for (int r = 0; r < 16; ++r) p0[r] = fmaf(p0[r], C2, mnL); for (int r = 0; r < 16; ++r) p1[r] = fmaf(p1[r], C2, mnL);
    SBAR();
    PV_D0(3);
    for (int r = 0; r < 16; ++r) p0[r] = __builtin_amdgcn_exp2f(p0[r]);
#undef PV_D0
#undef TRRD
}
struct BlockRef { const bf16* Q; const bf16* K; const bf16* V; int bh, qb, m0; };
struct Seam { bf16x8 qr[8]; bf16x8 st_v0, st_v1, st_k0, st_k1; };
struct Ctx { const float* kmean; const bf16* ZA; bf16* Y; float* SSQ; float y8; };
__device__ __forceinline__ bf16x8 ld8(const bf16* p) { return *reinterpret_cast<const bf16x8*>(p); }
__device__ __forceinline__ void write_km(const float* km, char* KM_lds, int tid) {
    asm volatile("" : "+v"(tid));
    if (tid < 256) { const int row = tid >> 4, ch = tid & 15, n = row & 7;
        const f32x4 a = *(const f32x4*)(km + n * 128 + ch * 8), b = *(const f32x4*)(km + n * 128 + ch * 8 + 4);
        float v[8] = {a[0], a[1], a[2], a[3], b[0], b[1], b[2], b[3]};
        if (row >= 8) {
#pragma unroll
            for (int e = 0; e < 8; e += 2) { const unsigned w = cvtpk(v[e], v[e + 1]); v[e] -= bflo(w); v[e + 1] -= bfhi(w); } }
        u32x4 w = {cvtpk(v[0], v[1]), cvtpk(v[2], v[3]), cvtpk(v[4], v[5]), cvtpk(v[6], v[7])};
        *(u32x4*)(KM_lds + KSWZ(row, ch * 16)) = w; }
}
#define ROW(p, k0, rr) ((p) + (size_t)((k0) + (rr)) * PITCH + sc)
#define VMW() asm volatile("s_waitcnt vmcnt(0)" ::: "memory")
#define VMWN(n) asm volatile("s_waitcnt vmcnt(%0)" :: "i"(n) : "memory")
#define SLOAD_H(Kp, Vp, k0) do { S.st_v0 = ld8(ROW(Vp, k0, sr)); S.st_v1 = ld8(ROW(Vp, k0, 32 + sr));              \
                         S.st_k0 = ld8(ROW(Kp, k0, sr)); S.st_k1 = ld8(ROW(Kp, k0, 32 + sr)); } while (0)
#define SWRITE_HK(bf) do { *(bf16x8*)(K_lds + (bf) * SHM_K + kws) = S.st_k0; *(bf16x8*)(K_lds + (bf) * SHM_K + kws + 32 * 256) = S.st_k1; } while (0)
#define SWRITE_HV(bf) do { *(bf16x8*)(V_lds + (bf) * SHM_V + vst0) = S.st_v0; *(bf16x8*)(V_lds + (bf) * SHM_V + vst1) = S.st_v1; } while (0)
#define SWRITE_H(bf) do { SWRITE_HV(bf); SWRITE_HK(bf); } while (0)
__device__ __forceinline__ void moba_prime(const BlockRef& cur, const Ctx& C, char* lds, Seam& S) {
    int tid_ = threadIdx.x; asm volatile("" : "+v"(tid_));
    const int tid = tid_, wid = __builtin_amdgcn_readfirstlane(tid >> 6), lane = tid & 63, r32 = lane & 31, hi = lane >> 5;
    const int sr = tid >> 4, sc = (tid & 15) * 8, kws = KSWZ(sr, sc * 2); char* K_lds = lds + 2 * SHM_V;
    for (int d0 = 0; d0 < 8; ++d0) S.qr[d0] = ld8(cur.Q + (size_t)(wid * QBLK + r32) * PITCH + d0 * 16 + hi * 8);
    SLOAD_H(cur.K, cur.V, 0); write_km(C.kmean + (size_t)cur.bh * 8 * 128, lds + OFF_KM, tid); VMW(); SWRITE_HK(0);
    __syncthreads();
}
__device__ __forceinline__ void moba_block(const BlockRef& cur, const BlockRef& nxt, const Ctx& C, char* lds, Seam& S) {
    int tid_ = threadIdx.x; asm volatile("" : "+v"(tid_));
    const int tid = tid_, wid = __builtin_amdgcn_readfirstlane(tid >> 6), lane = tid & 63, r32 = lane & 31, hi = lane >> 5;
    const int own = cur.qb, NT = 4 * (own + 1);
    const int qlo = own * QB + wid * QBLK, qm = qlo + r32 - 4 * hi;
    char* V_lds = lds; char* K_lds = lds + 2 * SHM_V;
    float* ws = (float*)(lds + OFF_WSF) + wid * 64; float* li_l = ws, * al_l = ws + 32;
    float m_reg = -1e30f, l_reg = 0; f32x16 o[4] = {};
    const int sr = tid >> 4, sc = (tid & 15) * 8, vst0 = v_st(sr, sc), vst1 = v_st(32 + sr, sc), kws = KSWZ(sr, sc * 2);
    const int vb0 = (int)(uintptr_t)V_lds + v_rd_base(lane);
    const bf16* Kh = cur.K; const bf16* Vh = cur.V;
    unsigned selmask = 0;
    {   f32x16 g = f32x16{};
        int gl = lane; asm volatile("" : "+v"(gl));
        const int gr = gl & 31, gh = gl >> 5;
        const char* kmb[4];
#pragma unroll
        for (int dd = 0; dd < 4; ++dd) kmb[dd] = lds + OFF_KM + KSWZ(gr, (dd * 16 + gh * 8) * 2);
#pragma unroll
        for (int d0 = 0; d0 < 8; ++d0) { const bf16x8 a = *reinterpret_cast<const bf16x8*>(kmb[d0 & 3] + (d0 >> 2) * 128); g = __builtin_amdgcn_mfma_f32_32x32x16_bf16(a, S.qr[d0], g, 0, 0, 0); }
        float gate[8];
#pragma unroll
        for (int i = 0; i < 4; ++i) { const float a = g[i] + g[4 + i]; auto rr = __builtin_amdgcn_permlane32_swap(__float_as_uint(a), __float_as_uint(a), false, false);
            gate[i] = __uint_as_float(rr[0]); gate[4 + i] = __uint_as_float(rr[1]); }
#pragma unroll
        for (int n = 0; n < 8; ++n) if (n >= own) gate[n] = -__builtin_inff();
#pragma unroll
        for (int n = 0; n < 8; ++n) { int rank = 0;
#pragma unroll
            for (int n2 = 0; n2 < 8; ++n2) if (n2 != n) rank += (gate[n2] > gate[n] || (gate[n2] == gate[n] && n2 < n)) ? 1 : 0;
            if (n < own && rank < 3) selmask |= 1u << n; }
    }
#define RESC(a) do { if (__any((a) < 1.f)) { if (hi == 0) al_l[r32] = (a); asm volatile("s_waitcnt lgkmcnt(0)" ::: "memory");              \
                     for (int d_ = 0; d_ < 4; ++d_) for (int r = 0; r < 16; ++r) o[d_][r] *= al_l[crow(r, hi)]; } } while (0)
#define KBASE(t) ((t) * KVBLK)
#define MASKED(t) (((t) >> 2) < own && !((selmask >> ((t) >> 2)) & 1u))
#define MASKT(P0_, P1_, t) do { const int kb_ = KBASE(t); if (((t) >> 2) == own && kb_ + KVBLK - 1 > qlo) mask_tile(P0_, P1_, qm - kb_); } while (0)
    constexpr int NQL = 8;
#define SEAM_K0() do { VMWN(NQL); SWRITE_HK(0); SBAR(); } while (0)
    f32x16 pA0, pA1, pB0, pB1; float mnA, mnB, alA, alB; bf16x8 pa0, pa1, pa2, pa3;
    SWRITE_HV(0); SBAR();
    SLOAD_H(Kh, Vh, KBASE(1));
    SBAR(); qkt<0>(pA0, pA1, K_lds, r32, hi, S.qr);
    MASKT(pA0, pA1, 0); partialSM(pA0, pA1, m_reg, mnA, alA, MASKED(0));
    VMW(); SWRITE_H(1);
    __syncthreads();
#define HALF_STEP(PX0, PX1, mnX, alX, PY0, PY1, alY, t, KB, VB, SB) do {                                                      \
        SBAR(); qkt<KB>(PX0, PX1, K_lds, r32, hi, S.qr);                                                         \
        finishSM(PY0, PY1, alY, l_reg, pa0, pa1, pa2, pa3); SBAR();                                                           \
        if ((t) + 1 < NT) { SLOAD_H(Kh, Vh, KBASE((t) + 1)); SBAR(); }                                               \
        pv_sm<VB>(o, vb0, pa0, pa1, pa2, pa3, PX0, PX1, m_reg, mnX, alX, MASKED(t), (((t) >> 2) == own && KBASE(t) + KVBLK - 1 > qlo), qm - KBASE(t));                \
        __syncthreads();                                                                                                      \
        if ((t) + 1 < NT) { VMW(); SWRITE_H(SB); }                                                                          \
        RESC(alX); __syncthreads(); } while (0)
    for (int t = 1; t + 1 < NT; t += 2) {
        HALF_STEP(pB0, pB1, mnB, alB, pA0, pA1, alA, t, 1, 0, 0);
        HALF_STEP(pA0, pA1, mnA, alA, pB0, pB1, alB, t + 1, 0, 1, 1);
    }
    SBAR(); qkt<1>(pB0, pB1, K_lds, r32, hi, S.qr); SBAR();
    SLOAD_H(nxt.K, nxt.V, 0); SBAR();
#pragma unroll
    for (int d0 = 0; d0 < 8; ++d0) S.qr[d0] = ld8(nxt.Q + (size_t)(wid * QBLK + r32) * PITCH + d0 * 16 + hi * 8);
    SBAR();
    finishSM(pA0, pA1, alA, l_reg, pa0, pa1, pa2, pa3); SBAR();
    pv_tile<0>(o, vb0, pa0, pa1, pa2, pa3);
    MASKT(pB0, pB1, NT - 1); partialSM(pB0, pB1, m_reg, mnB, alB, MASKED(NT - 1)); __syncthreads(); RESC(alB);
    finishSM(pB0, pB1, alB, l_reg, pa0, pa1, pa2, pa3); SBAR(); pv_tile<1>(o, vb0, pa0, pa1, pa2, pa3);
    SBAR(); SEAM_K0();
    if (nxt.bh != cur.bh) write_km(C.kmean + (size_t)nxt.bh * 8 * 128, lds + OFF_KM, tid);
    if (hi == 0) li_l[r32] = l_reg; asm volatile("s_waitcnt lgkmcnt(0)" ::: "memory");
    float rli[16];
#pragma unroll
    for (int r = 0; r < 16; ++r) rli[r] = __builtin_amdgcn_rcpf(li_l[crow(r, hi)]);
    {   int el = lane; asm volatile("" : "+v"(el));
        const int er32 = el & 31, ehi = el >> 5, erow = el >> 4, ech = el & 15;
        char* stg = lds + OFF_OST + wid * 8192;
        const int h = cur.bh & 7;
        const int mrow = cur.m0 + wid * QBLK;
        char* wb = stg + (4 * ehi) * 256 + er32 * 2;
#pragma unroll
        for (int r = 0; r < 16; ++r) {
#pragma unroll
            for (int d0 = 0; d0 < 4; ++d0) { const float v = o[d0][r] * rli[r]; const unsigned w = cvtpk(v, v);
                *(bf16*)(wb + ((r & 3) + 8 * (r >> 2)) * 256 + d0 * 64) = (bf16)(w & 0xffffu); } }
        asm volatile("s_waitcnt lgkmcnt(0)" ::: "memory"); SBAR();
        const char* rb = stg + erow * 256 + ech * 16;
        const bf16* zp = C.ZA + (size_t)(mrow + erow) * 1024 + h * 128 + ech * 8;
        bf16* yp = C.Y + (size_t)(mrow + erow) * 2048 + 1024 + h * 128 + ech * 8;
        unsigned char* yp8 = (unsigned char*)C.Y + (size_t)(mrow + erow) * 2048 + 1024 + h * 128 + ech * 8;
        float* sp = C.SSQ + (size_t)(mrow + erow) * 8 + h;
        u32x4 zz[8];
#pragma unroll
        for (int i = 0; i < 8; ++i) zz[i] = *(const u32x4*)(zp + (size_t)i * 4096);
#pragma unroll
        for (int i = 0; i < 8; ++i) {
            const u32x4 v = *(const u32x4*)(rb + i * 1024);
            float ov[8] = {bflo(v[0]), bfhi(v[0]), bflo(v[1]), bfhi(v[1]), bflo(v[2]), bfhi(v[2]), bflo(v[3]), bfhi(v[3])};
            float zv[8] = {bflo(zz[i][0]), bfhi(zz[i][0]), bflo(zz[i][1]), bfhi(zz[i][1]), bflo(zz[i][2]), bfhi(zz[i][2]), bflo(zz[i][3]), bfhi(zz[i][3])};
            float ss = 0.f, y[8];
#pragma unroll
            for (int e = 0; e < 8; ++e) { ss += ov[e] * ov[e]; y[e] = ov[e] * (zv[e] / (1.0f + __expf(-zv[e]))); }
            ss += __shfl_xor(ss, 1); ss += __shfl_xor(ss, 2); ss += __shfl_xor(ss, 4); ss += __shfl_xor(ss, 8);
            if (ech == 0) sp[i * 32] = ss;
            if (C.y8 != 0.0f) { typedef unsigned u32x2 __attribute__((ext_vector_type(2))); u32x2 w; unsigned t = 0;
#pragma unroll
                for (int e = 0; e < 8; ++e) y[e] = fminf(fmaxf(y[e] * C.y8, -448.0f), 448.0f);
                t = __builtin_amdgcn_cvt_pk_fp8_f32(y[0], y[1], t, false); t = __builtin_amdgcn_cvt_pk_fp8_f32(y[2], y[3], t, true); w.x = t; t = 0;
                t = __builtin_amdgcn_cvt_pk_fp8_f32(y[4], y[5], t, false); t = __builtin_amdgcn_cvt_pk_fp8_f32(y[6], y[7], t, true); w.y = t;
                *(u32x2*)(yp8 + (size_t)i * 8192) = w; }
            else { u32x4 w = {cvtpk(y[0], y[1]), cvtpk(y[2], y[3]), cvtpk(y[4], y[5]), cvtpk(y[6], y[7])};
            *(u32x4*)(yp + (size_t)i * 8192) = w; } }
    }
    __syncthreads();
#undef RESC
#undef KBASE
#undef MASKED
#undef MASKT
#undef SEAM_K0
#undef HALF_STEP
}
#undef ROW
#undef VMW
#undef VMWN
#undef SLOAD_H
#undef SWRITE_HK
#undef SWRITE_HV
#undef SWRITE_H
#undef KSWZ
#undef SBAR
}


struct Frame {
    LAS unsigned char* lds;
    volatile LAS unsigned* MISC;
    gu32* ctl;
    int tid, lane, wave;
    int vcu, G;
    const float *x, *norm_gain, *w_in, *conv_w, *qg, *kg, *cog, *aog, *w_out; float* out;
    bf16 *WinT, *WoutT, *XN, *PROJ, *Y; float *KMEAN, *SSQ, *XRS; unsigned char *XN8, *Win8;
};

__device__ __forceinline__ float wave_sum(float v) {
#pragma unroll
    for (int o = 1; o < 64; o <<= 1) v += __shfl_xor(v, o);
    return v;
}
__device__ __forceinline__ float wave_max(float v) {
#pragma unroll
    for (int o = 1; o < 64; o <<= 1) v = fmaxf(v, __shfl_xor(v, o));
    return v;
}
__device__ __forceinline__ float bf_lo(unsigned w) { return __builtin_bit_cast(float, w << 16); }
__device__ __forceinline__ float bf_hi(unsigned w) { return __builtin_bit_cast(float, w & 0xffff0000u); }
__device__ __forceinline__ float silu_f(float z) { return z / (1.0f + __expf(-z)); }
__device__ __forceinline__ float clamp8(float v) { return fminf(fmaxf(v, -448.0f), 448.0f); }
__device__ __forceinline__ unsigned pk4_fp8(float a, float b, float c, float d) { a = clamp8(a); b = clamp8(b); c = clamp8(c); d = clamp8(d); unsigned w = 0; w = __builtin_amdgcn_cvt_pk_fp8_f32(a, b, w, false); w = __builtin_amdgcn_cvt_pk_fp8_f32(c, d, w, true); return w; }

__device__ __forceinline__ void p0_transpose_item(const float* W, const float* g0, const float* g1, int ksplit, int K, int N, bf16* WT, LAS float* scr, int item, int lane, bool fp8 = false, float wscale = 1.0f, int drow = -1, int pitch8 = 0) {
    const int nblk = N / 32, kb = item / nblk, nb = item % nblk, k0 = 64 * kb, n0 = 32 * nb, d0 = drow >= 0 ? drow : n0;
    float wv[32];
    const float* wp = W + (size_t)(k0 + (lane >> 5)) * N + n0 + (lane & 31);
#pragma unroll
    for (int i = 0; i < 32; ++i) wv[i] = __builtin_nontemporal_load(wp + (size_t)(2 * i) * N);
    const float* gp = (k0 < ksplit) ? g0 + k0 : g1 + (k0 - ksplit);
    const float gl = gp[lane];
#pragma unroll
    for (int i = 0; i < 32; ++i) { const int kk = 2 * i + (lane >> 5); const float gv = __shfl(gl, kk);
        scr[kk * 33 + (lane & 31)] = wv[i] * gv; }
    LDS_WAIT(); asm volatile("" ::: "memory");
    const int c = lane & 7;
#pragma unroll
    for (int j = 0; j < 4; ++j) { const int n = (lane >> 3) + 8 * j; const LAS float* s = scr + (8 * c) * 33 + n;
        if (fp8) { typedef unsigned u32x2g __attribute__((ext_vector_type(2))); u32x2g o;
            o.x = pk4_fp8(s[0 * 33] * wscale, s[1 * 33] * wscale, s[2 * 33] * wscale, s[3 * 33] * wscale); o.y = pk4_fp8(s[4 * 33] * wscale, s[5 * 33] * wscale, s[6 * 33] * wscale, s[7 * 33] * wscale);
            *(GAS u32x2g*)((unsigned char*)WT + (size_t)(d0 + n) * (pitch8 ? pitch8 : K) + k0 + 8 * c) = o; }
        else { v4u o; o.x = pk2(s[0 * 33] * wscale, s[1 * 33] * wscale); o.y = pk2(s[2 * 33] * wscale, s[3 * 33] * wscale); o.z = pk2(s[4 * 33] * wscale, s[5 * 33] * wscale); o.w = pk2(s[6 * 33] * wscale, s[7 * 33] * wscale);
        *(GAS v4u*)(WT + (size_t)(d0 + n) * K + k0 + 8 * c) = o; } }
    LDS_WAIT(); asm volatile("" ::: "memory");
}
__device__ __forceinline__ void rms_row_to_bf16(Frame& F, const float* xrow, bf16* orow) {
    const GAS f32x4* xr = (const GAS f32x4*)xrow + F.lane;
    f32x4 v[8]; float s = 0.f;
#pragma unroll
    for (int j = 0; j < 8; ++j) { v[j] = xr[64 * j]; s += (v[j].x * v[j].x + v[j].y * v[j].y) + (v[j].z * v[j].z + v[j].w * v[j].w); }
    const float rs = 1.f / sqrtf(wave_sum(s) * (1.f / DM) + EPS);
    GAS unsigned long long* o8 = (GAS unsigned long long*)orow + F.lane;
#pragma unroll
    for (int j = 0; j < 8; ++j) o8[64 * j] = (unsigned long long)pk2(v[j].x * rs, v[j].y * rs) | ((unsigned long long)pk2(v[j].z * rs, v[j].w * rs) << 32);
}
__device__ __forceinline__ void rms_row2_to_bf16(Frame& F, const float* xrow, bf16* orow, size_t rstride) {
    const GAS f32x4* xa = (const GAS f32x4*)xrow + F.lane; const GAS f32x4* xb = (const GAS f32x4*)(xrow + rstride) + F.lane;
    f32x4 va[8], vb[8]; float sa = 0.f, sb = 0.f;
#pragma unroll
    for (int j = 0; j < 8; ++j) va[j] = __builtin_nontemporal_load(xa + 64 * j);
#pragma unroll
    for (int j = 0; j < 8; ++j) vb[j] = __builtin_nontemporal_load(xb + 64 * j);
#pragma unroll
    for (int j = 0; j < 8; ++j) sa += (va[j].x * va[j].x + va[j].y * va[j].y) + (va[j].z * va[j].z + va[j].w * va[j].w);
#pragma unroll
    for (int j = 0; j < 8; ++j) sb += (vb[j].x * vb[j].x + vb[j].y * vb[j].y) + (vb[j].z * vb[j].z + vb[j].w * vb[j].w);
    const float qa = sqrtf(wave_sum(sa) * (1.f / DM) + EPS), qb = sqrtf(wave_sum(sb) * (1.f / DM) + EPS), ra = 1.f / qa, rb = 1.f / qb;
    if (F.lane == 0) { const size_t m = (size_t)(orow - F.XN) / DM; F.XRS[m] = qa; F.XRS[m + rstride / DM] = qb; }
    GAS unsigned long long* oa = (GAS unsigned long long*)orow + F.lane; GAS unsigned long long* ob = (GAS unsigned long long*)(orow + rstride) + F.lane;
#pragma unroll
    for (int j = 0; j < 8; ++j) oa[64 * j] = (unsigned long long)pk2(va[j].x * ra, va[j].y * ra) | ((unsigned long long)pk2(va[j].z * ra, va[j].w * ra) << 32);
#pragma unroll
    for (int j = 0; j < 8; ++j) ob[64 * j] = (unsigned long long)pk2(vb[j].x * rb, vb[j].y * rb) | ((unsigned long long)pk2(vb[j].z * rb, vb[j].w * rb) << 32);
    if (NF8 > 0) { GAS unsigned* pa = (GAS unsigned*)(F.XN8 + (orow - F.XN)) + F.lane; GAS unsigned* pb = (GAS unsigned*)(F.XN8 + (orow - F.XN) + rstride) + F.lane;
#pragma unroll
        for (int j = 0; j < 8; ++j) { pa[64 * j] = pk4_fp8(va[j].x * ra, va[j].y * ra, va[j].z * ra, va[j].w * ra); pb[64 * j] = pk4_fp8(vb[j].x * rb, vb[j].y * rb, vb[j].z * rb, vb[j].w * rb); } }
}
__device__ __forceinline__ void p0_prologue(Frame& F, bool wout) {
    LAS float* scr = (LAS float*)(F.lds + RING_OFF + F.wave * 16384);
    const int gw = F.vcu * NWAVES + F.wave, NGW = F.G * NWAVES;
    constexpr int I_IN = (DM / 64) * (DIN / 32), I_OUT = (DMIX / 64) * (DM / 32);
    if (!wout) for (int m = gw; m < M; m += 2 * NGW) rms_row2_to_bf16(F, F.x + (size_t)m * DM, F.XN + (size_t)m * DM, (size_t)NGW * DM);
    for (int it = (wout ? I_IN : 0) + gw; it < (wout ? I_IN + I_OUT : I_IN); it += NGW) {
        if (it < I_IN) { const int n0 = 32 * (it % (DIN / 32)), ts = n0 >> 10, c0 = n0 & 1023; int lt0, roff;
            if (ts == 0 || ts == 2) { lt0 = 16 + (c0 >> 7); roff = (ts >> 1) * 128 + (c0 & 127); }
            else { lt0 = (int)((PPOS >> (4 * ts)) & 15u) * 4 + (c0 >> 8); roff = c0 & 255; }
            if ((lt0 >> 2) < NF8) p0_transpose_item(F.w_in, F.norm_gain, F.norm_gain, DM, DM, DIN, (bf16*)F.Win8, scr, it, F.lane, true, WI8_SCALE, lt0 * 256 + roff);
            else p0_transpose_item(F.w_in, F.norm_gain, F.norm_gain, DM, DM, DIN, F.WinT, scr, it, F.lane, false, 1.0f, (lt0 - 4 * NF8) * 256 + roff); }
        else if (HYBP > 0) { const int k0o = 64 * ((it - I_IN) / (DM / 32));
            if (k0o < HYBC) p0_transpose_item(F.w_out, F.cog, F.aog, DCONV, DMIX, DM, F.WoutT, scr, it - I_IN, F.lane, true, HYB_W, -1, DMIX * 2);
            else p0_transpose_item(F.w_out, F.cog, F.aog, DCONV, DMIX, DM, F.WoutT, scr, it - I_IN, F.lane, false, HYB_ALL); }
        else p0_transpose_item(F.w_out, F.cog, F.aog, DCONV, DMIX, DM, F.WoutT, scr, it - I_IN, F.lane, FP8_OUT, W8_SCALE);
    }
}

__device__ __forceinline__ void unpack8(const v4u a, float (&f)[16], int o) {
    f[o + 0] = bf_lo(a.x); f[o + 1] = bf_hi(a.x); f[o + 2] = bf_lo(a.y); f[o + 3] = bf_hi(a.y); f[o + 4] = bf_lo(a.z); f[o + 5] = bf_hi(a.z); f[o + 6] = bf_lo(a.w); f[o + 7] = bf_hi(a.w); }
__device__ __forceinline__ void p2_conv(Frame& F) {
    const int gw = F.vcu * NWAVES + F.wave, NGW = F.G * NWAVES;
    const bf16* UU = F.PROJ; const bf16* BG = F.PROJ + PROJ_STRIDE / 2; const bf16* ZC = F.PROJ + 3 * (PROJ_STRIDE / 2);
    for (int ck = gw; ck < M / 8; ck += NGW) {
        const int m0 = ck * 8, t0 = m0 % SEQ;
        const size_t co = (size_t)8 * F.lane;
        float w0[16], w1[16], w2[16], u1[16], u2[16];
#pragma unroll
        for (int j = 0; j < 2; ++j)
#pragma unroll
            for (int q = 0; q < 2; ++q) { const int c = 8 * F.lane + 512 * j + 4 * q;
                const f32x4 a = *(const GAS f32x4*)(F.conv_w + c), b = *(const GAS f32x4*)(F.conv_w + DCONV + c), d = *(const GAS f32x4*)(F.conv_w + 2 * DCONV + c);
#pragma unroll
                for (int e = 0; e < 4; ++e) { w0[8 * j + 4 * q + e] = a[e]; w1[8 * j + 4 * q + e] = b[e]; w2[8 * j + 4 * q + e] = d[e]; } }
        if (t0 > 0) {
#pragma unroll
            for (int j = 0; j < 2; ++j) { unpack8(__builtin_nontemporal_load((const GAS v4u*)(UU + (size_t)(m0 - 2) * 1024 + co + 512 * j)), u2, 8 * j); unpack8(__builtin_nontemporal_load((const GAS v4u*)(UU + (size_t)(m0 - 1) * 1024 + co + 512 * j)), u1, 8 * j); }
        } else {
#pragma unroll
            for (int e = 0; e < 16; ++e) { u1[e] = 0.f; u2[e] = 0.f; }
        }
#pragma unroll 2
        for (int i = 0; i < 8; ++i) {
            const size_t m = (size_t)(m0 + i);
            float u0[16], bb[16], zz[16], y[16];
#pragma unroll
            for (int j = 0; j < 2; ++j) { unpack8(__builtin_nontemporal_load((const GAS v4u*)(UU + m * 1024 + co + 512 * j)), u0, 8 * j);
                unpack8(__builtin_nontemporal_load((const GAS v4u*)(BG + m * 1024 + co + 512 * j)), bb, 8 * j); unpack8(__builtin_nontemporal_load((const GAS v4u*)(ZC + m * 1024 + co + 512 * j)), zz, 8 * j); }
            float ss = 0.f;
#pragma unroll
            for (int e = 0; e < 16; ++e) { const float cv = w0[e] * u2[e] + w1[e] * u1[e] + w2[e] * u0[e]; y[e] = bb[e] * cv; ss += y[e] * y[e]; u2[e] = u1[e]; u1[e] = u0[e]; }
            const float rs = 1.f / sqrtf(wave_sum(ss) * (1.f / DCONV) + EPS);
#pragma unroll
            for (int j = 0; j < 2; ++j) { float o[8];
#pragma unroll
                for (int e = 0; e < 8; ++e) o[e] = y[8 * j + e] * rs * silu_f(zz[8 * j + e]);
                if (HYBP > 0 && 512 * j < HYBC) { typedef unsigned u32x2g __attribute__((ext_vector_type(2))); u32x2g w;
                    w.x = pk4_fp8(o[0] * HYB_Y, o[1] * HYB_Y, o[2] * HYB_Y, o[3] * HYB_Y); w.y = pk4_fp8(o[4] * HYB_Y, o[5] * HYB_Y, o[6] * HYB_Y, o[7] * HYB_Y);
                    *(GAS u32x2g*)((unsigned char*)F.Y + m * (DMIX * 2) + co + 512 * j) = w; }
                else if (FP8_OUT) { typedef unsigned u32x2g __attribute__((ext_vector_type(2))); u32x2g w;
                    w.x = pk4_fp8(o[0] * Y8C_SCALE, o[1] * Y8C_SCALE, o[2] * Y8C_SCALE, o[3] * Y8C_SCALE); w.y = pk4_fp8(o[4] * Y8C_SCALE, o[5] * Y8C_SCALE, o[6] * Y8C_SCALE, o[7] * Y8C_SCALE);
                    *(GAS u32x2g*)((unsigned char*)F.Y + m * DMIX + co + 512 * j) = w; }
                else { v4u w; w.x = pk2(o[0], o[1]); w.y = pk2(o[2], o[3]); w.z = pk2(o[4], o[5]); w.w = pk2(o[6], o[7]);
                *(GAS v4u*)(F.Y + m * DMIX + co + 512 * j) = w; } }
        }
    }
}
__device__ __forceinline__ moba::BlockRef moba_ref(Frame& F, int bh, int qb) {
    const int b = bh >> 3, h = bh & 7; moba::BlockRef r;
    const bf16* Q = F.PROJ + 4 * (PROJ_STRIDE / 2); const bf16* K = F.PROJ + 5 * (PROJ_STRIDE / 2); const bf16* V = F.PROJ + 6 * (PROJ_STRIDE / 2);
    r.Q = Q + ((size_t)bh * SEQ + (size_t)qb * 256) * HD; r.K = K + (size_t)bh * SEQ * HD; r.V = V + (size_t)bh * SEQ * HD;
    r.bh = bh; r.qb = qb; r.m0 = b * SEQ + qb * 256; return r;
}
__device__ __forceinline__ void p3_attn(Frame& F, char* lds) {
    static_assert(moba::LDS_BYTES <= RING_BYTES, "attention LDS vs ring");
    moba::Ctx C{F.KMEAN, F.PROJ + 7 * (PROJ_STRIDE / 2), F.Y, F.SSQ, FP8_OUT ? Y8A_SCALE : 0.0f};
    for (int L = F.vcu; L < BATCH * NH * 4; L += F.G) {
        const int bh = L >> 2, x = L & 3;
        const moba::BlockRef r0 = moba_ref(F, bh, x), r1 = moba_ref(F, bh, 7 - x);
        moba::Seam S;
        moba::moba_prime(r0, C, lds, S);
        moba::moba_block(r0, r1, C, lds, S);
        moba::moba_block(r1, r1, C, lds, S);
    }
}
struct Args { const float* in[9]; float* out; unsigned char* ws; int ph_lo, ph_hi, li, pad; };
__global__ void __launch_bounds__(NWAVES * 64, 2) skel_fwd(Args args) {
    extern __shared__ __attribute__((aligned(16))) unsigned char lds[];
    Frame F;
    F.lds = (LAS unsigned char*)lds;
    F.MISC = (volatile LAS unsigned*)(F.lds + MISC_OFF);
    F.tid = threadIdx.x; F.lane = F.tid & 63; F.wave = __builtin_amdgcn_readfirstlane(F.tid >> 6);
    F.G = gridDim.x; { const int bx = blockIdx.x; F.vcu = (F.G % 8 == 0) ? (bx % 8) * (F.G / 8) + bx / 8 : bx; }
#define GRID_BAR(seam) do { if (!ONE_LAUNCH) { if (F.tid == 0) __hip_atomic_store(F.ctl + CW_TMO, 0xBADBA0u | (unsigned)(seam), RLX_AGENT); } \
    else if ((seam) != 0 && MK_LOCBAR && F.MISC[10]) { xcd_barrier_local(bar); }     \
    else { xcd_barrier(bar); } } while (0)
    unsigned char* ws = args.ws;
    F.ctl = (gu32*)(ws + WS_CTL);
    F.x = args.in[0]; F.norm_gain = args.in[1]; F.w_in = args.in[2]; F.conv_w = args.in[3]; F.qg = args.in[4]; F.kg = args.in[5];
    F.cog = args.in[6]; F.aog = args.in[7]; F.w_out = args.in[8]; F.out = args.out;
    F.WinT = (bf16*)(ws + WS_WIN); F.WoutT = (bf16*)(ws + WS_WOUT); F.XN = (bf16*)(ws + WS_XN); F.PROJ = (bf16*)(ws + WS_PROJ); F.Y = (bf16*)(ws + WS_Y);
    F.KMEAN = (float*)(ws + WS_KMEAN); F.SSQ = (float*)(ws + WS_SSQ); F.XRS = (float*)(ws + WS_XRS); F.XN8 = ws + WS_XN8; F.Win8 = ws + WS_WIN8;
    for (int u = F.tid; u < (LDS_BYTES - LDSCTL_OFF) / 4; u += NWAVES * 64) ((LAS unsigned*)(F.lds + LDSCTL_OFF))[u] = 0u;
    __syncthreads();
    XcdBarrier bar; bar.bar = (unsigned*)(F.ctl + CW_BAR); bar.x = 0; bar.st = nullptr;
    if (ONE_LAUNCH) { bar = xcd_barrier_post((unsigned*)(F.ctl + CW_BAR), F.MISC + 8);
        if (F.tid == 0 && (bar.x != ((unsigned)blockIdx.x & 7u) || (F.G & 7) != 0 || F.G != 256)) (void)xb_add(&bar.bar[XB_MIS], 1u); }

    const int lo = args.ph_lo, hi = args.ph_hi;
#define IN(k) (lo <= (k) && (k) < hi)
#define BOTH(k) (IN(k) && IN((k) + 1))
    const pg8::EpiOut E3{F.XN, F.XRS, F.out, DM, F.SSQ, EPS, (LAS float*)(F.lds + 131072), FP8_OUT ? 1.0f / (Y8A_SCALE * W8_SCALE) : (HYBP > 0 ? 1.0f / HYB_ALL : 1.0f), FP8_OUT ? Y8A_SCALE / Y8C_SCALE : 1.0f};
    pg8::EpiOut::Pre pre3;

    if (IN(0)) { p0_prologue(F, false); p0_prologue(F, true);
        if (BOTH(0)) { GRID_BAR(0); if (F.tid == 0) F.MISC[10] = (ONE_LAUNCH && xb_ld(&bar.bar[XB_MIS]) == 0u) ? 1u : 0u; __syncthreads(); } }

    if (IN(1)) {
        {
        { pg8::Gemm g{F.XN, F.WinT, M, DIN - NF8 * 1024, DM}; pg8::StaticOrder S; S.init(M, DIN - NF8 * 1024, F.G, (int)blockIdx.x);
        pg8::EpiProj E{F.PROJ, PROJ_STRIDE / 2, F.qg, F.kg, F.KMEAN, F.lds + 131072, EPS, 4 * NF8, PORD, 1.0f};
        pg8::gemm_phase<pg8::EpiProj, pg8::StaticOrder, true, PG8_SP2>(F.lds + RING_OFF, g, S, E); }
        if constexpr (NF8 > 0) {
            pg8::Gemm g{(const bf16*)F.XN8, (const bf16*)F.Win8, M, NF8 * 1024, DM / 2}; pg8::StaticOrder S; S.init(M, NF8 * 1024, F.G, (int)blockIdx.x);
            pg8::EpiProj E{F.PROJ, PROJ_STRIDE / 2, F.qg, F.kg, F.KMEAN, F.lds + 131072, EPS, 0, PORD, 1.0f / (X8_SCALE * WI8_SCALE)};
            pg8::gemm_phase<pg8::EpiProj, pg8::StaticOrder, true, PG8_SP2_FP8, true>(F.lds + RING_OFF, g, S, E); }
 }
        if (BOTH(1)) GRID_BAR(1);
    }
    if (IN(2)) {
        p2_conv(F);
        p3_attn(F, (char*)lds);
        if (BOTH(2)) {
            pg8::StaticOrder S3; S3.init(M, DM, F.G, (int)blockIdx.x); pg8::Unit u3; if (S3.next(0, u3)) E3.init_issue(pre3, u3, F.wave >> 2, F.wave & 3, F.lane);
            GRID_BAR(2); }
    }
    if (IN(3)) {
        pg8::Gemm g{F.Y, F.WoutT, M, DM, FP8_OUT ? DMIX / 2 : DMIX}; pg8::StaticOrder S; S.init(M, DM, F.G, (int)blockIdx.x);
        if (!BOTH(2)) { pg8::Unit u3; if (S.next(0, u3)) E3.init_issue(pre3, u3, F.wave >> 2, F.wave & 3, F.lane); }
        pg8::gemm_phase<pg8::EpiOut, pg8::StaticOrder, true, (FP8_OUT ? PG8_SP2_FP8 : PG8_SP2), FP8_OUT, (FP8_OUT ? 0 : HYBP)>(F.lds + RING_OFF, g, S, E3, &pre3);
    }
#undef IN
#undef BOTH
}

extern "C" void kernel_launch(void* const* d_in, const int* in_sizes, int n_in, void* d_out, int out_size, void* d_ws, size_t ws_size, hipStream_t stream) {
    static int grid = 0;
    if (grid == 0) {
        if (n_in != 9 || in_sizes[0] != M * DM || out_size != M * DM || ws_size < WS_END) { fprintf(stderr, "kernel_launch: shape/workspace mismatch (n_in %d, in0 %d, out %d, ws %zu)\n", n_in, n_in > 0 ? in_sizes[0] : -1, out_size, ws_size); grid = -1; return; }
        int dev = 0, cus = 0;
        if (hipGetDevice(&dev) != hipSuccess || hipDeviceGetAttribute(&cus, hipDeviceAttributeMultiprocessorCount, dev) != hipSuccess) { fprintf(stderr, "kernel_launch: device query failed\n"); grid = -1; return; }
        if (hipFuncSetAttribute((const void*)skel_fwd, hipFuncAttributeMaxDynamicSharedMemorySize, LDS_BYTES) != hipSuccess) { fprintf(stderr, "kernel_launch: hipFuncSetAttribute failed\n"); grid = -1; return; }
        (void)hipGetLastError();
        grid = cus;
    }
    if (grid < 0) return;
    if (hipMemsetAsync((char*)d_ws + WS_CTL, 0, CTL_ZERO_BYTES, stream) != hipSuccess) { fprintf(stderr, "kernel_launch: hipMemsetAsync failed\n"); return; }
    Args a{};
    for (int i = 0; i < 9; ++i) a.in[i] = (const float*)d_in[i];
    a.out = (float*)d_out; a.ws = (unsigned char*)d_ws;
    if (ONE_LAUNCH) {
        a.ph_lo = 0; a.ph_hi = PER_PHASE; a.li = 0;
        hipLaunchKernelGGL(skel_fwd, dim3(grid), dim3(NWAVES * 64), LDS_BYTES, stream, a);
    } else {
        for (int li = 0; li < PER_PHASE; ++li) { a.ph_lo = li; a.ph_hi = li + 1; a.li = li;
            hipLaunchKernelGGL(skel_fwd, dim3(grid), dim3(NWAVES * 64), LDS_BYTES, stream, a); }
    }
}
```

```cpp
#define MK_NF8 6
#define MK_FP8_OUT 0
#define MK_HYB 3
#define MOBA_QLA 4
#include <hip/hip_runtime.h>
#include <cstdio>
#include <cstdint>
namespace pg8 {
#define PG8_LAS __attribute__((address_space(3)))
typedef unsigned short bf16_t;
typedef short bf16x8 __attribute__((ext_vector_type(8)));
typedef float f32x4 __attribute__((ext_vector_type(4)));
typedef unsigned u32x4 __attribute__((ext_vector_type(4)));
constexpr int BM = 256, BK = 64, HALF = 128, HTB = HALF * BK * 2  , STAGE_BYTES = 8 * HTB, NXCD = 8, WGM = 8;

__host__ __device__ __forceinline__ int lds_byte(int r, int c) { const int st = (r >> 4) * 2 + (c >> 5), rr = r & 15, cc = c & 31, ob = rr * 64 + cc * 2; return st * 1024 + (ob ^ (((ob >> 9) & 1) << 5)); }
__host__ __device__ __forceinline__ void stage_rc(int b, int& R, int& C) { const int st = b / 1024, sb = b % 1024, swz = sb ^ (((sb >> 9) & 1) << 5); R = (st >> 1) * 16 + swz / 64; C = (st & 1) * 32 + (swz % 64) / 2; }
__host__ __device__ __forceinline__ int perm32(int rho) { const int n = rho >> 4, i = rho & 15; return 8 * (i >> 2) + 4 * n + (i & 3); }

struct Unit { int pm, pn; };
struct Gemm { const bf16_t* A; const bf16_t* Bt; int M, N, K; };

struct StaticOrder {
    int nM, nN, nwg, G, c;
    __host__ __device__ void init(int M, int N, int G_, int c_) { nM = M / BM; nN = N / BM; nwg = nM * nN; G = G_; c = c_; }
    __host__ __device__ bool next(int i, Unit& u) const {
        const long L = (long)i * G + c; if (L >= nwg) return false;
        int wgid = (int)L; { const int q = nwg / NXCD, r = nwg % NXCD, xcd = wgid % NXCD, off = wgid / NXCD; wgid = (xcd < r ? xcd * (q + 1) : r * (q + 1) + (xcd - r) * q) + off; }
        const int nig = WGM * nN, gid = wgid / nig, fm = gid * WGM, gsz = (nM - fm) < WGM ? (nM - fm) : WGM;
        u.pm = fm + ((wgid % nig) % gsz); u.pn = (wgid % nig) / gsz; return true;
    }
    __device__ __forceinline__ void a_ready(const Unit&) const {}
    __device__ __forceinline__ void done(const Unit&) const {}
};

__device__ __forceinline__ unsigned cvt_pk_bf16(float lo, float hi) { unsigned r; asm volatile("v_cvt_pk_bf16_f32 %0, %1, %2" : "=v"(r) : "v"(lo), "v"(hi)); return r; }

typedef float f32x2 __attribute__((ext_vector_type(2)));
struct EpiProj {
    static constexpr bool PERM = true, AFTER_DRAIN = false, MID = false, INIT = false;
    bf16_t* O; size_t tstride; const float* qg; const float* kg; float* kmean; PG8_LAS unsigned char* xl; float eps; int pn_off; unsigned order; float oscale;
    __device__ __forceinline__ void operator()(const f32x4 (&acc)[2][2][4][2], const Unit& u, int wr, int wc, int fr_, int fq_, int wid, int lane) const {
        asm volatile("" : "+v"(lane));
        const int fr = lane & 15, fq = lane >> 4;
        const int lt = u.pn + pn_off, t = (int)((order >> (4 * (lt >> 2))) & 15u), colw = (lt & 3) * BM;
        const int row0 = u.pm * BM + wr * 64 + fr;
        if (lt >= 16 && lt < 24) {
            bf16_t* pb = O + (size_t)row0 * 1024 + (lt & 7) * 128 + wc * 32 + 8 * fq;
            const float os2 = oscale * oscale;
#pragma unroll
            for (int ai = 0; ai < 2; ++ai)
#pragma unroll
                for (int m = 0; m < 4; ++m) { const f32x4 r0 = acc[ai][0][m][0] * acc[ai][1][m][0] * os2, r1 = acc[ai][0][m][1] * acc[ai][1][m][1] * os2;
                    u32x4 w; w.x = cvt_pk_bf16(r0[0], r0[1]); w.y = cvt_pk_bf16(r0[2], r0[3]); w.z = cvt_pk_bf16(r1[0], r1[1]); w.w = cvt_pk_bf16(r1[2], r1[3]);
                    *(u32x4*)(pb + (size_t)(ai * HALF + m * 16) * 1024) = w; }
            return;
        }
        bf16_t* base = O + (size_t)t * tstride;
        const int col0 = colw + wc * 32 + 8 * fq;
        const size_t hm0 = ((size_t)((u.pm >> 3) * 8 + (colw >> 7)) * 2048 + (size_t)((u.pm & 7) * BM + wr * 64 + fr)) * 128 + wc * 32 + 8 * fq;
        if (t != 4 && t != 5) {
#pragma unroll
            for (int ai = 0; ai < 2; ++ai)
#pragma unroll
                for (int m = 0; m < 4; ++m) { bf16_t* rowp = (t == 6) ? base + hm0 + (size_t)(ai * HALF + m * 16) * 128 : base + (size_t)(row0 + ai * HALF + m * 16) * 1024 + col0;
#pragma unroll
                    for (int bj = 0; bj < 2; ++bj) { const f32x4 v0 = acc[ai][bj][m][0] * oscale, v1 = acc[ai][bj][m][1] * oscale;
                        u32x4 w; w.x = cvt_pk_bf16(v0[0], v0[1]); w.y = cvt_pk_bf16(v0[2], v0[3]); w.z = cvt_pk_bf16(v1[0], v1[1]); w.w = cvt_pk_bf16(v1[2], v1[3]);
                        *(u32x4*)(rowp + ((t == 6) ? (size_t)bj * 2048 * 128 : (size_t)bj * HALF)) = w; } }
            return;
        }
        PG8_LAS float* P = (PG8_LAS float*)xl;
        PG8_LAS float* CS = (PG8_LAS float*)(xl + 8192);
        const float* gp = (t == 4 ? qg : kg) + wc * 32 + 8 * fq;
        const f32x4 g0 = *(const f32x4*)gp, g1 = *(const f32x4*)(gp + 4);
#pragma unroll
        for (int ai = 0; ai < 2; ++ai)
#pragma unroll
            for (int m = 0; m < 4; ++m)
#pragma unroll
                for (int bj = 0; bj < 2; ++bj) { const f32x4 a = acc[ai][bj][m][0], b = acc[ai][bj][m][1];
                    float s = ((a[0] * a[0] + a[1] * a[1]) + (a[2] * a[2] + a[3] * a[3])) + ((b[0] * b[0] + b[1] * b[1]) + (b[2] * b[2] + b[3] * b[3]));
                    s += __shfl_xor(s, 16); s += __shfl_xor(s, 32);
                    if (fq == 0) P[(ai * HALF + wr * 64 + m * 16 + fr) * 8 + bj * 4 + wc] = s; }
        asm volatile("s_waitcnt lgkmcnt(0)" ::: "memory"); __builtin_amdgcn_s_barrier(); asm volatile("" ::: "memory");
        f32x4 cs[2][2];
#pragma unroll
        for (int bj = 0; bj < 2; ++bj) { cs[bj][0] = (f32x4){0.f, 0.f, 0.f, 0.f}; cs[bj][1] = (f32x4){0.f, 0.f, 0.f, 0.f}; }
#pragma unroll
        for (int ai = 0; ai < 2; ++ai)
#pragma unroll
            for (int m = 0; m < 4; ++m) { const int rl = ai * HALF + wr * 64 + m * 16 + fr; bf16_t* rowp = base + hm0 + (size_t)(ai * HALF + m * 16) * 128;
#pragma unroll
                for (int bj = 0; bj < 2; ++bj) { const f32x4 p4 = *(const PG8_LAS f32x4*)(P + rl * 8 + bj * 4);
                    const float rs = 1.0f / sqrtf(((p4[0] + p4[1]) + (p4[2] + p4[3])) * (1.0f / 128.0f) + eps);
                    const f32x4 v0 = acc[ai][bj][m][0] * rs * g0, v1 = acc[ai][bj][m][1] * rs * g1;
                    cs[bj][0] += v0; cs[bj][1] += v1; asm volatile("" : "+v"(cs[bj][0]), "+v"(cs[bj][1]));
                    u32x4 w; w.x = cvt_pk_bf16(v0[0], v0[1]); w.y = cvt_pk_bf16(v0[2], v0[3]); w.z = cvt_pk_bf16(v1[0], v1[1]); w.w = cvt_pk_bf16(v1[2], v1[3]);
                    *(u32x4*)(rowp + (size_t)bj * 2048 * 128) = w; } }
        if (t == 5) {
#pragma unroll
            for (int bj = 0; bj < 2; ++bj)
#pragma unroll
                for (int n = 0; n < 2; ++n)
#pragma unroll
                    for (int e = 0; e < 4; ++e) { float s = cs[bj][n][e]; s += __shfl_xor(s, 1); s += __shfl_xor(s, 2); s += __shfl_xor(s, 4); s += __shfl_xor(s, 8); cs[bj][n][e] = s; }
            if (fr == 0) {
#pragma unroll
                for (int bj = 0; bj < 2; ++bj)
#pragma unroll
                    for (int n = 0; n < 2; ++n) *(PG8_LAS f32x4*)(CS + wr * 256 + bj * HALF + wc * 32 + 8 * fq + 4 * n) = cs[bj][n]; }
            asm volatile("s_waitcnt lgkmcnt(0)" ::: "memory"); __builtin_amdgcn_s_barrier(); asm volatile("" ::: "memory");
            const int tid = wid * 64 + lane;
            if (tid < 256) { const int b = u.pm >> 3, blk = u.pm & 7, head = (colw >> 7) + (tid >> 7);
                kmean[(size_t)((b * 8 + head) * 8 + blk) * 128 + (tid & 127)] = (CS[tid] + CS[256 + tid]) * (1.0f / 256.0f); }
        }
    }
};
struct EpiOut {
    static constexpr bool PERM = false, AFTER_DRAIN = false, MID = true, INIT = true;
    const bf16_t* xn; const float* xrs; float* out; int ldc;
     const float* ssq; float eps; PG8_LAS float* rrs; float fin, midk;
    __device__ __forceinline__ void mid(f32x4 (&acc)[2][2][4][2], const Unit& u, int wr, int wc, int fr, int fq) const {
        asm volatile("" : "+v"(fr));
        if (__builtin_amdgcn_readfirstlane(__builtin_bit_cast(int, rrs[512])) == u.pm) {
#pragma unroll
            for (int ai = 0; ai < 2; ++ai)
#pragma unroll
                for (int m = 0; m < 4; ++m) { const float s = rrs[256 + ai * HALF + wr * 64 + m * 16 + fr];
#pragma unroll
                    for (int bj = 0; bj < 2; ++bj)
#pragma unroll
                        for (int n = 0; n < 2; ++n) acc[ai][bj][m][n] *= s; }
            return;
        }
        if (wr == 0 && wc == 0 && fr == 0 && fq == 0) rrs[512] = __builtin_bit_cast(float, -1);
        const int row0 = u.pm * BM + wr * 64 + fr;
        f32x4 sa[2][4], sb[2][4];
#pragma unroll
        for (int ai = 0; ai < 2; ++ai)
#pragma unroll
            for (int m = 0; m < 4; ++m) { const float* sp = ssq + (size_t)(row0 + ai * HALF + m * 16) * 8; sa[ai][m] = *(const f32x4*)sp; sb[ai][m] = *(const f32x4*)(sp + 4); }
#pragma unroll
        for (int ai = 0; ai < 2; ++ai)
#pragma unroll
            for (int m = 0; m < 4; ++m) { const f32x4 a = sa[ai][m], b = sb[ai][m];
                const float v = (((a[0] + a[1]) + (a[2] + a[3])) + ((b[0] + b[1]) + (b[2] + b[3]))) * (1.0f / 1024.0f) + eps;
                const float s0 = sqrtf(v), s = s0 * midk;
                if (wc == 0 && fq == 0) rrs[ai * HALF + wr * 64 + m * 16 + fr] = fin / s0;
#pragma unroll
                for (int bj = 0; bj < 2; ++bj)
#pragma unroll
                    for (int n = 0; n < 2; ++n) acc[ai][bj][m][n] *= s; }
    }
    typedef unsigned u32x2 __attribute__((ext_vector_type(2)));
    __device__ __forceinline__ void init(f32x4 (&acc)[2][2][4][2], const Unit& u, int wr, int wc, int lane) const {
        asm volatile("" : "+v"(lane));
        const int fr = lane & 15, fq = lane >> 4;
        const int row0 = u.pm * BM + wr * 64 + fr, col0 = u.pn * BM + wc * 32 + 4 * fq; const float ik = 1.0f / (midk * fin);
#pragma unroll
        for (int g = 0; g < 8; ++g) { const int row = row0 + (g >> 2) * HALF + (g & 3) * 16; const float xs = xrs[row] * ik; const size_t off = (size_t)row * ldc + col0;
#pragma unroll
            for (int bj = 0; bj < 2; ++bj)
#pragma unroll
                for (int n = 0; n < 2; ++n) { const u32x2 w = *(const u32x2*)(xn + off + bj * HALF + n * 16);
                    acc[g >> 2][bj][g & 3][n] = (f32x4){__builtin_bit_cast(float, w.x << 16), __builtin_bit_cast(float, w.x & 0xffff0000u), __builtin_bit_cast(float, w.y << 16), __builtin_bit_cast(float, w.y & 0xffff0000u)} * xs; } }
        f32x4 sa[8], sb[8];
#pragma unroll
        for (int g = 0; g < 8; ++g) { const float* sp = ssq + (size_t)(row0 + (g >> 2) * HALF + (g & 3) * 16) * 8; sa[g] = *(const f32x4*)sp; sb[g] = *(const f32x4*)(sp + 4); }
#pragma unroll
        for (int g = 0; g < 8; ++g) { const f32x4 a = sa[g], b = sb[g];
            const float v = (((a[0] + a[1]) + (a[2] + a[3])) + ((b[0] + b[1]) + (b[2] + b[3]))) * (1.0f / 1024.0f) + eps; const float s0 = sqrtf(v);
            if (wc == 0 && fq == 0) { const int rl = (g >> 2) * HALF + wr * 64 + (g & 3) * 16 + fr; rrs[rl] = fin / s0; rrs[256 + rl] = s0 * midk; } }
        if (wr == 0 && wc == 0 && fr == 0 && fq == 0) rrs[512] = __builtin_bit_cast(float, u.pm);
    }
    __device__ __forceinline__ void operator()(f32x4 (&acc)[2][2][4][2], const Unit& u, int wr, int wc, int fr_, int fq_, int wid, int lane, bool has_next, const Unit& nx) const {
        asm volatile("" : "+v"(lane));
        const int fr = lane & 15, fq = lane >> 4;
        const int row0 = u.pm * BM + wr * 64 + fr, col0 = u.pn * BM + wc * 32 + 4 * fq;
        u32x2 xb[8][2][2]; float xs[8], rr[8];
        if (has_next) {
            const int rowN = nx.pm * BM + wr * 64 + fr, colN = nx.pn * BM + wc * 32 + 4 * fq;
#pragma unroll
            for (int g = 0; g < 8; ++g) { const float* sp = xrs + rowN + (g >> 2) * HALF + (g & 3) * 16; asm volatile("global_load_dword %0, %1, off" : "=v"(xs[g]) : "v"(sp) : "memory"); }
#pragma unroll
            for (int g = 0; g < 8; ++g) { const bf16_t* bp = xn + (size_t)(rowN + (g >> 2) * HALF + (g & 3) * 16) * ldc + colN;
#pragma unroll
                for (int bj = 0; bj < 2; ++bj)
#pragma unroll
                    for (int n = 0; n < 2; ++n) { const bf16_t* lp = bp + bj * HALF + n * 16; asm volatile("global_load_dwordx2 %0, %1, off" : "=v"(xb[g][bj][n]) : "v"(lp) : "memory"); } }
        }
#pragma unroll
        for (int g = 0; g < 8; ++g) rr[g] = rrs[(g >> 2) * HALF + wr * 64 + (g & 3) * 16 + fr];
#pragma unroll
        for (int g = 0; g < 8; ++g) { const size_t off = (size_t)(row0 + (g >> 2) * HALF + (g & 3) * 16) * ldc + col0;
#pragma unroll
            for (int bj = 0; bj < 2; ++bj)
#pragma unroll
                for (int n = 0; n < 2; ++n) *(f32x4*)(out + off + bj * HALF + n * 16) = acc[g >> 2][bj][g & 3][n] * rr[g]; }
        if (has_next) {
            asm volatile("s_waitcnt vmcnt(32)" : "+v"(xs[0]), "+v"(xs[1]), "+v"(xs[2]), "+v"(xs[3]), "+v"(xs[4]), "+v"(xs[5]), "+v"(xs[6]), "+v"(xs[7]),
                         "+v"(xb[0][0][0]), "+v"(xb[0][0][1]), "+v"(xb[0][1][0]), "+v"(xb[0][1][1]), "+v"(xb[1][0][0]), "+v"(xb[1][0][1]), "+v"(xb[1][1][0]), "+v"(xb[1][1][1]),
                         "+v"(xb[2][0][0]), "+v"(xb[2][0][1]), "+v"(xb[2][1][0]), "+v"(xb[2][1][1]) :: "memory");
            asm volatile("" : "+v"(xb[3][0][0]), "+v"(xb[3][0][1]), "+v"(xb[3][1][0]), "+v"(xb[3][1][1]), "+v"(xb[4][0][0]), "+v"(xb[4][0][1]), "+v"(xb[4][1][0]), "+v"(xb[4][1][1]),
                         "+v"(xb[5][0][0]), "+v"(xb[5][0][1]), "+v"(xb[5][1][0]), "+v"(xb[5][1][1]), "+v"(xb[6][0][0]), "+v"(xb[6][0][1]), "+v"(xb[6][1][0]), "+v"(xb[6][1][1]),
                         "+v"(xb[7][0][0]), "+v"(xb[7][0][1]), "+v"(xb[7][1][0]), "+v"(xb[7][1][1]) :: "memory");
            const float ik = 1.0f / (midk * fin);
#pragma unroll
            for (int g = 0; g < 8; ++g) { const float xsk = xs[g] * ik;
#pragma unroll
                for (int bj = 0; bj < 2; ++bj)
#pragma unroll
                    for (int n = 0; n < 2; ++n) { const u32x2 w = xb[g][bj][n];
                        acc[g >> 2][bj][g & 3][n] = (f32x4){__builtin_bit_cast(float, w.x << 16), __builtin_bit_cast(float, w.x & 0xffff0000u), __builtin_bit_cast(float, w.y << 16), __builtin_bit_cast(float, w.y & 0xffff0000u)} * xsk; } }
        }
    }
};

typedef int i32x4 __attribute__((ext_vector_type(4)));
typedef int i32x8 __attribute__((ext_vector_type(8)));
__device__ __forceinline__ i32x8 cat8(bf16x8 lo, bf16x8 hi) { const i32x4 a = __builtin_bit_cast(i32x4, lo), b = __builtin_bit_cast(i32x4, hi); return __builtin_shufflevector(a, b, 0, 1, 2, 3, 4, 5, 6, 7); }

#ifndef PG8_FP8ASM
#define PG8_FP8ASM 1
#endif
constexpr bool FP8ASM = (PG8_FP8ASM != 0);
template <class Epi, class Sched, bool ALIGN_EPI = false, bool SP2 = false, bool FP8 = false, int HYBP = 0>
__device__ __forceinline__ void gemm_phase(PG8_LAS unsigned char* lds, const Gemm g, const Sched& S, const Epi& E) {
    const int tid = threadIdx.x, wid = __builtin_amdgcn_readfirstlane(tid >> 6), lane = tid & 63, wr = wid >> 2, wc = wid & 3, fr = lane & 15, fq = lane >> 4;
    const int K = g.K, nt = K / BK;
    unsigned voffA[2], voffB[2];
#pragma unroll
    for (int i = 0; i < 2; ++i) { int R, C; stage_rc(tid * 16 + i * 8192, R, C); const int Rb = Epi::PERM ? ((R & ~31) + perm32(R & 31)) : R;
        voffA[i] = (unsigned)(R * K + C) * 2u; voffB[i] = (unsigned)(Rb * K + C) * 2u; }
    const size_t kstep = (size_t)(BK * 2);
    const size_t hstep = (size_t)HALF * K * 2;
    const size_t tstep = 2 * hstep;
    const unsigned ldsw = (unsigned)wid * 1024u;
    const int aoff = lds_byte(wr * 64 + fr, fq * 8), boff = lds_byte(wc * 32 + fr, fq * 8);
#define PG8_SA(b, h) (((b) * 2 + (h)) * HTB)
#define PG8_SB(b, h) ((4 + (b) * 2 + (h)) * HTB)
#define PG8_STAGE(bufoff, gbase, voff) do { _Pragma("unroll") for (int _i = 0; _i < 2; ++_i) \
        __builtin_amdgcn_global_load_lds((const unsigned*)((const char*)(gbase) + (voff)[_i]), (PG8_LAS unsigned*)(lds + (bufoff) + ldsw + _i * 8192), 16, 0, 0); } while (0)
#define PG8_LDA_(F8c, dst, b, h) do { if constexpr (F8c) { _Pragma("unroll") for (int m = 0; m < 4; ++m) dst##F[m] = cat8(*(const PG8_LAS bf16x8*)(lds + PG8_SA(b, h) + aoff + m * 2048), *(const PG8_LAS bf16x8*)(lds + PG8_SA(b, h) + aoff + m * 2048 + 1024)); } \
        else { _Pragma("unroll") for (int m = 0; m < 4; ++m) _Pragma("unroll") for (int k = 0; k < 2; ++k) dst[m][k] = *(const PG8_LAS bf16x8*)(lds + PG8_SA(b, h) + aoff + m * 2048 + k * 1024); } } while (0)
#define PG8_LDB_(F8c, dst, b, h) do { if constexpr (F8c) { _Pragma("unroll") for (int n = 0; n < 2; ++n) dst##F[n] = cat8(*(const PG8_LAS bf16x8*)(lds + PG8_SB(b, h) + boff + n * 2048), *(const PG8_LAS bf16x8*)(lds + PG8_SB(b, h) + boff + n * 2048 + 1024)); } \
        else { _Pragma("unroll") for (int n = 0; n < 2; ++n) _Pragma("unroll") for (int k = 0; k < 2; ++k) dst[n][k] = *(const PG8_LAS bf16x8*)(lds + PG8_SB(b, h) + boff + n * 2048 + k * 1024); } } while (0)
#define PG8_MMA_(F8c, ai, bj, At, Bt) do { __builtin_amdgcn_s_setprio(1); _Pragma("unroll") for (int m = 0; m < 4; ++m) _Pragma("unroll") for (int n = 0; n < 2; ++n) { \
        if constexpr (F8c) { if constexpr (FP8ASM) asm volatile("v_mfma_f32_16x16x128_f8f6f4 %0, %1, %2, %0" : "+v"(acc[ai][bj][m][n]) : "v"(Bt##F[n]), "v"(At##F[m])); \
            else acc[ai][bj][m][n] = __builtin_amdgcn_mfma_scale_f32_16x16x128_f8f6f4(Bt##F[n], At##F[m], acc[ai][bj][m][n], 0, 0, 0, 0, 0, 0); } \
        else { _Pragma("unroll") for (int k = 0; k < 2; ++k) acc[ai][bj][m][n] = __builtin_amdgcn_mfma_f32_16x16x32_bf16(Bt[n][k], At[m][k], acc[ai][bj][m][n], 0, 0, 0); } } \
        __builtin_amdgcn_s_setprio(0); } while (0)
#define PG8_LDA(dst, b, h) PG8_LDA_(FP8, dst, b, h)
#define PG8_LDB(dst, b, h) PG8_LDB_(FP8, dst, b, h)
#define PG8_MMA(ai, bj, At, Bt) PG8_MMA_(FP8, ai, bj, At, Bt)
#define PG8_WAIT_V(n) asm volatile("s_waitcnt vmcnt(" #n ")" ::: "memory")
#define PG8_WAIT_L(n) asm volatile("s_waitcnt lgkmcnt(" #n ")" ::: "memory")
#define PG8_BAR __builtin_amdgcn_s_barrier()
#define PG8_SCHED __builtin_amdgcn_sched_barrier(0)
#define PG8_ITER_SP2(F8c) do { \
            PG8_STAGE(PG8_SA(1, 1), a1 + hstep, voffA); PG8_SCHED; PG8_LDB_(F8c, B0, 0, 0); PG8_LDB_(F8c, B1, 0, 1); PG8_SCHED; PG8_LDA_(F8c, At, 0, 0); \
            PG8_WAIT_V(8); PG8_WAIT_L(0); PG8_BAR; PG8_MMA_(F8c, 0, 0, At, B0); PG8_MMA_(F8c, 0, 1, At, B1); PG8_BAR; PG8_SCHED; \
            PG8_STAGE(PG8_SB(0, 0), b2, voffB); PG8_STAGE(PG8_SB(0, 1), b2 + hstep, voffB); PG8_STAGE(PG8_SA(0, 0), a2, voffA); PG8_SCHED; PG8_LDA_(F8c, At, 0, 1); \
            PG8_WAIT_V(8); PG8_WAIT_L(0); PG8_BAR; PG8_MMA_(F8c, 1, 0, At, B0); PG8_MMA_(F8c, 1, 1, At, B1); PG8_BAR; PG8_SCHED; \
            PG8_STAGE(PG8_SA(0, 1), a2 + hstep, voffA); PG8_SCHED; PG8_LDB_(F8c, B0, 1, 0); PG8_LDB_(F8c, B1, 1, 1); PG8_SCHED; PG8_LDA_(F8c, At, 1, 0); \
            PG8_WAIT_V(8); PG8_WAIT_L(0); PG8_BAR; PG8_MMA_(F8c, 0, 0, At, B0); PG8_MMA_(F8c, 0, 1, At, B1); PG8_BAR; PG8_SCHED; \
            PG8_STAGE(PG8_SB(1, 0), b3, voffB); PG8_STAGE(PG8_SB(1, 1), b3 + hstep, voffB); PG8_STAGE(PG8_SA(1, 0), a3, voffA); PG8_SCHED; PG8_LDA_(F8c, At, 1, 1); \
            PG8_WAIT_V(8); PG8_WAIT_L(0); PG8_BAR; PG8_MMA_(F8c, 1, 0, At, B0); PG8_MMA_(F8c, 1, 1, At, B1); PG8_BAR; PG8_SCHED; \
            } while (0)
#define PG8_TSTEP(F8c) do { \
            const bool last = (t == ntl - 2); \
            const char* a1 = cA + (size_t)PG8_KT(t + 1) * kstep; \
            const char* a2 = last ? nA : cA + (size_t)PG8_KT(t + 2) * kstep; const char* b2 = last ? nB : cB + (size_t)PG8_KT(t + 2) * kstep; \
            const char* a3 = a2 + kstep; const char* b3 = b2 + kstep; \
            if (last && has_next) S.a_ready(nxt); \
            if constexpr (SP2) { \
            PG8_ITER_SP2(F8c); \
            } else { \
            PG8_LDB(B0, 0, 0); PG8_SCHED; PG8_LDA(At, 0, 0); PG8_STAGE(PG8_SA(1, 1), a1 + hstep, voffA); \
            PG8_WAIT_L(8); PG8_BAR; PG8_WAIT_L(0); PG8_MMA(0, 0, At, B0); PG8_BAR; PG8_SCHED; \
            PG8_LDB(B1, 0, 1); PG8_STAGE(PG8_SB(0, 0), b2, voffB); \
            PG8_BAR; PG8_WAIT_L(0); PG8_MMA(0, 1, At, B1); PG8_BAR; \
            PG8_LDA(At, 0, 1); PG8_STAGE(PG8_SA(0, 0), a2, voffA); \
            PG8_BAR; PG8_WAIT_L(0); PG8_MMA(1, 0, At, B0); PG8_BAR; PG8_SCHED; \
            PG8_STAGE(PG8_SB(0, 1), b2 + hstep, voffB); \
            PG8_WAIT_V(6); PG8_BAR; PG8_MMA(1, 1, At, B1); PG8_BAR; \
            PG8_LDB(B0, 1, 0); PG8_SCHED; PG8_LDA(At, 1, 0); PG8_STAGE(PG8_SA(0, 1), a2 + hstep, voffA); \
            PG8_WAIT_L(8); PG8_BAR; PG8_WAIT_L(0); PG8_MMA(0, 0, At, B0); PG8_BAR; PG8_SCHED; \
            PG8_LDB(B1, 1, 1); PG8_STAGE(PG8_SB(1, 0), b3, voffB); \
            PG8_BAR; PG8_WAIT_L(0); PG8_MMA(0, 1, At, B1); PG8_BAR; \
            PG8_LDA(At, 1, 1); PG8_STAGE(PG8_SA(1, 0), a3, voffA); \
            PG8_BAR; PG8_WAIT_L(0); PG8_MMA(1, 0, At, B0); PG8_BAR; PG8_SCHED; \
            PG8_STAGE(PG8_SB(1, 1), b3 + hstep, voffB); \
            PG8_WAIT_V(6); PG8_BAR; PG8_MMA(1, 1, At, B1); PG8_BAR; \
            } \
            if constexpr (Epi::MID) { if (t == nt / 2 - HSK - 2) { if constexpr (FP8 || (F8c)) asm volatile("s_nop 15\n\ts_nop 15" ::: "memory"); E.mid(acc, cur, wr, wc, fr, fq); } } \
        } while (0)
    Unit cur, nxt; int ui = 0;
    if (!S.next(0, cur)) return;
    f32x4 acc[2][2][4][2];
    if constexpr (Epi::INIT) E.init(acc, cur, wr, wc, lane);
    else {
#pragma unroll
    for (int a = 0; a < 2; ++a)
#pragma unroll
        for (int b = 0; b < 2; ++b)
#pragma unroll
            for (int m = 0; m < 4; ++m)
#pragma unroll
                for (int n = 0; n < 2; ++n) acc[a][b][m][n] = (f32x4){0.f, 0.f, 0.f, 0.f}; }
    bf16x8 At[4][2], B0[2][2], B1[2][2]; i32x8 AtF[4], B0F[2], B1F[2];
    const char* cA = (const char*)g.A + (size_t)cur.pm * tstep; const char* cB = (const char*)g.Bt + (size_t)cur.pn * tstep;
    S.a_ready(cur);
    if constexpr (SP2) {
        PG8_STAGE(PG8_SB(0, 0), cB, voffB); PG8_STAGE(PG8_SB(0, 1), cB + hstep, voffB); PG8_STAGE(PG8_SA(0, 0), cA, voffA); PG8_STAGE(PG8_SA(0, 1), cA + hstep, voffA);
        if (wr == 1) PG8_BAR;
        PG8_WAIT_V(2); PG8_BAR;
        PG8_STAGE(PG8_SB(1, 0), cB + kstep, voffB); PG8_STAGE(PG8_SA(1, 0), cA + kstep, voffA); PG8_STAGE(PG8_SB(1, 1), cB + hstep + kstep, voffB);
        PG8_WAIT_V(6); PG8_BAR;
    } else {
        PG8_STAGE(PG8_SB(0, 0), cB, voffB); PG8_STAGE(PG8_SA(0, 0), cA, voffA); PG8_STAGE(PG8_SB(0, 1), cB + hstep, voffB); PG8_STAGE(PG8_SA(0, 1), cA + hstep, voffA);
        if (wr == 1) PG8_BAR;
        PG8_WAIT_V(4); PG8_BAR;
        PG8_STAGE(PG8_SB(1, 0), cB + kstep, voffB); PG8_STAGE(PG8_SA(1, 0), cA + kstep, voffA); PG8_STAGE(PG8_SB(1, 1), cB + hstep + kstep, voffB);
        PG8_WAIT_V(6); PG8_BAR;
    }
    for (;;) {
        const bool has_next = S.next(ui + 1, nxt);
        const char* nA = has_next ? (const char*)g.A + (size_t)nxt.pm * tstep : cA; const char* nB = has_next ? (const char*)g.Bt + (size_t)nxt.pn * tstep : cB;
        constexpr int HSK = 2 * HYBP;
#define PG8_KT(i) ((HYBP > 0 && (i) >= HSK) ? (i) + HSK : (i))
        const int ntl = nt - HSK;
        if constexpr (HYBP > 0) { int t = 0; for (; t < HSK; t += 2) PG8_TSTEP(true); for (; t < ntl; t += 2) PG8_TSTEP(false); }
        else { for (int t = 0; t < ntl; t += 2) PG8_TSTEP(FP8); }
        if constexpr (ALIGN_EPI) { if (wr == 0) PG8_BAR; }
        if constexpr (FP8) asm volatile("s_nop 15\n\ts_nop 15" ::: "memory");
        if constexpr (!Epi::AFTER_DRAIN) { if constexpr (Epi::INIT) E(acc, cur, wr, wc, fr, fq, wid, lane, has_next, nxt); else E(acc, cur, wr, wc, fr, fq, wid, lane); S.done(cur); }
        if (!has_next) break;
        if constexpr (!Epi::INIT) {
#pragma unroll
        for (int a = 0; a < 2; ++a)
#pragma unroll
            for (int b = 0; b < 2; ++b)
#pragma unroll
                for (int m = 0; m < 4; ++m)
#pragma unroll
                    for (int n = 0; n < 2; ++n) acc[a][b][m][n] = (f32x4){0.f, 0.f, 0.f, 0.f}; }
        cur = nxt; cA = nA; cB = nB; ++ui;
        if constexpr (ALIGN_EPI) { if (wr == 1) PG8_BAR; }
    }
    PG8_WAIT_V(0);
    if constexpr (!ALIGN_EPI) { if (wr == 0) PG8_BAR; }
    PG8_BAR;
    if constexpr (Epi::AFTER_DRAIN) { E.fused(acc, cur, wr, wc, fr, fq, lds, wid, lane); S.done(cur); }
#undef PG8_SA
#undef PG8_SB
#undef PG8_STAGE
#undef PG8_LDA
#undef PG8_LDB
#undef PG8_MMA
#undef PG8_MMA_
#undef PG8_LDA_
#undef PG8_LDB_
#undef PG8_ITER_SP2
#undef PG8_TSTEP
#undef PG8_KT
#undef PG8_WAIT_V
#undef PG8_WAIT_L
#undef PG8_BAR
#undef PG8_SCHED
}
}

#include <cmath>


#ifndef PG8_SP2
#define PG8_SP2 true
#endif
#ifndef PG8_SP2_FP8
#define PG8_SP2_FP8 true
#endif
#ifndef PG8_ALIGN
#define PG8_ALIGN true
#endif

constexpr int NWAVES = 8;
#ifndef MK_ONE_LAUNCH
#define MK_ONE_LAUNCH 1
#endif
constexpr int PER_PHASE = 4;
constexpr bool ONE_LAUNCH = (MK_ONE_LAUNCH != 0);

constexpr int BATCH = 8, SEQ = 2048, DM = 2048, M = BATCH * SEQ;
constexpr int DCONV = 1024, DATTN = 1024, NH = 8, HD = 128, DIN = 8192, DMIX = 2048;
constexpr int MBLK = 256, NBLK = SEQ / MBLK, TOPK = 3;
constexpr float EPS = 1e-6f;
constexpr float SM_SCALE = 0.08838834764831845f;
#ifndef MK_FP8_OUT
#define MK_FP8_OUT 1
#endif
#ifndef MK_NF8
#define MK_NF8 2
#endif
constexpr int NF8 = MK_NF8;
constexpr unsigned PORD = 0x54201367u;
constexpr unsigned PPOS = 0x01762534u;
constexpr float X8_SCALE = 1.0f, WI8_SCALE = 64.0f;
#ifndef MK_LOCBAR
#define MK_LOCBAR 1
#endif
#ifndef MK_HYB
#define MK_HYB 2
#endif
constexpr int HYBP = MK_HYB;
constexpr int HYBC = 256 * HYBP;
constexpr float HYB_Y = 4.0f, HYB_W = 64.0f, HYB_ALL = HYB_Y * HYB_W;
constexpr bool FP8_OUT = (MK_FP8_OUT != 0);
constexpr float Y8C_SCALE = 4.0f, Y8A_SCALE = 8.0f, W8_SCALE = 64.0f;

constexpr size_t MiB = 1u << 20;
constexpr size_t WS_CTL = 0, CTL_ZERO_BYTES = 32768;
constexpr size_t WS_WIN = 388 * MiB;
constexpr size_t WS_WOUT = 34 * MiB;
constexpr size_t WS_KMEAN = 42 * MiB;
constexpr size_t WS_XRS = 43 * MiB;
constexpr size_t WS_SSQ = 44 * MiB;
constexpr size_t WS_XN = 400 * MiB;
constexpr size_t WS_PROJ = 48 * MiB;
constexpr size_t PROJ_STRIDE = 32 * MiB;
constexpr size_t WS_Y = 320 * MiB;
constexpr size_t WS_XN8 = 464 * MiB;
constexpr size_t WS_WIN8 = 496 * MiB;
constexpr size_t WS_END = 510 * MiB;
static_assert(MK_NF8 == 6, "this workspace map gives the bf16 W_in^T copy only 12 MiB (the q and k rows)");
constexpr int CW_TMO = 0, CW_CODE = 1;
constexpr int CW_BAR = 4096;

constexpr int RING_OFF = 0, RING_BYTES = 141312;
constexpr int LDSCTL_OFF = RING_BYTES, MISC_OFF = LDSCTL_OFF + 320;
constexpr int LDS_BYTES = 147456;
static_assert(MISC_OFF + 128 <= LDS_BYTES, "LDS map");
static_assert(HYBP >= 0 && HYBP <= 4, "the e4m3 channels are a prefix of the conv half");

#define GAS __attribute__((address_space(1)))
#define LAS __attribute__((address_space(3)))
typedef unsigned short bf16;
typedef unsigned v4u __attribute__((ext_vector_type(4)));
typedef float f32x4 __attribute__((ext_vector_type(4)));
typedef short bf16x8 __attribute__((ext_vector_type(8)));
typedef GAS unsigned gu32;
typedef GAS unsigned long long gu64;
#define RLX_AGENT __ATOMIC_RELAXED, __HIP_MEMORY_SCOPE_AGENT
#define LDS_WAIT() asm volatile("s_waitcnt lgkmcnt(0)" ::: "memory")
#define VM_WAIT() asm volatile("s_waitcnt vmcnt(0)" ::: "memory")
__device__ __forceinline__ unsigned long long rt() { return __builtin_amdgcn_s_memrealtime(); }
__device__ __forceinline__ unsigned f2bf(float f) { unsigned u = __builtin_bit_cast(unsigned, f); return (u + 0x7fffu + ((u >> 16) & 1u)) >> 16; }
__device__ __forceinline__ unsigned pk2(float lo, float hi) { return f2bf(lo) | (f2bf(hi) << 16); }

#define XB_TMO      128
#define XB_XCNT(j)  (256  + 64 * (j))
#define XB_XSUB(j)  (1280 + 64 * (j))
#define XB_XGEN(j)  (2304 + 64 * (j))
#define XB_TOP      3328
#define XB_TOPGEN   3392
#define XB_MIS      3456
#define XCD_BAR_WORDS 3520
#define XB_SPIN_CAP (1u << 18)

__device__ __forceinline__ unsigned xb_ld(unsigned* p)              { return __hip_atomic_load(p, __ATOMIC_RELAXED, __HIP_MEMORY_SCOPE_AGENT); }
__device__ __forceinline__ unsigned xb_add(unsigned* p, unsigned v) { return __hip_atomic_fetch_add(p, v, __ATOMIC_RELAXED, __HIP_MEMORY_SCOPE_AGENT); }
__device__ __forceinline__ unsigned xb_xcc_id() { return (unsigned)__builtin_amdgcn_s_getreg((3 << 11) | 20) & 0xFu; }
#define XB_SPIN(cond, bar) do { unsigned _sp = 0; while (cond) { __builtin_amdgcn_s_sleep(1); \
    if ((++_sp & 255u) == 0u) { if (xb_ld(&(bar)[XB_TMO])) break; if (_sp > XB_SPIN_CAP) { atomicAdd(&(bar)[XB_TMO], 1u); break; } } } } while (0)

struct XcdBarrier {
    unsigned* bar; unsigned x;
    volatile LAS unsigned* st;
};

__device__ __forceinline__ XcdBarrier xcd_barrier_post(unsigned* bar, volatile LAS unsigned* st) {
    XcdBarrier b; b.bar = bar; b.x = xb_xcc_id(); b.st = st;
    if (threadIdx.x == 0) (void)xb_add(&bar[XB_XCNT(b.x)], 1u);
    return b;
}
__device__ __forceinline__ void xcd_barrier_complete(unsigned* bar, unsigned x, unsigned& nloc, unsigned& nx) {
    const unsigned G = gridDim.x * gridDim.y * gridDim.z;
    unsigned sum, cnt, mine, sp = 0u;
    for (;;) {
        sum = 0u; cnt = 0u; mine = 0u;
#pragma unroll
        for (unsigned j = 0; j < 16; ++j) { const unsigned c = xb_ld(&bar[XB_XCNT(j)]); sum += c; cnt += (c > 0u) ? 1u : 0u; mine = (j == x) ? c : mine; }
        if (sum == G) break;
        __builtin_amdgcn_s_sleep(1);
        if ((++sp & 255u) == 0u) { if (xb_ld(&bar[XB_TMO])) break; if (sp > XB_SPIN_CAP) { atomicAdd(&bar[XB_TMO], 1u); break; } }
    }
    nloc = mine > 0u ? mine : 1u; nx = cnt > 0u ? cnt : 1u;
}

__device__ __forceinline__ void xcd_barrier(const XcdBarrier& b) {
    asm volatile("s_waitcnt vmcnt(0)" ::: "memory");
    __syncthreads();
    if (threadIdx.x == 0) {
        unsigned* bar = b.bar;
        __builtin_amdgcn_s_waitcnt(0);
        unsigned nloc = b.st[0], nx = b.st[1];
        if (nloc == 0u) { xcd_barrier_complete(bar, b.x, nloc, nx); b.st[0] = nloc; b.st[1] = nx; }
        const unsigned old = xb_add(&bar[XB_XSUB(b.x)], 1u);
        const unsigned gen = old / nloc;
        if (old + 1u == (gen + 1u) * nloc) {
            __builtin_amdgcn_fence(__ATOMIC_RELEASE, "agent");
            asm volatile("s_waitcnt vmcnt(0)" ::: "memory");
            const unsigned og = xb_add(&bar[XB_TOP], 1u);
            const unsigned tg = og / nx;
            if (og + 1u == (tg + 1u) * nx) xb_add(&bar[XB_TOPGEN], 1u);
            else XB_SPIN(xb_ld(&bar[XB_TOPGEN]) == tg, bar);
            __builtin_amdgcn_fence(__ATOMIC_ACQUIRE, "agent");
            xb_add(&bar[XB_XGEN(b.x)], 1u);
            asm volatile("s_waitcnt vmcnt(0)" ::: "memory");
        } else {
            XB_SPIN(xb_ld(&bar[XB_XGEN(b.x)]) == gen, bar);
            __builtin_amdgcn_fence(__ATOMIC_ACQUIRE, "agent");
            asm volatile("s_waitcnt vmcnt(0)" ::: "memory");
        }
    }
    __syncthreads();
}

__device__ __forceinline__ void xcd_barrier_local(const XcdBarrier& b) {
    asm volatile("s_waitcnt vmcnt(0)" ::: "memory");
    __syncthreads();
    if (threadIdx.x == 0) {
        unsigned* bar = b.bar;
        __builtin_amdgcn_s_waitcnt(0);
        unsigned nloc = b.st[0], nx = b.st[1];
        if (nloc == 0u) { xcd_barrier_complete(bar, b.x, nloc, nx); b.st[0] = nloc; b.st[1] = nx; }
        const unsigned old = xb_add(&bar[XB_XSUB(b.x)], 1u);
        const unsigned gen = old / nloc;
        if (old + 1u == (gen + 1u) * nloc) xb_add(&bar[XB_XGEN(b.x)], 1u);
        else XB_SPIN(xb_ld(&bar[XB_XGEN(b.x)]) == gen, bar);
        __builtin_amdgcn_fence(__ATOMIC_ACQUIRE, "agent");
        asm volatile("s_waitcnt vmcnt(0)" ::: "memory");
    }
    __syncthreads();
}

namespace moba {
typedef short bf16x8 __attribute__((ext_vector_type(8)));
typedef short s16x4 __attribute__((ext_vector_type(4)));
typedef float f32x16 __attribute__((ext_vector_type(16)));
typedef float f32x4 __attribute__((ext_vector_type(4)));
typedef unsigned u32x4 __attribute__((ext_vector_type(4)));
typedef unsigned short bf16;
constexpr int D = 128, PITCH = 128, NW = 8, QBLK = 32, KVBLK = 64, QB = NW * QBLK;
constexpr int SHM_V = KVBLK * D * 2, SHM_K = KVBLK * D * 2;
constexpr int OFF_WSF = 2 * SHM_V + 2 * SHM_K, OFF_OST = OFF_WSF + NW * 64 * 4, OFF_KM = OFF_OST + NW * 8192, LDS_BYTES = OFF_KM + 8192;
constexpr float SCALE = 0.08838834764831845f, THR = 8.f;
#define KSWZ(row, colB) ((row) * 256 + ((colB) ^ (((row) & 7) << 4)))
#define SBAR() __builtin_amdgcn_sched_barrier(0)
__device__ __forceinline__ int v_st(int k, int c) { const int kk = (k & ~0xC) | ((k & 4) << 1) | ((k & 8) >> 1); return ((kk >> 3) * 4 + (c >> 5)) * 512 + ((kk & 7) * 32 + (c & 31)) * 2; }
__device__ __forceinline__ int v_rd_base(int lane) { return ((lane & 3) << 3) | (((lane >> 2) & 3) << 6) | (((lane >> 4) & 1) << 5) | (((lane >> 5) & 1) << 8); }
constexpr int v_rd_off(int d0, int ks, int half) { return d0 * 512 + ks * 4096 + half * 2048; }
__device__ __forceinline__ int crow(int r, int hi) { return (r & 3) + 8 * (r >> 2) + 4 * hi; }
__device__ __forceinline__ unsigned cvtpk(float lo, float hi) { unsigned r; asm volatile("v_cvt_pk_bf16_f32 %0, %1, %2" : "=v"(r) : "v"(lo), "v"(hi)); return r; }
__device__ __forceinline__ float bflo(unsigned w) { return __builtin_bit_cast(float, w << 16); }
__device__ __forceinline__ float bfhi(unsigned w) { return __builtin_bit_cast(float, w & 0xffff0000u); }
__device__ __forceinline__ void mask_tile(f32x16& p0, f32x16& p1, int dq) {
    const float NEG = -__builtin_inff();
#pragma unroll
    for (int r = 0; r < 16; ++r) { const int c = (r & 3) + 8 * (r >> 2); if (dq - c < 0) p0[r] = NEG; if (dq - c - 32 < 0) p1[r] = NEG; }
}
__device__ __forceinline__ void partialSM(f32x16& p0, f32x16& p1, float& m_reg, float& mn, float& alpha, bool masked) {
    float pmax = p0[0]; for (int r = 1; r < 16; ++r) pmax = fmaxf(pmax, p0[r]); for (int r = 0; r < 16; ++r) pmax = fmaxf(pmax, p1[r]);
    { auto rr = __builtin_amdgcn_permlane32_swap(__float_as_uint(pmax), __float_as_uint(pmax), false, false);
      pmax = fmaxf(__uint_as_float(rr[0]), __uint_as_float(rr[1])); }
    if (masked) pmax = -__builtin_inff();
    constexpr float C2 = 1.4426950408889634f * SCALE;
    if (__builtin_expect(__all((pmax - m_reg) * SCALE <= THR), 1)) { mn = m_reg; alpha = 1.f; }
    else { mn = fmaxf(m_reg, pmax); alpha = __builtin_amdgcn_exp2f((m_reg - mn) * C2); m_reg = mn; }
    const float mnL = masked ? -__builtin_inff() : -mn * C2;
    for (int r = 0; r < 16; ++r) p0[r] = fmaf(p0[r], C2, mnL); for (int r = 0; r < 16; ++r) p1[r] = fmaf(p1[r], C2, mnL);
    for (int r = 0; r < 16; ++r) p0[r] = __builtin_amdgcn_exp2f(p0[r]);
}
__device__ __forceinline__ void finishSM(f32x16& p0, f32x16& p1, float alpha, float& l_reg, bf16x8& pa0, bf16x8& pa1, bf16x8& pa2, bf16x8& pa3) {
    for (int r = 0; r < 16; ++r) p1[r] = __builtin_amdgcn_exp2f(p1[r]);
    float ps = 0; for (int r = 0; r < 16; ++r) ps += p0[r]; for (int r = 0; r < 16; ++r) ps += p1[r];
    { auto rr = __builtin_amdgcn_permlane32_swap(__float_as_uint(ps), __float_as_uint(ps), false, false);
      ps = __uint_as_float(rr[0]) + __uint_as_float(rr[1]); }
    l_reg = l_reg * alpha + ps;
#define PK4(P, B_, OUT) do { unsigned a0 = cvtpk(P[B_+0], P[B_+1]), a1 = cvtpk(P[B_+2], P[B_+3]);                          \
        unsigned b0 = cvtpk(P[B_+4], P[B_+5]), b1 = cvtpk(P[B_+6], P[B_+7]);                                             \
        auto r0 = __builtin_amdgcn_permlane32_swap(a0, b0, false, false); auto r1 = __builtin_amdgcn_permlane32_swap(a1, b1, false, false); \
        u32x4 w = {r0[0], r1[0], r0[1], r1[1]}; OUT = *reinterpret_cast<bf16x8*>(&w); } while (0)
    PK4(p0, 0, pa0); PK4(p0, 8, pa1); PK4(p1, 0, pa2); PK4(p1, 8, pa3);
#undef PK4
}
#ifndef MOBA_QLA
#define MOBA_QLA 3
#endif
template <int KB>
__device__ __forceinline__ void qkt(f32x16& p0, f32x16& p1, const char* K_lds, int r32, int hi, const bf16x8* qr) {
    p0 = f32x16{}; p1 = f32x16{};
    const char* kb[4];
#pragma unroll
    for (int dd = 0; dd < 4; ++dd) kb[dd] = K_lds + KB * SHM_K + KSWZ(r32, (dd * 16 + hi * 8) * 2);
    constexpr int QLA = MOBA_QLA;
    bf16x8 f0[8], f1[8];
#define QK_RD(d0) do { const char* a_ = kb[(d0) & 3] + ((d0) >> 2) * 128; f0[d0] = *reinterpret_cast<const bf16x8*>(a_); f1[d0] = *reinterpret_cast<const bf16x8*>(a_ + 32 * 256); } while (0)
#pragma unroll
    for (int d0 = 0; d0 < QLA; ++d0) QK_RD(d0);
    SBAR();
#pragma unroll
    for (int d0 = 0; d0 < 8; ++d0) {
        p0 = __builtin_amdgcn_mfma_f32_32x32x16_bf16(f0[d0], qr[d0], p0, 0, 0, 0);
        p1 = __builtin_amdgcn_mfma_f32_32x32x16_bf16(f1[d0], qr[d0], p1, 0, 0, 0);
        if (d0 + QLA < 8) { SBAR(); QK_RD(d0 + QLA); SBAR(); } }
#undef QK_RD
}
template <int VB>
__device__ __forceinline__ void pv_tile(f32x16* o, int vb0, bf16x8 pa0, bf16x8 pa1, bf16x8 pa2, bf16x8 pa3) {
#define TRRD(dst, off) asm volatile("ds_read_b64_tr_b16 %0, %1 offset:%2" : "=&v"(dst) : "v"(vb0), "i"(off) : "memory")
#define PV_D0(d0) do { s16x4 l0, l1, l2, l3, h0, h1, h2, h3; constexpr int b_ = VB * SHM_V + v_rd_off(d0, 0, 0); \
        TRRD(l0, b_); TRRD(h0, b_ + 2048); TRRD(l1, b_ + 4096); TRRD(h1, b_ + 6144); TRRD(l2, b_ + 8192); TRRD(h2, b_ + 10240); TRRD(l3, b_ + 12288); TRRD(h3, b_ + 14336); \
        asm volatile("s_waitcnt lgkmcnt(0)" ::: "memory"); SBAR();   \
        o[d0] = __builtin_amdgcn_mfma_f32_32x32x16_bf16(pa0, (bf16x8){l0[0], l0[1], l0[2], l0[3], h0[0], h0[1], h0[2], h0[3]}, o[d0], 0, 0, 0);   \
        o[d0] = __builtin_amdgcn_mfma_f32_32x32x16_bf16(pa1, (bf16x8){l1[0], l1[1], l1[2], l1[3], h1[0], h1[1], h1[2], h1[3]}, o[d0], 0, 0, 0);   \
        o[d0] = __builtin_amdgcn_mfma_f32_32x32x16_bf16(pa2, (bf16x8){l2[0], l2[1], l2[2], l2[3], h2[0], h2[1], h2[2], h2[3]}, o[d0], 0, 0, 0);   \
        o[d0] = __builtin_amdgcn_mfma_f32_32x32x16_bf16(pa3, (bf16x8){l3[0], l3[1], l3[2], l3[3], h3[0], h3[1], h3[2], h3[3]}, o[d0], 0, 0, 0); } while (0)
    PV_D0(0); PV_D0(1); PV_D0(2); PV_D0(3);
#undef PV_D0
#undef TRRD
}
template <int VB>
__device__ __forceinline__ void pv_sm(f32x16* o, int vb0, bf16x8 pa0, bf16x8 pa1, bf16x8 pa2, bf16x8 pa3, f32x16& p0, f32x16& p1, float& m_reg, float& mn, float& alpha, bool masked, bool domask, int dq) {
#define TRRD(dst, off) asm volatile("ds_read_b64_tr_b16 %0, %1 offset:%2" : "=&v"(dst) : "v"(vb0), "i"(off) : "memory")
#define PV_D0(d0) do { s16x4 l0, l1, l2, l3, h0, h1, h2, h3; constexpr int b_ = VB * SHM_V + v_rd_off(d0, 0, 0); \
        TRRD(l0, b_); TRRD(h0, b_ + 2048); TRRD(l1, b_ + 4096); TRRD(h1, b_ + 6144); TRRD(l2, b_ + 8192); TRRD(h2, b_ + 10240); TRRD(l3, b_ + 12288); TRRD(h3, b_ + 14336); \
        asm volatile("s_waitcnt lgkmcnt(0)" ::: "memory"); SBAR();   \
        o[d0] = __builtin_amdgcn_mfma_f32_32x32x16_bf16(pa0, (bf16x8){l0[0], l0[1], l0[2], l0[3], h0[0], h0[1], h0[2], h0[3]}, o[d0], 0, 0, 0);   \
        o[d0] = __builtin_amdgcn_mfma_f32_32x32x16_bf16(pa1, (bf16x8){l1[0], l1[1], l1[2], l1[3], h1[0], h1[1], h1[2], h1[3]}, o[d0], 0, 0, 0);   \
        o[d0] = __builtin_amdgcn_mfma_f32_32x32x16_bf16(pa2, (bf16x8){l2[0], l2[1], l2[2], l2[3], h2[0], h2[1], h2[2], h2[3]}, o[d0], 0, 0, 0);   \
        o[d0] = __builtin_amdgcn_mfma_f32_32x32x16_bf16(pa3, (bf16x8){l3[0], l3[1], l3[2], l3[3], h3[0], h3[1], h3[2], h3[3]}, o[d0], 0, 0, 0); } while (0)
    constexpr float C2 = 1.4426950408889634f * SCALE;
    PV_D0(0);
    if (domask) mask_tile(p0, p1, dq);
    float pmax = p0[0]; for (int r = 1; r < 16; ++r) pmax = fmaxf(pmax, p0[r]);
    SBAR();
    PV_D0(1);
    for (int r = 0; r < 16; ++r) pmax = fmaxf(pmax, p1[r]);
    { auto rr = __builtin_amdgcn_permlane32_swap(__float_as_uint(pmax), __float_as_uint(pmax), false, false);
      pmax = fmaxf(__uint_as_float(rr[0]), __uint_as_float(rr[1])); }
    if (masked) pmax = -__builtin_inff();
    if (__builtin_expect(__all((pmax - m_reg) * SCALE <= THR), 1)) { mn = m_reg; alpha = 1.f; }
    else { mn = fmaxf(m_reg, pmax); alpha = __builtin_amdgcn_exp2f((m_reg - mn) * C2); m_reg = mn; }
    const float mnL = masked ? -__builtin_inff() : -mn * C2;
    SBAR();
    PV_D0(2);
    for (int r = 0; r < 16; ++r) p0[r] = fmaf(p0[r], C2, mnL); for (int r = 0; r < 16; ++r) p1[r] = fmaf(p1[r], C2, mnL);
    SBAR();
    PV_D0(3);
    for (int r = 0; r < 16; ++r) p0[r] = __builtin_amdgcn_exp2f(p0[r]);
#undef PV_D0
#undef TRRD
}
struct BlockRef { const bf16* Q; const bf16* K; const bf16* V; int bh, qb, m0; };
struct Seam { bf16x8 qr[8]; bf16x8 st_v0, st_v1, st_k0, st_k1; };
struct Ctx { const float* kmean; const bf16* ZA; bf16* Y; float* SSQ; float y8; };
__device__ __forceinline__ bf16x8 ld8(const bf16* p) { return *reinterpret_cast<const bf16x8*>(p); }
__device__ __forceinline__ void write_km(const float* km, char* KM_lds, int tid) {
    asm volatile("" : "+v"(tid));
    if (tid < 256) { const int row = tid >> 4, ch = tid & 15, n = row & 7;
        const f32x4 a = *(const f32x4*)(km + n * 128 + ch * 8), b = *(const f32x4*)(km + n * 128 + ch * 8 + 4);
        float v[8] = {a[0], a[1], a[2], a[3], b[0], b[1], b[2], b[3]};
        if (row >= 8) {
#pragma unroll
            for (int e = 0; e < 8; e += 2) { const unsigned w = cvtpk(v[e], v[e + 1]); v[e] -= bflo(w); v[e + 1] -= bfhi(w); } }
        u32x4 w = {cvtpk(v[0], v[1]), cvtpk(v[2], v[3]), cvtpk(v[4], v[5]), cvtpk(v[6], v[7])};
        *(u32x4*)(KM_lds + KSWZ(row, ch * 16)) = w; }
}
#define ROW(p, k0, rr) ((p) + (size_t)((k0) + (rr)) * PITCH + sc)
#define VMW() asm volatile("s_waitcnt vmcnt(0)" ::: "memory")
#define VMWN(n) asm volatile("s_waitcnt vmcnt(%0)" :: "i"(n) : "memory")
#define SLOAD_H(Kp, Vp, k0) do { S.st_v0 = ld8(ROW(Vp, k0, sr)); S.st_v1 = ld8(ROW(Vp, k0, 32 + sr));              \
                         S.st_k0 = ld8(ROW(Kp, k0, sr)); S.st_k1 = ld8(ROW(Kp, k0, 32 + sr)); } while (0)
#define SWRITE_HK(bf) do { *(bf16x8*)(K_lds + (bf) * SHM_K + kws) = S.st_k0; *(bf16x8*)(K_lds + (bf) * SHM_K + kws + 32 * 256) = S.st_k1; } while (0)
#define SWRITE_HV(bf) do { *(bf16x8*)(V_lds + (bf) * SHM_V + vst0) = S.st_v0; *(bf16x8*)(V_lds + (bf) * SHM_V + vst1) = S.st_v1; } while (0)
#define SWRITE_H(bf) do { SWRITE_HV(bf); SWRITE_HK(bf); } while (0)
__device__ __forceinline__ void moba_prime(const BlockRef& cur, const Ctx& C, char* lds, Seam& S) {
    int tid_ = threadIdx.x; asm volatile("" : "+v"(tid_));
    const int tid = tid_, wid = __builtin_amdgcn_readfirstlane(tid >> 6), lane = tid & 63, r32 = lane & 31, hi = lane >> 5;
    const int sr = tid >> 4, sc = (tid & 15) * 8, kws = KSWZ(sr, sc * 2); char* K_lds = lds + 2 * SHM_V;
    for (int d0 = 0; d0 < 8; ++d0) S.qr[d0] = ld8(cur.Q + (size_t)(wid * QBLK + r32) * PITCH + d0 * 16 + hi * 8);
    SLOAD_H(cur.K, cur.V, 0); write_km(C.kmean + (size_t)cur.bh * 8 * 128, lds + OFF_KM, tid); VMW(); SWRITE_HK(0);
    __syncthreads();
}
__device__ __forceinline__ void moba_block(const BlockRef& cur, const BlockRef& nxt, const Ctx& C, char* lds, Seam& S) {
    int tid_ = threadIdx.x; asm volatile("" : "+v"(tid_));
    const int tid = tid_, wid = __builtin_amdgcn_readfirstlane(tid >> 6), lane = tid & 63, r32 = lane & 31, hi = lane >> 5;
    const int own = cur.qb, NT = 4 * (own + 1);
    const int qlo = own * QB + wid * QBLK, qm = qlo + r32 - 4 * hi;
    char* V_lds = lds; char* K_lds = lds + 2 * SHM_V;
    float* ws = (float*)(lds + OFF_WSF) + wid * 64; float* li_l = ws, * al_l = ws + 32;
    float m_reg = -1e30f, l_reg = 0; f32x16 o[4] = {};
    const int sr = tid >> 4, sc = (tid & 15) * 8, vst0 = v_st(sr, sc), vst1 = v_st(32 + sr, sc), kws = KSWZ(sr, sc * 2);
    const int vb0 = (int)(uintptr_t)V_lds + v_rd_base(lane);
    const bf16* Kh = cur.K; const bf16* Vh = cur.V;
    unsigned selmask = 0;
    {   f32x16 g = f32x16{};
        int gl = lane; asm volatile("" : "+v"(gl));
        const int gr = gl & 31, gh = gl >> 5;
        const char* kmb[4];
#pragma unroll
        for (int dd = 0; dd < 4; ++dd) kmb[dd] = lds + OFF_KM + KSWZ(gr, (dd * 16 + gh * 8) * 2);
#pragma unroll
        for (int d0 = 0; d0 < 8; ++d0) { const bf16x8 a = *reinterpret_cast<const bf16x8*>(kmb[d0 & 3] + (d0 >> 2) * 128); g = __builtin_amdgcn_mfma_f32_32x32x16_bf16(a, S.qr[d0], g, 0, 0, 0); }
        float gate[8];
#pragma unroll
        for (int i = 0; i < 4; ++i) { const float a = g[i] + g[4 + i]; auto rr = __builtin_amdgcn_permlane32_swap(__float_as_uint(a), __float_as_uint(a), false, false);
            gate[i] = __uint_as_float(rr[0]); gate[4 + i] = __uint_as_float(rr[1]); }
#pragma unroll
        for (int n = 0; n < 8; ++n) if (n >= own) gate[n] = -__builtin_inff();
#pragma unroll
        for (int n = 0; n < 8; ++n) { int rank = 0;
#pragma unroll
            for (int n2 = 0; n2 < 8; ++n2) if (n2 != n) rank += (gate[n2] > gate[n] || (gate[n2] == gate[n] && n2 < n)) ? 1 : 0;
            if (n < own && rank < 3) selmask |= 1u << n; }
    }
#define RESC(a) do { if (__any((a) < 1.f)) { if (hi == 0) al_l[r32] = (a); asm volatile("s_waitcnt lgkmcnt(0)" ::: "memory");              \
                     for (int d_ = 0; d_ < 4; ++d_) for (int r = 0; r < 16; ++r) o[d_][r] *= al_l[crow(r, hi)]; } } while (0)
#define KBASE(t) ((t) * KVBLK)
#define MASKED(t) (((t) >> 2) < own && !((selmask >> ((t) >> 2)) & 1u))
#define MASKT(P0_, P1_, t) do { const int kb_ = KBASE(t); if (((t) >> 2) == own && kb_ + KVBLK - 1 > qlo) mask_tile(P0_, P1_, qm - kb_); } while (0)
    constexpr int NQL = 8;
#define SEAM_K0() do { VMWN(NQL); SWRITE_HK(0); SBAR(); } while (0)
    f32x16 pA0, pA1, pB0, pB1; float mnA, mnB, alA, alB; bf16x8 pa0, pa1, pa2, pa3;
    SWRITE_HV(0); SBAR();
    SLOAD_H(Kh, Vh, KBASE(1));
    SBAR(); qkt<0>(pA0, pA1, K_lds, r32, hi, S.qr);
    MASKT(pA0, pA1, 0); partialSM(pA0, pA1, m_reg, mnA, alA, MASKED(0));
    VMW(); SWRITE_H(1);
    __syncthreads();
#define HALF_STEP(PX0, PX1, mnX, alX, PY0, PY1, alY, t, KB, VB, SB) do {                                                      \
        SBAR(); qkt<KB>(PX0, PX1, K_lds, r32, hi, S.qr);                                                         \
        finishSM(PY0, PY1, alY, l_reg, pa0, pa1, pa2, pa3); SBAR();                                                           \
        if ((t) + 1 < NT) { SLOAD_H(Kh, Vh, KBASE((t) + 1)); SBAR(); }                                               \
        pv_sm<VB>(o, vb0, pa0, pa1, pa2, pa3, PX0, PX1, m_reg, mnX, alX, MASKED(t), (((t) >> 2) == own && KBASE(t) + KVBLK - 1 > qlo), qm - KBASE(t));                \
        __syncthreads();                                                                                                      \
        if ((t) + 1 < NT) { VMW(); SWRITE_H(SB); }                                                                          \
        RESC(alX); __syncthreads(); } while (0)
    for (int t = 1; t + 1 < NT; t += 2) {
        HALF_STEP(pB0, pB1, mnB, alB, pA0, pA1, alA, t, 1, 0, 0);
        HALF_STEP(pA0, pA1, mnA, alA, pB0, pB1, alB, t + 1, 0, 1, 1);
    }
    SBAR(); qkt<1>(pB0, pB1, K_lds, r32, hi, S.qr); SBAR();
    SLOAD_H(nxt.K, nxt.V, 0); SBAR();
#pragma unroll
    for (int d0 = 0; d0 < 8; ++d0) S.qr[d0] = ld8(nxt.Q + (size_t)(wid * QBLK + r32) * PITCH + d0 * 16 + hi * 8);
    SBAR();
    finishSM(pA0, pA1, alA, l_reg, pa0, pa1, pa2, pa3); SBAR();
    pv_tile<0>(o, vb0, pa0, pa1, pa2, pa3);
    MASKT(pB0, pB1, NT - 1); partialSM(pB0, pB1, m_reg, mnB, alB, MASKED(NT - 1)); __syncthreads(); RESC(alB);
    finishSM(pB0, pB1, alB, l_reg, pa0, pa1, pa2, pa3); SBAR(); pv_tile<1>(o, vb0, pa0, pa1, pa2, pa3);
    SBAR(); SEAM_K0();
    if (nxt.bh != cur.bh) write_km(C.kmean + (size_t)nxt.bh * 8 * 128, lds + OFF_KM, tid);
    if (hi == 0) li_l[r32] = l_reg; asm volatile("s_waitcnt lgkmcnt(0)" ::: "memory");
    float rli[16];
#pragma unroll
    for (int r = 0; r < 16; ++r) rli[r] = __builtin_amdgcn_rcpf(li_l[crow(r, hi)]);
    {   int el = lane; asm volatile("" : "+v"(el));
        const int er32 = el & 31, ehi = el >> 5, erow = el >> 4, ech = el & 15;
        char* stg = lds + OFF_OST + wid * 8192;
        const int h = cur.bh & 7;
        const int mrow = cur.m0 + wid * QBLK;
        char* wb = stg + (4 * ehi) * 256 + er32 * 2;
#pragma unroll
        for (int r = 0; r < 16; ++r) {
#pragma unroll
            for (int d0 = 0; d0 < 4; ++d0) { const float v = o[d0][r] * rli[r]; const unsigned w = cvtpk(v, v);
                *(bf16*)(wb + ((r & 3) + 8 * (r >> 2)) * 256 + d0 * 64) = (bf16)(w & 0xffffu); } }
        asm volatile("s_waitcnt lgkmcnt(0)" ::: "memory"); SBAR();
        const char* rb = stg + erow * 256 + ech * 16;
        const bf16* zp = C.ZA + (size_t)(mrow + erow) * 1024 + h * 128 + ech * 8;
        bf16* yp = C.Y + (size_t)(mrow + erow) * 2048 + 1024 + h * 128 + ech * 8;
        unsigned char* yp8 = (unsigned char*)C.Y + (size_t)(mrow + erow) * 2048 + 1024 + h * 128 + ech * 8;
        float* sp = C.SSQ + (size_t)(mrow + erow) * 8 + h;
        u32x4 zz[8];
#pragma unroll
        for (int i = 0; i < 8; ++i) zz[i] = *(const u32x4*)(zp + (size_t)i * 4096);
#pragma unroll
        for (int i = 0; i < 8; ++i) {
            const u32x4 v = *(const u32x4*)(rb + i * 1024);
            float ov[8] = {bflo(v[0]), bfhi(v[0]), bflo(v[1]), bfhi(v[1]), bflo(v[2]), bfhi(v[2]), bflo(v[3]), bfhi(v[3])};
            float zv[8] = {bflo(zz[i][0]), bfhi(zz[i][0]), bflo(zz[i][1]), bfhi(zz[i][1]), bflo(zz[i][2]), bfhi(zz[i][2]), bflo(zz[i][3]), bfhi(zz[i][3])};
            float ss = 0.f, y[8];
#pragma unroll
            for (int e = 0; e < 8; ++e) { ss += ov[e] * ov[e]; y[e] = ov[e] * (zv[e] / (1.0f + __expf(-zv[e]))); }
            ss += __shfl_xor(ss, 1); ss += __shfl_xor(ss, 2); ss += __shfl_xor(ss, 4); ss += __shfl_xor(ss, 8);
            if (ech == 0) sp[i * 32] = ss;
            if (C.y8 != 0.0f) { typedef unsigned u32x2 __attribute__((ext_vector_type(2))); u32x2 w; unsigned t = 0;
#pragma unroll
                for (int e = 0; e < 8; ++e) y[e] = fminf(fmaxf(y[e] * C.y8, -448.0f), 448.0f);
                t = __builtin_amdgcn_cvt_pk_fp8_f32(y[0], y[1], t, false); t = __builtin_amdgcn_cvt_pk_fp8_f32(y[2], y[3], t, true); w.x = t; t = 0;
                t = __builtin_amdgcn_cvt_pk_fp8_f32(y[4], y[5], t, false); t = __builtin_amdgcn_cvt_pk_fp8_f32(y[6], y[7], t, true); w.y = t;
                *(u32x2*)(yp8 + (size_t)i * 8192) = w; }
            else { u32x4 w = {cvtpk(y[0], y[1]), cvtpk(y[2], y[3]), cvtpk(y[4], y[5]), cvtpk(y[6], y[7])};
            *(u32x4*)(yp + (size_t)i * 8192) = w; } }
    }
    __syncthreads();
#undef RESC
#undef KBASE
#undef MASKED
#undef MASKT
#undef SEAM_K0
#undef HALF_STEP
}
#undef ROW
#undef VMW
#undef VMWN
#undef SLOAD_H
#undef SWRITE_HK
#undef SWRITE_HV
#undef SWRITE_H
#undef KSWZ
#undef SBAR
}


struct Frame {
    LAS unsigned char* lds;
    volatile LAS unsigned* MISC;
    gu32* ctl;
    int tid, lane, wave;
    int vcu, G;
    const float *x, *norm_gain, *w_in, *conv_w, *qg, *kg, *cog, *aog, *w_out; float* out;
    bf16 *WinT, *WoutT, *XN, *PROJ, *Y; float *KMEAN, *SSQ, *XRS; unsigned char *XN8, *Win8;
};

__device__ __forceinline__ float wave_sum(float v) {
#pragma unroll
    for (int o = 1; o < 64; o <<= 1) v += __shfl_xor(v, o);
    return v;
}
__device__ __forceinline__ float wave_max(float v) {
#pragma unroll
    for (int o = 1; o < 64; o <<= 1) v = fmaxf(v, __shfl_xor(v, o));
    return v;
}
__device__ __forceinline__ float bf_lo(unsigned w) { return __builtin_bit_cast(float, w << 16); }
__device__ __forceinline__ float bf_hi(unsigned w) { return __builtin_bit_cast(float, w & 0xffff0000u); }
__device__ __forceinline__ float silu_f(float z) { return z / (1.0f + __expf(-z)); }
__device__ __forceinline__ float clamp8(float v) { return fminf(fmaxf(v, -448.0f), 448.0f); }
__device__ __forceinline__ unsigned pk4_fp8(float a, float b, float c, float d) { a = clamp8(a); b = clamp8(b); c = clamp8(c); d = clamp8(d); unsigned w = 0; w = __builtin_amdgcn_cvt_pk_fp8_f32(a, b, w, false); w = __builtin_amdgcn_cvt_pk_fp8_f32(c, d, w, true); return w; }

__device__ __forceinline__ void p0_transpose_item(const float* W, const float* g0, const float* g1, int ksplit, int K, int N, bf16* WT, LAS float* scr, int item, int lane, bool fp8 = false, float wscale = 1.0f, int drow = -1, int pitch8 = 0) {
    const int nblk = N / 32, kb = item / nblk, nb = item % nblk, k0 = 64 * kb, n0 = 32 * nb, d0 = drow >= 0 ? drow : n0;
    float wv[32];
    const float* wp = W + (size_t)(k0 + (lane >> 5)) * N + n0 + (lane & 31);
#pragma unroll
    for (int i = 0; i < 32; ++i) wv[i] = __builtin_nontemporal_load(wp + (size_t)(2 * i) * N);
    const float* gp = (k0 < ksplit) ? g0 + k0 : g1 + (k0 - ksplit);
    const float gl = gp[lane];
#pragma unroll
    for (int i = 0; i < 32; ++i) { const int kk = 2 * i + (lane >> 5); const float gv = __shfl(gl, kk);
        scr[kk * 33 + (lane & 31)] = wv[i] * gv; }
    LDS_WAIT(); asm volatile("" ::: "memory");
    const int c = lane & 7;
#pragma unroll
    for (int j = 0; j < 4; ++j) { const int n = (lane >> 3) + 8 * j; const LAS float* s = scr + (8 * c) * 33 + n;
        if (fp8) { typedef unsigned u32x2g __attribute__((ext_vector_type(2))); u32x2g o;
            o.x = pk4_fp8(s[0 * 33] * wscale, s[1 * 33] * wscale, s[2 * 33] * wscale, s[3 * 33] * wscale); o.y = pk4_fp8(s[4 * 33] * wscale, s[5 * 33] * wscale, s[6 * 33] * wscale, s[7 * 33] * wscale);
            *(GAS u32x2g*)((unsigned char*)WT + (size_t)(d0 + n) * (pitch8 ? pitch8 : K) + k0 + 8 * c) = o; }
        else { v4u o; o.x = pk2(s[0 * 33] * wscale, s[1 * 33] * wscale); o.y = pk2(s[2 * 33] * wscale, s[3 * 33] * wscale); o.z = pk2(s[4 * 33] * wscale, s[5 * 33] * wscale); o.w = pk2(s[6 * 33] * wscale, s[7 * 33] * wscale);
        *(GAS v4u*)(WT + (size_t)(d0 + n) * K + k0 + 8 * c) = o; } }
    LDS_WAIT(); asm volatile("" ::: "memory");
}
__device__ __forceinline__ void rms_row_to_bf16(Frame& F, const float* xrow, bf16* orow) {
    const GAS f32x4* xr = (const GAS f32x4*)xrow + F.lane;
    f32x4 v[8]; float s = 0.f;
#pragma unroll
    for (int j = 0; j < 8; ++j) { v[j] = xr[64 * j]; s += (v[j].x * v[j].x + v[j].y * v[j].y) + (v[j].z * v[j].z + v[j].w * v[j].w); }
    const float rs = 1.f / sqrtf(wave_sum(s) * (1.f / DM) + EPS);
    GAS unsigned long long* o8 = (GAS unsigned long long*)orow + F.lane;
#pragma unroll
    for (int j = 0; j < 8; ++j) o8[64 * j] = (unsigned long long)pk2(v[j].x * rs, v[j].y * rs) | ((unsigned long long)pk2(v[j].z * rs, v[j].w * rs) << 32);
}
__device__ __forceinline__ void rms_row2_to_bf16(Frame& F, const float* xrow, bf16* orow, size_t rstride) {
    const GAS f32x4* xa = (const GAS f32x4*)xrow + F.lane; const GAS f32x4* xb = (const GAS f32x4*)(xrow + rstride) + F.lane;
    f32x4 va[8], vb[8]; float sa = 0.f, sb = 0.f;
#pragma unroll
    for (int j = 0; j < 8; ++j) va[j] = __builtin_nontemporal_load(xa + 64 * j);
#pragma unroll
    for (int j = 0; j < 8; ++j) vb[j] = __builtin_nontemporal_load(xb + 64 * j);
#pragma unroll
    for (int j = 0; j < 8; ++j) sa += (va[j].x * va[j].x + va[j].y * va[j].y) + (va[j].z * va[j].z + va[j].w * va[j].w);
#pragma unroll
    for (int j = 0; j < 8; ++j) sb += (vb[j].x * vb[j].x + vb[j].y * vb[j].y) + (vb[j].z * vb[j].z + vb[j].w * vb[j].w);
    const float qa = sqrtf(wave_sum(sa) * (1.f / DM) + EPS), qb = sqrtf(wave_sum(sb) * (1.f / DM) + EPS), ra = 1.f / qa, rb = 1.f / qb;
    if (F.lane == 0) { const size_t m = (size_t)(orow - F.XN) / DM; F.XRS[m] = qa; F.XRS[m + rstride / DM] = qb; }
    GAS unsigned long long* oa = (GAS unsigned long long*)orow + F.lane; GAS unsigned long long* ob = (GAS unsigned long long*)(orow + rstride) + F.lane;
#pragma unroll
    for (int j = 0; j < 8; ++j) oa[64 * j] = (unsigned long long)pk2(va[j].x * ra, va[j].y * ra) | ((unsigned long long)pk2(va[j].z * ra, va[j].w * ra) << 32);
#pragma unroll
    for (int j = 0; j < 8; ++j) ob[64 * j] = (unsigned long long)pk2(vb[j].x * rb, vb[j].y * rb) | ((unsigned long long)pk2(vb[j].z * rb, vb[j].w * rb) << 32);
    if (NF8 > 0) { GAS unsigned* pa = (GAS unsigned*)(F.XN8 + (orow - F.XN)) + F.lane; GAS unsigned* pb = (GAS unsigned*)(F.XN8 + (orow - F.XN) + rstride) + F.lane;
#pragma unroll
        for (int j = 0; j < 8; ++j) { pa[64 * j] = pk4_fp8(va[j].x * ra, va[j].y * ra, va[j].z * ra, va[j].w * ra); pb[64 * j] = pk4_fp8(vb[j].x * rb, vb[j].y * rb, vb[j].z * rb, vb[j].w * rb); } }
}
__device__ __forceinline__ void p0_prologue(Frame& F, bool wout) {
    LAS float* scr = (LAS float*)(F.lds + RING_OFF + F.wave * 16384);
    const int gw = F.vcu * NWAVES + F.wave, NGW = F.G * NWAVES;
    constexpr int I_IN = (DM / 64) * (DIN / 32), I_OUT = (DMIX / 64) * (DM / 32);
    if (!wout) for (int m = gw; m < M; m += 2 * NGW) rms_row2_to_bf16(F, F.x + (size_t)m * DM, F.XN + (size_t)m * DM, (size_t)NGW * DM);
    for (int it = (wout ? I_IN : 0) + gw; it < (wout ? I_IN + I_OUT : I_IN); it += NGW) {
        if (it < I_IN) { const int n0 = 32 * (it % (DIN / 32)), ts = n0 >> 10, c0 = n0 & 1023; int lt0, roff;
            if (ts == 0 || ts == 2) { lt0 = 16 + (c0 >> 7); roff = (ts >> 1) * 128 + (c0 & 127); }
            else { lt0 = (int)((PPOS >> (4 * ts)) & 15u) * 4 + (c0 >> 8); roff = c0 & 255; }
            if ((lt0 >> 2) < NF8) p0_transpose_item(F.w_in, F.norm_gain, F.norm_gain, DM, DM, DIN, (bf16*)F.Win8, scr, it, F.lane, true, WI8_SCALE, lt0 * 256 + roff);
            else p0_transpose_item(F.w_in, F.norm_gain, F.norm_gain, DM, DM, DIN, F.WinT, scr, it, F.lane, false, 1.0f, (lt0 - 4 * NF8) * 256 + roff); }
        else if (HYBP > 0) { const int k0o = 64 * ((it - I_IN) / (DM / 32));
            if (k0o < HYBC) p0_transpose_item(F.w_out, F.cog, F.aog, DCONV, DMIX, DM, F.WoutT, scr, it - I_IN, F.lane, true, HYB_W, -1, DMIX * 2);
            else p0_transpose_item(F.w_out, F.cog, F.aog, DCONV, DMIX, DM, F.WoutT, scr, it - I_IN, F.lane, false, HYB_ALL); }
        else p0_transpose_item(F.w_out, F.cog, F.aog, DCONV, DMIX, DM, F.WoutT, scr, it - I_IN, F.lane, FP8_OUT, W8_SCALE);
    }
}

__device__ __forceinline__ void unpack8(const v4u a, float (&f)[16], int o) {
    f[o + 0] = bf_lo(a.x); f[o + 1] = bf_hi(a.x); f[o + 2] = bf_lo(a.y); f[o + 3] = bf_hi(a.y); f[o + 4] = bf_lo(a.z); f[o + 5] = bf_hi(a.z); f[o + 6] = bf_lo(a.w); f[o + 7] = bf_hi(a.w); }
__device__ __forceinline__ void p2_conv(Frame& F) {
    const int gw = F.vcu * NWAVES + F.wave, NGW = F.G * NWAVES;
    const bf16* UU = F.PROJ; const bf16* BG = F.PROJ + PROJ_STRIDE / 2; const bf16* ZC = F.PROJ + 3 * (PROJ_STRIDE / 2);
    for (int ck = gw; ck < M / 8; ck += NGW) {
        const int m0 = ck * 8, t0 = m0 % SEQ;
        const size_t co = (size_t)8 * F.lane;
        float w0[16], w1[16], w2[16], u1[16], u2[16];
#pragma unroll
        for (int j = 0; j < 2; ++j)
#pragma unroll
            for (int q = 0; q < 2; ++q) { const int c = 8 * F.lane + 512 * j + 4 * q;
                const f32x4 a = *(const GAS f32x4*)(F.conv_w + c), b = *(const GAS f32x4*)(F.conv_w + DCONV + c), d = *(const GAS f32x4*)(F.conv_w + 2 * DCONV + c);
#pragma unroll
                for (int e = 0; e < 4; ++e) { w0[8 * j + 4 * q + e] = a[e]; w1[8 * j + 4 * q + e] = b[e]; w2[8 * j + 4 * q + e] = d[e]; } }
        if (t0 > 0) {
#pragma unroll
            for (int j = 0; j < 2; ++j) { unpack8(*((const GAS v4u*)(UU + (size_t)(m0 - 2) * 1024 + co + 512 * j)), u2, 8 * j); unpack8(*((const GAS v4u*)(UU + (size_t)(m0 - 1) * 1024 + co + 512 * j)), u1, 8 * j); }
        } else {
#pragma unroll
            for (int e = 0; e < 16; ++e) { u1[e] = 0.f; u2[e] = 0.f; }
        }
#pragma unroll 2
        for (int i = 0; i < 8; ++i) {
            const size_t m = (size_t)(m0 + i);
            float u0[16], bb[16], zz[16], y[16];
#pragma unroll
            for (int j = 0; j < 2; ++j) { unpack8(*((const GAS v4u*)(UU + m * 1024 + co + 512 * j)), u0, 8 * j);
                unpack8(*((const GAS v4u*)(BG + m * 1024 + co + 512 * j)), bb, 8 * j); unpack8(*((const GAS v4u*)(ZC + m * 1024 + co + 512 * j)), zz, 8 * j); }
            float ss = 0.f;
#pragma unroll
            for (int e = 0; e < 16; ++e) { const float cv = w0[e] * u2[e] + w1[e] * u1[e] + w2[e] * u0[e]; y[e] = bb[e] * cv; ss += y[e] * y[e]; u2[e] = u1[e]; u1[e] = u0[e]; }
            const float rs = 1.f / sqrtf(wave_sum(ss) * (1.f / DCONV) + EPS);
#pragma unroll
            for (int j = 0; j < 2; ++j) { float o[8];
#pragma unroll
                for (int e = 0; e < 8; ++e) o[e] = y[8 * j + e] * rs * silu_f(zz[8 * j + e]);
                if (HYBP > 0 && 512 * j + 8 * F.lane < HYBC) {   typedef unsigned u32x2g __attribute__((ext_vector_type(2))); u32x2g w;
                    w.x = pk4_fp8(o[0] * HYB_Y, o[1] * HYB_Y, o[2] * HYB_Y, o[3] * HYB_Y); w.y = pk4_fp8(o[4] * HYB_Y, o[5] * HYB_Y, o[6] * HYB_Y, o[7] * HYB_Y);
                    *(GAS u32x2g*)((unsigned char*)F.Y + m * (DMIX * 2) + co + 512 * j) = w; }
                else if (FP8_OUT) { typedef unsigned u32x2g __attribute__((ext_vector_type(2))); u32x2g w;
                    w.x = pk4_fp8(o[0] * Y8C_SCALE, o[1] * Y8C_SCALE, o[2] * Y8C_SCALE, o[3] * Y8C_SCALE); w.y = pk4_fp8(o[4] * Y8C_SCALE, o[5] * Y8C_SCALE, o[6] * Y8C_SCALE, o[7] * Y8C_SCALE);
                    *(GAS u32x2g*)((unsigned char*)F.Y + m * DMIX + co + 512 * j) = w; }
                else { v4u w; w.x = pk2(o[0], o[1]); w.y = pk2(o[2], o[3]); w.z = pk2(o[4], o[5]); w.w = pk2(o[6], o[7]);
                *(GAS v4u*)(F.Y + m * DMIX + co + 512 * j) = w; } }
        }
    }
}
__device__ __forceinline__ moba::BlockRef moba_ref(Frame& F, int bh, int qb) {
    const int b = bh >> 3, h = bh & 7; moba::BlockRef r;
    const bf16* Q = F.PROJ + 4 * (PROJ_STRIDE / 2); const bf16* K = F.PROJ + 5 * (PROJ_STRIDE / 2); const bf16* V = F.PROJ + 6 * (PROJ_STRIDE / 2);
    r.Q = Q + ((size_t)bh * SEQ + (size_t)qb * 256) * HD; r.K = K + (size_t)bh * SEQ * HD; r.V = V + (size_t)bh * SEQ * HD;
    r.bh = bh; r.qb = qb; r.m0 = b * SEQ + qb * 256; return r;
}
__device__ __forceinline__ void p3_attn(Frame& F, char* lds) {
    static_assert(moba::LDS_BYTES <= RING_BYTES, "attention LDS vs ring");
    moba::Ctx C{F.KMEAN, F.PROJ + 7 * (PROJ_STRIDE / 2), F.Y, F.SSQ, FP8_OUT ? Y8A_SCALE : 0.0f};
    for (int L = F.vcu; L < BATCH * NH * 4; L += F.G) {
        const int bh = L >> 2, x = L & 3;
        const moba::BlockRef r0 = moba_ref(F, bh, x), r1 = moba_ref(F, bh, 7 - x);
        moba::Seam S;
        moba::moba_prime(r0, C, lds, S);
        moba::moba_block(r0, r1, C, lds, S);
        moba::moba_block(r1, r1, C, lds, S);
    }
}
struct Args { const float* in[9]; float* out; unsigned char* ws; int ph_lo, ph_hi, li, pad; };
__global__ void __launch_bounds__(NWAVES * 64, 2) skel_fwd(Args args) {
    extern __shared__ __attribute__((aligned(16))) unsigned char lds[];
    Frame F;
    F.lds = (LAS unsigned char*)lds;
    F.MISC = (volatile LAS unsigned*)(F.lds + MISC_OFF);
    F.tid = threadIdx.x; F.lane = F.tid & 63; F.wave = __builtin_amdgcn_readfirstlane(F.tid >> 6);
    F.G = gridDim.x; { const int bx = blockIdx.x; F.vcu = (F.G % 8 == 0) ? (bx % 8) * (F.G / 8) + bx / 8 : bx; }
#define GRID_BAR(seam) do { if (!ONE_LAUNCH) { if (F.tid == 0) __hip_atomic_store(F.ctl + CW_TMO, 0xBADBA0u | (unsigned)(seam), RLX_AGENT); } \
    else if ((seam) != 0 && MK_LOCBAR && F.MISC[10]) { xcd_barrier_local(bar); }     \
    else { xcd_barrier(bar); } } while (0)
    unsigned char* ws = args.ws;
    F.ctl = (gu32*)(ws + WS_CTL);
    F.x = args.in[0]; F.norm_gain = args.in[1]; F.w_in = args.in[2]; F.conv_w = args.in[3]; F.qg = args.in[4]; F.kg = args.in[5];
    F.cog = args.in[6]; F.aog = args.in[7]; F.w_out = args.in[8]; F.out = args.out;
    F.WinT = (bf16*)(ws + WS_WIN); F.WoutT = (bf16*)(ws + WS_WOUT); F.XN = (bf16*)(ws + WS_XN); F.PROJ = (bf16*)(ws + WS_PROJ); F.Y = (bf16*)(ws + WS_Y);
    F.KMEAN = (float*)(ws + WS_KMEAN); F.SSQ = (float*)(ws + WS_SSQ); F.XRS = (float*)(ws + WS_XRS); F.XN8 = ws + WS_XN8; F.Win8 = ws + WS_WIN8;
    for (int u = F.tid; u < (LDS_BYTES - LDSCTL_OFF) / 4; u += NWAVES * 64) ((LAS unsigned*)(F.lds + LDSCTL_OFF))[u] = 0u;
    __syncthreads();
    XcdBarrier bar; bar.bar = (unsigned*)(F.ctl + CW_BAR); bar.x = 0; bar.st = nullptr;
    if (ONE_LAUNCH) { bar = xcd_barrier_post((unsigned*)(F.ctl + CW_BAR), F.MISC + 8);
        if (F.tid == 0 && (bar.x != ((unsigned)blockIdx.x & 7u) || (F.G & 7) != 0 || F.G != 256)) (void)xb_add(&bar.bar[XB_MIS], 1u); }

    const int lo = args.ph_lo, hi = args.ph_hi;
#define IN(k) (lo <= (k) && (k) < hi)
#define BOTH(k) (IN(k) && IN((k) + 1))

    if (IN(0)) { p0_prologue(F, false); p0_prologue(F, true);
        if (BOTH(0)) { GRID_BAR(0); if (F.tid == 0) F.MISC[10] = (ONE_LAUNCH && xb_ld(&bar.bar[XB_MIS]) == 0u) ? 1u : 0u; __syncthreads(); } }

    if (IN(1)) {
        {
        { pg8::Gemm g{F.XN, F.WinT, M, DIN - NF8 * 1024, DM}; pg8::StaticOrder S; S.init(M, DIN - NF8 * 1024, F.G, (int)blockIdx.x);
        pg8::EpiProj E{F.PROJ, PROJ_STRIDE / 2, F.qg, F.kg, F.KMEAN, F.lds + 131072, EPS, 4 * NF8, PORD, 1.0f};
        pg8::gemm_phase<pg8::EpiProj, pg8::StaticOrder, true, PG8_SP2>(F.lds + RING_OFF, g, S, E); }
        if constexpr (NF8 > 0) {
            pg8::Gemm g{(const bf16*)F.XN8, (const bf16*)F.Win8, M, NF8 * 1024, DM / 2}; pg8::StaticOrder S; S.init(M, NF8 * 1024, F.G, (int)blockIdx.x);
            pg8::EpiProj E{F.PROJ, PROJ_STRIDE / 2, F.qg, F.kg, F.KMEAN, F.lds + 131072, EPS, 0, PORD, 1.0f / (X8_SCALE * WI8_SCALE)};
            pg8::gemm_phase<pg8::EpiProj, pg8::StaticOrder, true, PG8_SP2_FP8, true>(F.lds + RING_OFF, g, S, E); }
 }
        if (BOTH(1)) GRID_BAR(1);
    }
    if (IN(2)) {
        p2_conv(F);
        p3_attn(F, (char*)lds);
        if (BOTH(2)) GRID_BAR(2);
    }
    if (IN(3)) {
        pg8::Gemm g{F.Y, F.WoutT, M, DM, FP8_OUT ? DMIX / 2 : DMIX}; pg8::StaticOrder S; S.init(M, DM, F.G, (int)blockIdx.x);
        pg8::EpiOut E{F.XN, F.XRS, F.out, DM, F.SSQ, EPS, (LAS float*)(F.lds + 131072), FP8_OUT ? 1.0f / (Y8A_SCALE * W8_SCALE) : (HYBP > 0 ? 1.0f / HYB_ALL : 1.0f), FP8_OUT ? Y8A_SCALE / Y8C_SCALE : 1.0f};
        pg8::gemm_phase<pg8::EpiOut, pg8::StaticOrder, true, (FP8_OUT ? PG8_SP2_FP8 : PG8_SP2), FP8_OUT, (FP8_OUT ? 0 : HYBP)>(F.lds + RING_OFF, g, S, E);
    }
#undef IN
#undef BOTH
}

extern "C" void kernel_launch(void* const* d_in, const int* in_sizes, int n_in, void* d_out, int out_size, void* d_ws, size_t ws_size, hipStream_t stream) {
    static int grid = 0;
    if (grid == 0) {
        if (n_in != 9 || in_sizes[0] != M * DM || out_size != M * DM || ws_size < WS_END) { fprintf(stderr, "kernel_launch: shape/workspace mismatch (n_in %d, in0 %d, out %d, ws %zu)\n", n_in, n_in > 0 ? in_sizes[0] : -1, out_size, ws_size); grid = -1; return; }
        int dev = 0, cus = 0;
        if (hipGetDevice(&dev) != hipSuccess || hipDeviceGetAttribute(&cus, hipDeviceAttributeMultiprocessorCount, dev) != hipSuccess) { fprintf(stderr, "kernel_launch: device query failed\n"); grid = -1; return; }
        if (hipFuncSetAttribute((const void*)skel_fwd, hipFuncAttributeMaxDynamicSharedMemorySize, LDS_BYTES) != hipSuccess) { fprintf(stderr, "kernel_launch: hipFuncSetAttribute failed\n"); grid = -1; return; }
        (void)hipGetLastError();
        grid = cus;
    }
    if (grid < 0) return;
    if (hipMemsetAsync((char*)d_ws + WS_CTL, 0, CTL_ZERO_BYTES, stream) != hipSuccess) { fprintf(stderr, "kernel_launch: hipMemsetAsync failed\n"); return; }
    Args a{};
    for (int i = 0; i < 9; ++i) a.in[i] = (const float*)d_in[i];
    a.out = (float*)d_out; a.ws = (unsigned char*)d_ws;
    if (ONE_LAUNCH) {
        a.ph_lo = 0; a.ph_hi = PER_PHASE; a.li = 0;
        hipLaunchKernelGGL(skel_fwd, dim3(grid), dim3(NWAVES * 64), LDS_BYTES, stream, a);
    } else {
        for (int li = 0; li < PER_PHASE; ++li) { a.ph_lo = li; a.ph_hi = li + 1; a.li = li;
            hipLaunchKernelGGL(skel_fwd, dim3(grid), dim3(NWAVES * 64), LDS_BYTES, stream, a); }
    }
}
```
